# Optimizing an MI355X kernel written in HIP

```python
import jax, jax.numpy as jnp
from jax import lax
import numpy as np

D_MODEL = 1024
BATCH = 2
SEQ = 8192
DEPTH = 2

N_MIXERS = 2
EPS = 1e-6

DSW_PATTERNS = ((128, 1), (512, 4), (2048, 16))
DSW_GROUPS = len(DSW_PATTERNS)
DSW_HEADS = 16
DSW_HEAD_DIM = D_MODEL // DSW_HEADS
DSW_IN_DIM = 3 * DSW_GROUPS * DSW_HEADS * DSW_HEAD_DIM

GLA_HEADS = 4
GLA_DK = D_MODEL // 2
GLA_DV = D_MODEL
GLA_HK = GLA_DK // GLA_HEADS
GLA_HV = GLA_DV // GLA_HEADS
GLA_GATE_RANK = 16
GLA_TAU = 16.0
GLA_CHUNK = 64
GLA_SPLITS = (GLA_DK, 2 * GLA_DK, 2 * GLA_DK + GLA_DV, 2 * GLA_DK + GLA_DV + GLA_GATE_RANK)
GLA_IN_DIM = 2 * GLA_DK + 2 * GLA_DV + GLA_GATE_RANK

FFN_DIM = 2816
CONV_WIDTH = 3

N_ATTN_LAYERS = (DEPTH + 1) // N_MIXERS
N_GLA_LAYERS = DEPTH // N_MIXERS

kernel_name = "hybrid_dilated_attn_gla_convffn_adaln"


def rms_norm(x, gain):
    xf = x.astype(jnp.float32)
    y = xf * lax.rsqrt(jnp.mean(xf * xf, axis=-1, keepdims=True) + EPS)
    return (y * gain.astype(jnp.float32)).astype(x.dtype)


def modulate(x, gain, shift, scale):
    return rms_norm(x, gain) * (1 + scale[:, None, :]) + shift[:, None, :]


def dilated_window_attention(q, k, v, window, dilation):
    B, S, H, E = q.shape
    n_keys = window // dilation
    L = S // dilation
    nb = -(-L // n_keys)
    L_pad = nb * n_keys

    def to_blocks(t):
        t = t.reshape(B, L, dilation, H, E).transpose(0, 2, 1, 3, 4)
        t = jnp.pad(t, ((0, 0), (0, 0), (0, L_pad - L), (0, 0), (0, 0)))
        return t.reshape(B, dilation, nb, n_keys, H, E)

    def with_prev(t):
        prev = jnp.pad(t, ((0, 0), (0, 0), (1, 0), (0, 0), (0, 0), (0, 0)))[:, :, :-1]
        return jnp.concatenate([prev, t], axis=3)

    qb = to_blocks(q)
    kb = with_prev(to_blocks(k))
    vb = with_prev(to_blocks(v))

    s = jnp.einsum('brnqhe,brnkhe->brnhqk', qb, kb,
                   preferred_element_type=jnp.float32) * (E ** -0.5)
    qi = jnp.arange(n_keys)[:, None] + n_keys
    kj = jnp.arange(2 * n_keys)[None, :]
    dist = qi - kj
    band = (dist >= 0) & (dist <= n_keys)
    not_first = (jnp.arange(nb) > 0)[:, None, None]
    valid = band[None] & (not_first | (kj >= n_keys)[None])
    s = jnp.where(valid[:, None], s, -jnp.inf)

    m = jnp.max(s, axis=-1, keepdims=True)
    p = jnp.exp(s - m)
    denom = jnp.sum(p, axis=-1, keepdims=True)
    o = jnp.einsum('brnhqk,brnkhe->brnqhe', p / denom, vb.astype(jnp.float32))
    lse = jnp.swapaxes((m + jnp.log(denom))[..., 0], 3, 4)

    def from_blocks(t):
        t = t.reshape((B, dilation, L_pad) + t.shape[4:])[:, :, :L]
        t = jnp.swapaxes(t, 1, 2)
        return t.reshape((B, S) + t.shape[3:])

    return from_blocks(o), from_blocks(lse)


def dilated_mixture_attention(h, w_in, w_out):
    B, S, _ = h.shape
    qkv = (h @ w_in).reshape(B, S, 3, DSW_GROUPS, DSW_HEADS, DSW_HEAD_DIM)
    outs, lses = [], []
    for g, (window, dilation) in enumerate(DSW_PATTERNS):
        o, lse = dilated_window_attention(qkv[:, :, 0, g], qkv[:, :, 1, g], qkv[:, :, 2, g],
                                          window, dilation)
        outs.append(o)
        lses.append(lse)
    weights = jax.nn.softmax(jnp.stack(lses, axis=0), axis=0)
    o = jnp.sum(weights[..., None] * jnp.stack(outs, axis=0), axis=0)
    return o.reshape(B, S, D_MODEL).astype(h.dtype) @ w_out


def gated_linear_attention(h, w_in, w_gate, b_gate, norm_gain, w_out):
    B, S, _ = h.shape
    f32 = jnp.float32
    q, k, v, g_low, r = jnp.split(h @ w_in, list(GLA_SPLITS), axis=-1)
    log_a = jax.nn.log_sigmoid((g_low @ w_gate + b_gate).astype(f32)) / GLA_TAU

    nc = S // GLA_CHUNK

    def chunks(t, hd):
        return t.astype(f32).reshape(B, nc, GLA_CHUNK, GLA_HEADS, hd)

    q = chunks(q, GLA_HK) * (GLA_HK ** -0.5)
    k = chunks(k, GLA_HK)
    v = chunks(v, GLA_HV)
    b = jnp.cumsum(chunks(log_a, GLA_HK), axis=2)
    b_last = b[:, :, -1:]
    q_dec = q * jnp.exp(b)
    k_dec = k * jnp.exp(-b)
    k_to_end = k * jnp.exp(b_last - b)

    causal = jnp.tril(jnp.ones((GLA_CHUNK, GLA_CHUNK), dtype=bool))
    att = jnp.where(causal, jnp.einsum('bnihk,bnjhk->bnhij', q_dec, k_dec), 0.0)
    o_intra = jnp.einsum('bnhij,bnjhv->bnihv', att, v)

    d_state = jnp.einsum('bnjhk,bnjhv->bnhkv', k_to_end, v)
    decay = jnp.exp(b_last[:, :, 0])

    def step(state, inp):
        dec, ds = inp
        return dec[..., None] * state + ds, state

    s0 = jnp.zeros((B, GLA_HEADS, GLA_HK, GLA_HV), f32)
    _, starts = lax.scan(step, s0, (jnp.moveaxis(decay, 1, 0), jnp.moveaxis(d_state, 1, 0)))
    starts = jnp.moveaxis(starts, 0, 1)
    o_inter = jnp.einsum('bnihk,bnhkv->bnihv', q_dec, starts)

    o = (o_intra + o_inter).reshape(B, S, GLA_HEADS, GLA_HV)
    o = rms_norm(o, norm_gain) * jax.nn.silu(r.astype(f32).reshape(B, S, GLA_HEADS, GLA_HV))
    return o.reshape(B, S, GLA_DV).astype(h.dtype) @ w_out


def conv_ffn(h, w_up, conv_w, conv_b, w_down):
    a, u = jnp.split(h @ w_up, 2, axis=-1)
    a = lax.conv_general_dilated(a, conv_w[:, None, :], window_strides=(1,),
                                 padding=[(CONV_WIDTH - 1, 0)],
                                 dimension_numbers=('NWC', 'WIO', 'NWC'),
                                 feature_group_count=FFN_DIM) + conv_b
    return (jax.nn.silu(a) * u) @ w_down


def setup_inputs(seed: int = 0) -> dict:
    key = jax.random.key(seed)
    ks = jax.random.split(key, 20)
    D, F = D_MODEL, FFN_DIM

    def nrm(k, shape, scale):
        return jax.random.normal(k, shape, jnp.float32) * scale

    return {
        "x": nrm(ks[0], (BATCH, SEQ, D), 1.0),
        "c": nrm(ks[1], (BATCH, D), 1.0),
        "w_ada": nrm(ks[2], (DEPTH, D, 6 * D), 0.5 * D ** -0.5),
        "b_ada": nrm(ks[3], (DEPTH, 6 * D), 0.01),
        "norm_mix": 1.0 + nrm(ks[4], (DEPTH, D), 0.01),
        "norm_ffn": 1.0 + nrm(ks[5], (DEPTH, D), 0.01),
        "attn_w_in": nrm(ks[6], (N_ATTN_LAYERS, D, DSW_IN_DIM), D ** -0.5),
        "attn_w_out": nrm(ks[7], (N_ATTN_LAYERS, D, D), D ** -0.5),
        "gla_w_in": nrm(ks[8], (N_GLA_LAYERS, D, GLA_IN_DIM), D ** -0.5),
        "gla_w_gate": nrm(ks[9], (N_GLA_LAYERS, GLA_GATE_RANK, GLA_DK), GLA_GATE_RANK ** -0.5),
        "gla_b_gate": nrm(ks[10], (N_GLA_LAYERS, GLA_DK), 0.01),
        "gla_norm": 1.0 + nrm(ks[11], (N_GLA_LAYERS, GLA_HV), 0.01),
        "gla_w_out": nrm(ks[12], (N_GLA_LAYERS, GLA_DV, D), GLA_DV ** -0.5),
        "ffn_w_up": nrm(ks[13], (DEPTH, D, 2 * F), D ** -0.5),
        "ffn_conv_w": nrm(ks[14], (DEPTH, CONV_WIDTH, F), CONV_WIDTH ** -0.5),
        "ffn_conv_b": nrm(ks[15], (DEPTH, F), 0.01),
        "ffn_w_down": nrm(ks[16], (DEPTH, F, D), F ** -0.5),
        "norm_final": 1.0 + nrm(ks[17], (D,), 0.01),
    }


def reference(x, c, w_ada, b_ada, norm_mix, norm_ffn, attn_w_in, attn_w_out,
              gla_w_in, gla_w_gate, gla_b_gate, gla_norm, gla_w_out,
              ffn_w_up, ffn_conv_w, ffn_conv_b, ffn_w_down, norm_final):
    cond = jax.nn.silu(c)
    for i in range(DEPTH):
        mod = cond @ w_ada[i] + b_ada[i]
        sh1, sc1, g1, sh2, sc2, g2 = jnp.split(mod, 6, axis=-1)
        h = modulate(x, norm_mix[i], sh1, sc1)
        j = i // N_MIXERS
        if i % N_MIXERS == 0:
            y = dilated_mixture_attention(h, attn_w_in[j], attn_w_out[j])
        else:
            y = gated_linear_attention(h, gla_w_in[j], gla_w_gate[j], gla_b_gate[j],
                                       gla_norm[j], gla_w_out[j])
        x = x + g1[:, None, :] * y
        h = modulate(x, norm_ffn[i], sh2, sc2)
        x = x + g2[:, None, :] * conv_ffn(h, ffn_w_up[i], ffn_conv_w[i], ffn_conv_b[i], ffn_w_down[i])
    return rms_norm(x, norm_final)
```

```cpp
#include <hip/hip_runtime.h>
#include <hip/hip_cooperative_groups.h>
#include <cstdio>
#include <cstdint>
namespace cg = cooperative_groups;
#ifndef STAGE
#define STAGE 4
#endif
namespace pg8 {
#define PG8_LAS __attribute__((address_space(3)))
typedef unsigned short bf16_t;
typedef short bf16x8 __attribute__((ext_vector_type(8)));
typedef float f32x4 __attribute__((ext_vector_type(4)));
typedef unsigned u32x4 __attribute__((ext_vector_type(4)));
constexpr int BM = 256, BK = 64, HALF = 128, HTB = HALF * BK * 2  , STAGE_BYTES = 8 * HTB, NXCD = 8, WGM = 8;

__host__ __device__ __forceinline__ int lds_byte(int r, int c) { const int st = (r >> 4) * 2 + (c >> 5), rr = r & 15, cc = c & 31, ob = rr * 64 + cc * 2; return st * 1024 + (ob ^ (((ob >> 9) & 1) << 5)); }
__host__ __device__ __forceinline__ void stage_rc(int b, int& R, int& C) { const int st = b / 1024, sb = b % 1024, swz = sb ^ (((sb >> 9) & 1) << 5); R = (st >> 1) * 16 + swz / 64; C = (st & 1) * 32 + (swz % 64) / 2; }
__host__ __device__ __forceinline__ int perm32(int rho) { const int n = rho >> 4, i = rho & 15; return 8 * (i >> 2) + 4 * n + (i & 3); }

struct Unit { int pm, pn; };
struct Gemm { const bf16_t* A; const bf16_t* Bt; int M, N, K; int dil, L;
    __device__ __forceinline__ size_t a_off(int pm) const { const int n0 = pm * 256; return (size_t)((n0 / L) + dil * (n0 % L)) * (size_t)K * 2; } };

struct StaticOrder {
    int nM, nN, nwg, G, c;
    __host__ __device__ void init(int M, int N, int G_, int c_) { nM = M / BM; nN = N / BM; nwg = nM * nN; G = G_; c = c_; }
    __host__ __device__ bool next(int i, Unit& u) const {
        const long L = (long)i * G + c; if (L >= nwg) return false;
        int wgid = (int)L; { const int q = nwg / NXCD, r = nwg % NXCD, xcd = wgid % NXCD, off = wgid / NXCD; wgid = (xcd < r ? xcd * (q + 1) : r * (q + 1) + (xcd - r) * q) + off; }
        const int nig = WGM * nN, gid = wgid / nig, fm = gid * WGM, gsz = (nM - fm) < WGM ? (nM - fm) : WGM;
        u.pm = fm + ((wgid % nig) % gsz); u.pn = (wgid % nig) / gsz; return true;
    }
    __device__ __forceinline__ void a_ready(const Unit&) const {}
    __device__ __forceinline__ void done(const Unit&) const {}
};

typedef unsigned u32x4 __attribute__((ext_vector_type(4)));
typedef float f32x2_t __attribute__((ext_vector_type(2))); typedef __bf16 bf16x2_t __attribute__((ext_vector_type(2)));
__device__ __forceinline__ unsigned cvt_pk_bf16(float lo, float hi) { f32x2_t v = {lo, hi}; bf16x2_t b = __builtin_convertvector(v, bf16x2_t); return __builtin_bit_cast(unsigned, b); }
__device__ __forceinline__ void store_rm_bf16(const f32x4 (&acc)[2][2][4][2], bf16_t* base, int ld, int row0, int col0) {
#pragma unroll
    for (int ai = 0; ai < 2; ++ai)
#pragma unroll
        for (int m = 0; m < 4; ++m) { bf16_t* rowp = base + (size_t)(row0 + ai * HALF + m * 16) * ld + col0;
#pragma unroll
            for (int bj = 0; bj < 2; ++bj) { const f32x4 v0 = acc[ai][bj][m][0], v1 = acc[ai][bj][m][1];
                u32x4 w; w.x = cvt_pk_bf16(v0[0], v0[1]); w.y = cvt_pk_bf16(v0[2], v0[3]); w.z = cvt_pk_bf16(v1[0], v1[1]); w.w = cvt_pk_bf16(v1[2], v1[3]);
                *(u32x4*)(rowp + bj * HALF) = w; } }
}
__device__ __forceinline__ void store_tr_bf16(const f32x4 (&acc)[2][2][4][2], bf16_t* base, size_t pitch, int row0, int col0) {
#pragma unroll
    for (int ai = 0; ai < 2; ++ai)
#pragma unroll
        for (int m = 0; m < 4; ++m) { bf16_t* rp = base + (row0 + ai * HALF + m * 16);
#pragma unroll
            for (int bj = 0; bj < 2; ++bj)
#pragma unroll
                for (int n = 0; n < 2; ++n) { const f32x4 v = acc[ai][bj][m][n]; const unsigned p0 = cvt_pk_bf16(v[0], v[1]), p1 = cvt_pk_bf16(v[2], v[3]);
                    bf16_t* cp = rp + (size_t)(col0 + bj * HALF + 4 * n) * pitch;
                    cp[0] = (bf16_t)(p0 & 0xffffu); cp[pitch] = (bf16_t)(p0 >> 16); cp[2 * pitch] = (bf16_t)(p1 & 0xffffu); cp[3 * pitch] = (bf16_t)(p1 >> 16); } }
}
struct EpiAttn {
    static constexpr bool PERM = true, AFTER_DRAIN = false;
    bf16_t* Q; bf16_t* Kb; bf16_t* VT;
    __device__ __forceinline__ void operator()(const f32x4 (&acc)[2][2][4][2], const Unit& u, int wr, int wc, int fr, int fq) const {
        const int row0 = u.pm * BM + wr * 64 + fr, col0 = (u.pn & 3) * BM + wc * 32 + 8 * fq;
        if (u.pn < 8) store_rm_bf16(acc, u.pn < 4 ? Q : Kb, 1024, row0, col0);
        else store_tr_bf16(acc, VT, 8192, row0, col0);
    }
};
struct EpiGla {
    static constexpr bool PERM = true, AFTER_DRAIN = false;
    bf16_t* Q; bf16_t* Kb; bf16_t* VT; bf16_t* R; float* GL;
    __device__ __forceinline__ void operator()(const f32x4 (&acc)[2][2][4][2], const Unit& u, int wr, int wc, int fr, int fq) const {
        const int row0 = u.pm * BM + wr * 64 + fr, cw = wc * 32 + 8 * fq;
        if (u.pn < 2) store_rm_bf16(acc, Q, 512, row0, u.pn * BM + cw);
        else if (u.pn < 4) store_rm_bf16(acc, Kb, 512, row0, (u.pn - 2) * BM + cw);
        else if (u.pn < 8) store_tr_bf16(acc, VT, 16384, row0, (u.pn - 4) * BM + cw);
        else if (u.pn < 12) store_rm_bf16(acc, R, 1024, row0, (u.pn - 8) * BM + cw);
        else if (wc == 0 && fq < 2) {
#pragma unroll
            for (int ai = 0; ai < 2; ++ai)
#pragma unroll
                for (int m = 0; m < 4; ++m) { float* gp = GL + (size_t)(row0 + ai * HALF + m * 16) * 16 + 8 * fq;
                    *(f32x4*)gp = acc[ai][0][m][0]; *(f32x4*)(gp + 4) = acc[ai][0][m][1]; }
        }
    }
};
struct EpiUp {
    static constexpr bool PERM = true, AFTER_DRAIN = false;
    bf16_t* Ab; bf16_t* Ub;
    __device__ __forceinline__ void operator()(const f32x4 (&acc)[2][2][4][2], const Unit& u, int wr, int wc, int fr, int fq) const {
        const int row0 = u.pm * BM + wr * 64 + fr, cw = wc * 32 + 8 * fq;
        if (u.pn < 11) store_rm_bf16(acc, Ab, 2816, row0, u.pn * BM + cw); else store_rm_bf16(acc, Ub, 2816, row0, (u.pn - 11) * BM + cw);
    }
};
struct EpiRes {
    static constexpr bool PERM = false, AFTER_DRAIN = false;
    const float* base; float* out; const float* gate;
    __device__ __forceinline__ void operator()(const f32x4 (&acc)[2][2][4][2], const Unit& u, int wr, int wc, int fr, int fq) const {
        const int row0 = u.pm * BM + wr * 64 + fr, col0 = u.pn * BM + wc * 32 + 4 * fq;
        const float* gp = gate + (size_t)((u.pm * BM) >> 13) * 6144 + col0;
        f32x4 gv[2][2];
#pragma unroll
        for (int bj = 0; bj < 2; ++bj)
#pragma unroll
            for (int n = 0; n < 2; ++n) gv[bj][n] = *(const f32x4*)(gp + bj * HALF + n * 16);
#pragma unroll
        for (int ai = 0; ai < 2; ++ai)
#pragma unroll
            for (int m = 0; m < 4; ++m) { const size_t off = (size_t)(row0 + ai * HALF + m * 16) * 1024 + col0;
#pragma unroll
                for (int bj = 0; bj < 2; ++bj)
#pragma unroll
                    for (int n = 0; n < 2; ++n) { const f32x4 bs = *(const f32x4*)(base + off + bj * HALF + n * 16);
                        *(f32x4*)(out + off + bj * HALF + n * 16) = bs + gv[bj][n] * acc[ai][bj][m][n]; } }
    }
};
template <class Epi, class Sched, bool ALIGN_EPI = false, bool SP2 = false>
__device__ __forceinline__ void gemm_phase(PG8_LAS unsigned char* lds, const Gemm g, const Sched& S, const Epi& E) {
    const int tid = threadIdx.x, wid = __builtin_amdgcn_readfirstlane(tid >> 6), lane = tid & 63, wr = wid >> 2, wc = wid & 3, fr = lane & 15, fq = lane >> 4;
    const int K = g.K, nt = K / BK, lda = g.dil * K;
    unsigned voffA[2], voffB[2];
#pragma unroll
    for (int i = 0; i < 2; ++i) { int R, C; stage_rc(tid * 16 + i * 8192, R, C); const int Rb = Epi::PERM ? ((R & ~31) + perm32(R & 31)) : R;
        voffA[i] = (unsigned)(R * lda + C) * 2u; voffB[i] = (unsigned)(Rb * K + C) * 2u; }
    const size_t kstep = (size_t)(BK * 2);
     const size_t hstepA = (size_t)HALF * lda * 2, hstepB = (size_t)HALF * K * 2;
    const size_t tstepB = 2 * hstepB;
    const unsigned ldsw = (unsigned)wid * 1024u;
    const int aoff = lds_byte(wr * 64 + fr, fq * 8), boff = lds_byte(wc * 32 + fr, fq * 8);
#define PG8_SA(b, h) (((b) * 2 + (h)) * HTB)
#define PG8_SB(b, h) ((4 + (b) * 2 + (h)) * HTB)
#define PG8_STAGE(bufoff, gbase, voff) do { _Pragma("unroll") for (int _i = 0; _i < 2; ++_i) \
        __builtin_amdgcn_global_load_lds((const unsigned*)((const char*)(gbase) + (voff)[_i]), (PG8_LAS unsigned*)(lds + (bufoff) + ldsw + _i * 8192), 16, 0, 0); } while (0)
#define PG8_LDA(dst, b, h) do { _Pragma("unroll") for (int m = 0; m < 4; ++m) _Pragma("unroll") for (int k = 0; k < 2; ++k) dst[m][k] = *(const PG8_LAS bf16x8*)(lds + PG8_SA(b, h) + aoff + m * 2048 + k * 1024); } while (0)
#define PG8_LDB(dst, b, h) do { _Pragma("unroll") for (int n = 0; n < 2; ++n) _Pragma("unroll") for (int k = 0; k < 2; ++k) dst[n][k] = *(const PG8_LAS bf16x8*)(lds + PG8_SB(b, h) + boff + n * 2048 + k * 1024); } while (0)
#define PG8_MMA(ai, bj, At, Bt) do { __builtin_amdgcn_s_setprio(1); _Pragma("unroll") for (int m = 0; m < 4; ++m) _Pragma("unroll") for (int n = 0; n < 2; ++n) _Pragma("unroll") for (int k = 0; k < 2; ++k) \
        acc[ai][bj][m][n] = __builtin_amdgcn_mfma_f32_16x16x32_bf16(Bt[n][k], At[m][k], acc[ai][bj][m][n], 0, 0, 0); __builtin_amdgcn_s_setprio(0); } while (0)
#define PG8_WAIT_V(n) asm volatile("s_waitcnt vmcnt(" #n ")" ::: "memory")
#define PG8_WAIT_L(n) asm volatile("s_waitcnt lgkmcnt(" #n ")" ::: "memory")
#define PG8_BAR __builtin_amdgcn_s_barrier()
#define PG8_SCHED __builtin_amdgcn_sched_barrier(0)
    Unit cur, nxt; int ui = 0;
    if (!S.next(0, cur)) return;
    f32x4 acc[2][2][4][2];
#pragma unroll
    for (int a = 0; a < 2; ++a)
#pragma unroll
        for (int b = 0; b < 2; ++b)
#pragma unroll
            for (int m = 0; m < 4; ++m)
#pragma unroll
                for (int n = 0; n < 2; ++n) acc[a][b][m][n] = (f32x4){0.f, 0.f, 0.f, 0.f};
    bf16x8 At[4][2], B0[2][2], B1[2][2];
    const char* cA = (const char*)g.A + g.a_off(cur.pm); const char* cB = (const char*)g.Bt + (size_t)cur.pn * tstepB;
    S.a_ready(cur);
    if constexpr (SP2) {
        PG8_STAGE(PG8_SB(0, 0), cB, voffB); PG8_STAGE(PG8_SB(0, 1), cB + hstepB, voffB); PG8_STAGE(PG8_SA(0, 0), cA, voffA); PG8_STAGE(PG8_SA(0, 1), cA + hstepA, voffA);
        if (wr == 1) PG8_BAR;
        PG8_WAIT_V(2); PG8_BAR;
        PG8_STAGE(PG8_SB(1, 0), cB + kstep, voffB); PG8_STAGE(PG8_SA(1, 0), cA + kstep, voffA); PG8_STAGE(PG8_SB(1, 1), cB + hstepB + kstep, voffB);
        PG8_WAIT_V(6); PG8_BAR;
    } else {
        PG8_STAGE(PG8_SB(0, 0), cB, voffB); PG8_STAGE(PG8_SA(0, 0), cA, voffA); PG8_STAGE(PG8_SB(0, 1), cB + hstepB, voffB); PG8_STAGE(PG8_SA(0, 1), cA + hstepA, voffA);
        if (wr == 1) PG8_BAR;
        PG8_WAIT_V(4); PG8_BAR;
        PG8_STAGE(PG8_SB(1, 0), cB + kstep, voffB); PG8_STAGE(PG8_SA(1, 0), cA + kstep, voffA); PG8_STAGE(PG8_SB(1, 1), cB + hstepB + kstep, voffB);
        PG8_WAIT_V(6); PG8_BAR;
    }
    for (;;) {
        const bool has_next = S.next(ui + 1, nxt);
        const char* nA = has_next ? (const char*)g.A + g.a_off(nxt.pm) : cA; const char* nB = has_next ? (const char*)g.Bt + (size_t)nxt.pn * tstepB : cB;
        for (int t = 0; t < nt; t += 2) {
            const bool last = (t == nt - 2);
            const char* a1 = cA + (size_t)(t + 1) * kstep;
            const char* a2 = last ? nA : cA + (size_t)(t + 2) * kstep; const char* b2 = last ? nB : cB + (size_t)(t + 2) * kstep;
            const char* a3 = a2 + kstep; const char* b3 = b2 + kstep;
            if (last && has_next) S.a_ready(nxt);
            if constexpr (SP2) {
            PG8_LDB(B0, 0, 0); PG8_LDB(B1, 0, 1); PG8_SCHED; PG8_LDA(At, 0, 0); PG8_STAGE(PG8_SA(1, 1), a1 + hstepA, voffA);
            PG8_WAIT_V(8); PG8_WAIT_L(0); PG8_BAR; PG8_MMA(0, 0, At, B0); PG8_MMA(0, 1, At, B1); PG8_BAR; PG8_SCHED;
            PG8_LDA(At, 0, 1); PG8_STAGE(PG8_SB(0, 0), b2, voffB); PG8_STAGE(PG8_SB(0, 1), b2 + hstepB, voffB); PG8_STAGE(PG8_SA(0, 0), a2, voffA);
            PG8_WAIT_V(8); PG8_WAIT_L(0); PG8_BAR; PG8_MMA(1, 0, At, B0); PG8_MMA(1, 1, At, B1); PG8_BAR; PG8_SCHED;
            PG8_LDB(B0, 1, 0); PG8_LDB(B1, 1, 1); PG8_SCHED; PG8_LDA(At, 1, 0); PG8_STAGE(PG8_SA(0, 1), a2 + hstepA, voffA);
            PG8_WAIT_V(8); PG8_WAIT_L(0); PG8_BAR; PG8_MMA(0, 0, At, B0); PG8_MMA(0, 1, At, B1); PG8_BAR; PG8_SCHED;
            PG8_LDA(At, 1, 1); PG8_STAGE(PG8_SB(1, 0), b3, voffB); PG8_STAGE(PG8_SB(1, 1), b3 + hstepB, voffB); PG8_STAGE(PG8_SA(1, 0), a3, voffA);
            PG8_WAIT_V(8); PG8_WAIT_L(0); PG8_BAR; PG8_MMA(1, 0, At, B0); PG8_MMA(1, 1, At, B1); PG8_BAR; PG8_SCHED;
            } else {
            PG8_LDB(B0, 0, 0); PG8_SCHED; PG8_LDA(At, 0, 0); PG8_STAGE(PG8_SA(1, 1), a1 + hstepA, voffA);
            PG8_WAIT_L(8); PG8_BAR; PG8_WAIT_L(0); PG8_MMA(0, 0, At, B0); PG8_BAR; PG8_SCHED;
            PG8_LDB(B1, 0, 1); PG8_STAGE(PG8_SB(0, 0), b2, voffB);
            PG8_BAR; PG8_WAIT_L(0); PG8_MMA(0, 1, At, B1); PG8_BAR;
            PG8_LDA(At, 0, 1); PG8_STAGE(PG8_SA(0, 0), a2, voffA);
            PG8_BAR; PG8_WAIT_L(0); PG8_MMA(1, 0, At, B0); PG8_BAR; PG8_SCHED;
            PG8_STAGE(PG8_SB(0, 1), b2 + hstepB, voffB);
            PG8_WAIT_V(6); PG8_BAR; PG8_MMA(1, 1, At, B1); PG8_BAR;
            PG8_LDB(B0, 1, 0); PG8_SCHED; PG8_LDA(At, 1, 0); PG8_STAGE(PG8_SA(0, 1), a2 + hstepA, voffA);
            PG8_WAIT_L(8); PG8_BAR; PG8_WAIT_L(0); PG8_MMA(0, 0, At, B0); PG8_BAR; PG8_SCHED;
            PG8_LDB(B1, 1, 1); PG8_STAGE(PG8_SB(1, 0), b3, voffB);
            PG8_BAR; PG8_WAIT_L(0); PG8_MMA(0, 1, At, B1); PG8_BAR;
            PG8_LDA(At, 1, 1); PG8_STAGE(PG8_SA(1, 0), a3, voffA);
            PG8_BAR; PG8_WAIT_L(0); PG8_MMA(1, 0, At, B0); PG8_BAR; PG8_SCHED;
            PG8_STAGE(PG8_SB(1, 1), b3 + hstepB, voffB);
            PG8_WAIT_V(6); PG8_BAR; PG8_MMA(1, 1, At, B1); PG8_BAR;
            }
        }
        if constexpr (ALIGN_EPI) { if (wr == 0) PG8_BAR; }
        if constexpr (!Epi::AFTER_DRAIN) { E(acc, cur, wr, wc, fr, fq); S.done(cur); }
        if (!has_next) break;
#pragma unroll
        for (int a = 0; a < 2; ++a)
#pragma unroll
            for (int b = 0; b < 2; ++b)
#pragma unroll
                for (int m = 0; m < 4; ++m)
#pragma unroll
                    for (int n = 0; n < 2; ++n) acc[a][b][m][n] = (f32x4){0.f, 0.f, 0.f, 0.f};
        cur = nxt; cA = nA; cB = nB; ++ui;
        if constexpr (ALIGN_EPI) { if (wr == 1) PG8_BAR; }
    }
    PG8_WAIT_V(0);
    if constexpr (!ALIGN_EPI) { if (wr == 0) PG8_BAR; }
    PG8_BAR;
    if constexpr (Epi::AFTER_DRAIN) { E.fused(acc, cur, wr, wc, fr, fq, lds, wid, lane); S.done(cur); }
#undef PG8_SA
#undef PG8_SB
#undef PG8_STAGE
#undef PG8_LDA
#undef PG8_LDB
#undef PG8_MMA
#undef PG8_WAIT_V
#undef PG8_WAIT_L
#undef PG8_BAR
#undef PG8_SCHED
}
}
#define LAS __attribute__((address_space(3)))
typedef unsigned short bf16;
typedef short bf16x8 __attribute__((ext_vector_type(8)));
typedef float f32x4 __attribute__((ext_vector_type(4)));
typedef float f32x2 __attribute__((ext_vector_type(2)));
typedef float f32x16 __attribute__((ext_vector_type(16)));
typedef unsigned u32x4 __attribute__((ext_vector_type(4)));
typedef unsigned u32x2 __attribute__((ext_vector_type(2)));
#define MFMA32(a, b, c) __builtin_amdgcn_mfma_f32_32x32x16_bf16((a), (b), (c), 0, 0, 0)

constexpr int NWAVES = 8, NTHR = 512;
constexpr int SEQ = 8192, DM = 1024, MROWS = 16384, FF = 2816;
constexpr float EPS = 1e-6f;
constexpr size_t MiB = 1u << 20;
constexpr size_t WS_MOD = 0;
constexpr size_t WS_W = 1 * MiB;
constexpr size_t W_IN = WS_W, W_OUT = WS_W + 18 * MiB, W_UP = WS_W + 20 * MiB, W_DOWN = WS_W + 31 * MiB;
constexpr size_t WS_XN = 38 * MiB;
constexpr size_t WS_BIG = 70 * MiB;
constexpr size_t A_Q = WS_BIG, A_K = WS_BIG + 48 * MiB, A_VT = WS_BIG + 96 * MiB, A_LSE = WS_BIG + 144 * MiB;
constexpr size_t F_A = WS_BIG, F_U = WS_BIG + 88 * MiB;
constexpr size_t G_Q = WS_BIG, G_K = WS_BIG + 16 * MiB, G_R = WS_BIG + 32 * MiB, G_VT = WS_BIG + 64 * MiB, G_GL = WS_BIG + 96 * MiB, G_DEC = WS_BIG + 97 * MiB, G_ST = WS_BIG + 98 * MiB;
constexpr size_t WS_END = 256 * MiB;
static_assert(G_ST + 64 * MiB <= WS_END && F_U + 88 * MiB <= WS_END && A_LSE + 2 * MiB <= WS_END, "ws map");
constexpr int LDS_BYTES = 147456;

__device__ __forceinline__ float wave_sum(float v) {
#pragma unroll
    for (int o = 1; o < 64; o <<= 1) v += __shfl_xor(v, o);
    return v;
}
__device__ __forceinline__ unsigned pkbf(float lo, float hi) { return pg8::cvt_pk_bf16(lo, hi); }
__device__ __forceinline__ float bflo(unsigned w) { return __uint_as_float(w << 16); }
__device__ __forceinline__ float bfhi(unsigned w) { return __uint_as_float(w & 0xffff0000u); }
__device__ __forceinline__ float silu_f(float x) { return x / (1.0f + __expf(-x)); }
__device__ __forceinline__ int crow(int r, int hi) { return (r & 3) + 8 * (r >> 2) + 4 * hi; }
__device__ __forceinline__ bf16x8 pack8(const f32x16& x, int s) {
    u32x4 p; p.x = pkbf(x[8 * s], x[8 * s + 1]); p.y = pkbf(x[8 * s + 2], x[8 * s + 3]); p.z = pkbf(x[8 * s + 4], x[8 * s + 5]); p.w = pkbf(x[8 * s + 6], x[8 * s + 7]);
    return __builtin_bit_cast(bf16x8, p);
}
__device__ __forceinline__ bf16x8 ld2x8(const bf16* p) {
    const u32x2 a = *(const u32x2*)p, b = *(const u32x2*)(p + 8); u32x4 r; r.x = a.x; r.y = a.y; r.z = b.x; r.w = b.y; return __builtin_bit_cast(bf16x8, r);
}

__device__ __forceinline__ int remap_col(int mode, int n) {
    if (mode == 1) { const int blk = n >> 10, rest = n & 1023, which = blk / 3, g = blk - which * 3; return g * 3072 + which * 1024 + rest; }
    if (mode == 2) { return n < 2048 ? n : (n < 2064 ? 3072 + (n - 2048) : n - 16); }
    return n;
}
__device__ __forceinline__ void transpose_item(const float* W, int K, int N, bf16* WT, int mode, LAS float* scr, int item, int lane) {
    const int nblk = (N + 31) / 32, kb = item / nblk, nb = item % nblk, k0 = 64 * kb, n0 = 32 * nb;
    const int ncol = n0 + (lane & 31); const bool ok = ncol < N;
#pragma unroll 8
    for (int i = 0; i < 32; ++i) { const int kk = 2 * i + (lane >> 5); scr[kk * 33 + (lane & 31)] = ok ? W[(size_t)(k0 + kk) * N + ncol] : 0.f; }
    asm volatile("s_waitcnt lgkmcnt(0)" ::: "memory");
    const int c = lane & 7;
#pragma unroll
    for (int j = 0; j < 4; ++j) { const int n = (lane >> 3) + 8 * j; const LAS float* s = scr + (8 * c) * 33 + n;
        u32x4 o; o.x = pkbf(s[0 * 33], s[1 * 33]); o.y = pkbf(s[2 * 33], s[3 * 33]); o.z = pkbf(s[4 * 33], s[5 * 33]); o.w = pkbf(s[6 * 33], s[7 * 33]);
        if (n0 + n < N) *(u32x4*)(WT + (size_t)remap_col(mode, n0 + n) * K + k0 + 8 * c) = o; }
    asm volatile("s_waitcnt lgkmcnt(0)" ::: "memory");
}
__device__ __forceinline__ void modulate_phase(const float* xin, bf16* xn, const float* gain, const float* shift, const float* scale  , int gw, int ngw, int lane) {
    for (int b = 0; b < 2; ++b) {
        f32x4 A[4], B[4];
#pragma unroll
        for (int j = 0; j < 4; ++j) { const int c = 256 * j + 4 * lane; const f32x4 g = *(const f32x4*)(gain + c), sc = *(const f32x4*)(scale + b * 6144 + c); A[j] = g * (1.0f + sc); B[j] = *(const f32x4*)(shift + b * 6144 + c); }
        for (int m = gw; m < SEQ; m += ngw) {
            const size_t row = (size_t)b * SEQ + m; const f32x4* xr = (const f32x4*)(xin + row * DM) + lane;
            f32x4 v[4]; float s = 0.f;
#pragma unroll
            for (int j = 0; j < 4; ++j) { v[j] = xr[64 * j]; s += (v[j].x * v[j].x + v[j].y * v[j].y) + (v[j].z * v[j].z + v[j].w * v[j].w); }
            const float rs = 1.0f / sqrtf(wave_sum(s) * (1.0f / DM) + EPS);
            u32x2* o8 = (u32x2*)(xn + row * DM) + lane;
#pragma unroll
            for (int j = 0; j < 4; ++j) { const f32x4 y = v[j] * rs * A[j] + B[j]; u32x2 w; w.x = pkbf(y.x, y.y); w.y = pkbf(y.z, y.w); o8[64 * j] = w; }
        }
    }
}
__device__ __forceinline__ void final_norm_phase(const float* xin, float* out, const float* gain, int gw, int ngw, int lane) {
    f32x4 A[4];
#pragma unroll
    for (int j = 0; j < 4; ++j) A[j] = *(const f32x4*)(gain + 256 * j + 4 * lane);
    for (int m = gw; m < MROWS; m += ngw) {
        const f32x4* xr = (const f32x4*)(xin + (size_t)m * DM) + lane; f32x4 v[4]; float s = 0.f;
#pragma unroll
        for (int j = 0; j < 4; ++j) { v[j] = xr[64 * j]; s += (v[j].x * v[j].x + v[j].y * v[j].y) + (v[j].z * v[j].z + v[j].w * v[j].w); }
        const float rs = 1.0f / sqrtf(wave_sum(s) * (1.0f / DM) + EPS);
        f32x4* o = (f32x4*)(out + (size_t)m * DM) + lane;
#pragma unroll
        for (int j = 0; j < 4; ++j) o[64 * j] = v[j] * rs * A[j];
    }
}

__device__ __forceinline__ void attn_phase(bf16* Qg, const bf16* Kg, const bf16* VT, float* LSE, int gw, int ngw, int lane) {
    const int q = lane & 31, hi = lane >> 5;
    for (int u = gw; u < 3 * 16 * 256; u += ngw) {
        const int qt = u & 255, h = (u >> 8) & 15, g = u >> 12;
        const int L = (g == 0) ? 8192 : (g == 1 ? 2048 : 512);
        const int n0 = 32 * qt, m0 = n0 & (L - 1);
        const int kt_lo = (m0 >= 128) ? 0 : ((128 - m0) >> 5);
        bf16* Qp = Qg + ((size_t)g * 8192 + n0 + q) * 1024 + h * 64;
        bf16x8 qf[4];
#pragma unroll
        for (int s = 0; s < 4; ++s) qf[s] = *(const bf16x8*)(Qp + 16 * s + 8 * hi);
        f32x16 S[5];
#pragma unroll
        for (int kt = 0; kt < 5; ++kt) {
            f32x16 acc;
#pragma unroll
            for (int r = 0; r < 16; ++r) acc[r] = 0.f;
            if (kt >= kt_lo) {
                const bf16* Kp = Kg + ((size_t)g * 8192 + (n0 - 128 + 32 * kt) + q) * 1024 + h * 64 + 8 * hi;
#pragma unroll
                for (int s = 0; s < 4; ++s) { const bf16x8 kf = *(const bf16x8*)(Kp + 16 * s); acc = MFMA32(kf, qf[s], acc); }
            }
#pragma unroll
            for (int r = 0; r < 16; ++r) {
                const int kk = crow(r, hi);
                bool valid = kt >= kt_lo;
                if (kt == 0) valid = valid && (kk >= q);
                if (kt == 4) valid = valid && (kk <= q);
                acc[r] = valid ? acc[r] : -1e30f;
            }
            S[kt] = acc;
        }
        float mx = -1e30f;
#pragma unroll
        for (int kt = 0; kt < 5; ++kt)
#pragma unroll
            for (int r = 0; r < 16; ++r) mx = fmaxf(mx, S[kt][r]);
        mx = fmaxf(mx, __shfl_xor(mx, 32));
        const float c2 = 0.125f * 1.4426950408889634f;
        float l = 0.f;
#pragma unroll
        for (int kt = 0; kt < 5; ++kt)
#pragma unroll
            for (int r = 0; r < 16; ++r) { const float p = exp2f((S[kt][r] - mx) * c2); S[kt][r] = p; l += p; }
        l += __shfl_xor(l, 32);
        f32x16 O[2];
#pragma unroll
        for (int r = 0; r < 16; ++r) { O[0][r] = 0.f; O[1][r] = 0.f; }
#pragma unroll
        for (int kt = 0; kt < 5; ++kt) {
            if (kt >= kt_lo) {
#pragma unroll
                for (int jj = 0; jj < 2; ++jj) {
                    const bf16x8 pf = pack8(S[kt], jj);
#pragma unroll
                    for (int et = 0; et < 2; ++et) {
                        const bf16* Vp = VT + ((size_t)g * 1024 + h * 64 + 32 * et + q) * 8192 + (n0 - 128 + 32 * kt) + 16 * jj + 4 * hi;
                        O[et] = MFMA32(ld2x8(Vp), pf, O[et]);
                    }
                }
            }
        }
        const float inv = 1.0f / l;
#pragma unroll
        for (int et = 0; et < 2; ++et)
#pragma unroll
            for (int rg = 0; rg < 4; ++rg) { u32x2 w; w.x = pkbf(O[et][4 * rg] * inv, O[et][4 * rg + 1] * inv); w.y = pkbf(O[et][4 * rg + 2] * inv, O[et][4 * rg + 3] * inv);
                *(u32x2*)(Qp + 32 * et + 8 * rg + 4 * hi) = w; }
        if (hi == 0) LSE[((size_t)g * 8192 + n0 + q) * 16 + h] = mx * 0.125f + __logf(l);
    }
}
__device__ __forceinline__ void combine_phase(const bf16* Qg, const float* LSE, bf16* O  , int gtid, int nthr) {
    for (int i = gtid; i < 8192 * 128; i += nthr) {
        const int t = i >> 7, ch = i & 127, head = ch >> 3;
        int np[3]; np[0] = t; np[1] = (t & 3) * 2048 + (t >> 2); np[2] = (t & 15) * 512 + (t >> 4);
        float ls[3];
#pragma unroll
        for (int g = 0; g < 3; ++g) ls[g] = LSE[((size_t)g * 8192 + np[g]) * 16 + head];
        const float mx = fmaxf(ls[0], fmaxf(ls[1], ls[2]));
        float w[3]; float sw = 0.f;
#pragma unroll
        for (int g = 0; g < 3; ++g) { w[g] = __expf(ls[g] - mx); sw += w[g]; }
        const float isw = 1.0f / sw;
        float acc[8];
#pragma unroll
        for (int e = 0; e < 8; ++e) acc[e] = 0.f;
#pragma unroll
        for (int g = 0; g < 3; ++g) { const u32x4 v = *(const u32x4*)(Qg + ((size_t)g * 8192 + np[g]) * 1024 + 8 * ch); const float wg = w[g] * isw;
            acc[0] += wg * bflo(v.x); acc[1] += wg * bfhi(v.x); acc[2] += wg * bflo(v.y); acc[3] += wg * bfhi(v.y);
            acc[4] += wg * bflo(v.z); acc[5] += wg * bfhi(v.z); acc[6] += wg * bflo(v.w); acc[7] += wg * bfhi(v.w); }
        u32x4 o; o.x = pkbf(acc[0], acc[1]); o.y = pkbf(acc[2], acc[3]); o.z = pkbf(acc[4], acc[5]); o.w = pkbf(acc[6], acc[7]);
        *(u32x4*)(O + (size_t)t * 1024 + 8 * ch) = o;
    }
}

__device__ __forceinline__ void convgate_phase(const bf16* Ab, bf16* Ub, const float* cw, const float* cb, int gtid, int nthr) {
    for (int it = gtid; it < 512 * 352; it += nthr) {
        const int rb = it / 352, ch = it - rb * 352, col = ch * 8, row0 = rb * 32;
        float w0[8], w1[8], w2[8], bb[8], a2[8], a1[8];
#pragma unroll
        for (int e = 0; e < 8; ++e) { w0[e] = cw[col + e]; w1[e] = cw[FF + col + e]; w2[e] = cw[2 * FF + col + e]; bb[e] = cb[col + e]; a2[e] = 0.f; a1[e] = 0.f; }
        if ((row0 & (SEQ - 1)) != 0) {
            const u32x4 p2 = *(const u32x4*)(Ab + (size_t)(row0 - 2) * FF + col), p1 = *(const u32x4*)(Ab + (size_t)(row0 - 1) * FF + col);
            a2[0] = bflo(p2.x); a2[1] = bfhi(p2.x); a2[2] = bflo(p2.y); a2[3] = bfhi(p2.y); a2[4] = bflo(p2.z); a2[5] = bfhi(p2.z); a2[6] = bflo(p2.w); a2[7] = bfhi(p2.w);
            a1[0] = bflo(p1.x); a1[1] = bfhi(p1.x); a1[2] = bflo(p1.y); a1[3] = bfhi(p1.y); a1[4] = bflo(p1.z); a1[5] = bfhi(p1.z); a1[6] = bflo(p1.w); a1[7] = bfhi(p1.w);
        }
#pragma unroll 4
        for (int r = 0; r < 32; ++r) {
            const size_t off = (size_t)(row0 + r) * FF + col;
            const u32x4 pa = *(const u32x4*)(Ab + off), pu = *(const u32x4*)(Ub + off);
            float a[8], uu[8], o[8];
            a[0] = bflo(pa.x); a[1] = bfhi(pa.x); a[2] = bflo(pa.y); a[3] = bfhi(pa.y); a[4] = bflo(pa.z); a[5] = bfhi(pa.z); a[6] = bflo(pa.w); a[7] = bfhi(pa.w);
            uu[0] = bflo(pu.x); uu[1] = bfhi(pu.x); uu[2] = bflo(pu.y); uu[3] = bfhi(pu.y); uu[4] = bflo(pu.z); uu[5] = bfhi(pu.z); uu[6] = bflo(pu.w); uu[7] = bfhi(pu.w);
#pragma unroll
            for (int e = 0; e < 8; ++e) { const float y = w0[e] * a2[e] + w1[e] * a1[e] + w2[e] * a[e] + bb[e]; o[e] = silu_f(y) * uu[e]; a2[e] = a1[e]; a1[e] = a[e]; }
            u32x4 w; w.x = pkbf(o[0], o[1]); w.y = pkbf(o[2], o[3]); w.z = pkbf(o[4], o[5]); w.w = pkbf(o[6], o[7]);
            *(u32x4*)(Ub + off) = w;
        }
    }
}
__device__ __forceinline__ void gla_g3_phase(LAS unsigned char* lds, bf16* Qb, bf16* Kb, const bf16* VT, const float* GL, const float* w_gate, const float* b_gate, float* DEC, bf16* ST, int G) {
    LAS float* Bc = (LAS float*)lds;
    LAS float* SEG = (LAS float*)(lds + 32768);
    LAS bf16* KET = (LAS bf16*)(lds + 36864);
    const int tid = threadIdx.x, lane = tid & 63, wave = tid >> 6, hi = lane >> 5, l31 = lane & 31;
    for (int item = blockIdx.x; item < 1024; item += G) {
        const int h = item & 3, c = (item >> 2) & 127, b = item >> 9; const size_t t0 = (size_t)b * SEQ + 64 * c;
        {
            const int k = tid & 127, jq = tid >> 7;
            float wg[16];
#pragma unroll
            for (int i = 0; i < 16; ++i) wg[i] = w_gate[i * 512 + h * 128 + k];
            const float bg = b_gate[h * 128 + k];
            float run = 0.f;
            for (int jj = 0; jj < 16; ++jj) { const int j = jq * 16 + jj; const float* gp = GL + (t0 + j) * 16; float z = bg;
#pragma unroll
                for (int i = 0; i < 16; ++i) z += gp[i] * wg[i];
                const float ls = fminf(z, 0.f) - log1pf(__expf(-fabsf(z)));
                run += ls * (1.0f / 16.0f); Bc[j * 128 + k] = run; }
            SEG[jq * 128 + k] = run;
            __syncthreads();
            float off = 0.f;
            for (int qq = 0; qq < jq; ++qq) off += SEG[qq * 128 + k];
            for (int jj = 0; jj < 16; ++jj) Bc[(jq * 16 + jj) * 128 + k] += off;
            __syncthreads();
            if (tid < 128) DEC[(size_t)item * 128 + tid] = __expf(Bc[63 * 128 + tid]);
        }
#pragma unroll
        for (int i = 0; i < 2; ++i) { const int idx = tid + 512 * i, j = idx >> 4, kc = (idx & 15) * 8;
            bf16* qp = Qb + (t0 + j) * 512 + h * 128 + kc; bf16* kp = Kb + (t0 + j) * 512 + h * 128 + kc;
            const u32x4 qv = *(const u32x4*)qp, kv = *(const u32x4*)kp;
            float qf[8], kf[8], qd[8], kd[8];
            qf[0] = bflo(qv.x); qf[1] = bfhi(qv.x); qf[2] = bflo(qv.y); qf[3] = bfhi(qv.y); qf[4] = bflo(qv.z); qf[5] = bfhi(qv.z); qf[6] = bflo(qv.w); qf[7] = bfhi(qv.w);
            kf[0] = bflo(kv.x); kf[1] = bfhi(kv.x); kf[2] = bflo(kv.y); kf[3] = bfhi(kv.y); kf[4] = bflo(kv.z); kf[5] = bfhi(kv.z); kf[6] = bflo(kv.w); kf[7] = bfhi(kv.w);
#pragma unroll
            for (int e = 0; e < 8; ++e) { const float bv = Bc[j * 128 + kc + e], bl = Bc[63 * 128 + kc + e];
                qd[e] = qf[e] * 0.08838834764831845f * __expf(bv); kd[e] = kf[e] * __expf(-bv);
                const float ke = kf[e] * __expf(bl - bv); KET[(kc + e) * 72 + j] = (bf16)(pkbf(ke, ke) & 0xffffu); }
            u32x4 qo, ko; qo.x = pkbf(qd[0], qd[1]); qo.y = pkbf(qd[2], qd[3]); qo.z = pkbf(qd[4], qd[5]); qo.w = pkbf(qd[6], qd[7]);
            ko.x = pkbf(kd[0], kd[1]); ko.y = pkbf(kd[2], kd[3]); ko.z = pkbf(kd[4], kd[5]); ko.w = pkbf(kd[6], kd[7]);
            *(u32x4*)qp = qo; *(u32x4*)kp = ko; }
        __syncthreads();
        {
            f32x16 acc[4];
#pragma unroll
            for (int kt = 0; kt < 4; ++kt)
#pragma unroll
                for (int r = 0; r < 16; ++r) acc[kt][r] = 0.f;
            const bf16* Vp = VT + (size_t)(h * 256 + 32 * wave + l31) * MROWS + t0 + 8 * hi;
#pragma unroll
            for (int s = 0; s < 4; ++s) { const bf16x8 vf = *(const bf16x8*)(Vp + 16 * s);
#pragma unroll
                for (int kt = 0; kt < 4; ++kt) { const bf16x8 af = *(const LAS bf16x8*)(KET + (32 * kt + l31) * 72 + 16 * s + 8 * hi); acc[kt] = MFMA32(af, vf, acc[kt]); } }
            bf16* Sp = ST + ((size_t)item * 256 + 32 * wave + l31) * 128;
#pragma unroll
            for (int kt = 0; kt < 4; ++kt)
#pragma unroll
                for (int rg = 0; rg < 4; ++rg) { u32x2 w; w.x = pkbf(acc[kt][4 * rg], acc[kt][4 * rg + 1]); w.y = pkbf(acc[kt][4 * rg + 2], acc[kt][4 * rg + 3]);
                    *(u32x2*)(Sp + 32 * kt + 8 * rg + 4 * hi) = w; }
        }
        __syncthreads();
    }
}
__device__ __forceinline__ void gla_scan_phase(bf16* ST, const float* DEC, int gtid, int nthr) {
    for (int e = gtid; e < 2 * 4 * 256 * 64; e += nthr) {
        const int kp = e & 63, v = (e >> 6) & 255, h = (e >> 14) & 3, b = e >> 16;
        float s0 = 0.f, s1 = 0.f;
#pragma unroll 8
        for (int c = 0; c < 128; ++c) { const size_t item = (size_t)(b * 128 + c) * 4 + h;
            unsigned* p = (unsigned*)(ST + (item * 256 + v) * 128 + 2 * kp); const unsigned ds = *p; const f32x2 dc = *(const f32x2*)(DEC + item * 128 + 2 * kp);
            *p = pkbf(s0, s1); s0 = dc.x * s0 + bflo(ds); s1 = dc.y * s1 + bfhi(ds); }
    }
}
__device__ __forceinline__ void gla_g5_phase(LAS unsigned char* lds, const bf16* Qb, const bf16* Kb, const bf16* VT, const bf16* Rb, const bf16* ST, const float* gain, bf16* O, int G) {
    LAS float* red = (LAS float*)lds;
    const int tid = threadIdx.x, lane = tid & 63, wave = tid >> 6, hi = lane >> 5, l31 = lane & 31;
    const int it = wave & 1, vp = wave >> 1;
    for (int item = blockIdx.x; item < 1024; item += G) {
        const int h = item & 3, c = (item >> 2) & 127, b = item >> 9; const size_t t0 = (size_t)b * SEQ + 64 * c;
        bf16x8 qf[8];
        const bf16* Qp = Qb + (t0 + 32 * it + l31) * 512 + h * 128 + 8 * hi;
#pragma unroll
        for (int s = 0; s < 8; ++s) qf[s] = *(const bf16x8*)(Qp + 16 * s);
        f32x16 AT[2];
#pragma unroll
        for (int jt = 0; jt < 2; ++jt) {
            f32x16 acc;
#pragma unroll
            for (int r = 0; r < 16; ++r) acc[r] = 0.f;
            if (jt <= it) {
                const bf16* Kp = Kb + (t0 + 32 * jt + l31) * 512 + h * 128 + 8 * hi;
#pragma unroll
                for (int s = 0; s < 8; ++s) { const bf16x8 kf = *(const bf16x8*)(Kp + 16 * s); acc = MFMA32(kf, qf[s], acc); }
                if (jt == it) {
#pragma unroll
                    for (int r = 0; r < 16; ++r) acc[r] = (crow(r, hi) <= l31) ? acc[r] : 0.f;
                }
            }
            AT[jt] = acc;
        }
        f32x16 Oa[2];
#pragma unroll
        for (int vt = 0; vt < 2; ++vt) {
            f32x16 acc;
#pragma unroll
            for (int r = 0; r < 16; ++r) acc[r] = 0.f;
            const int vcol = 32 * (2 * vp + vt) + l31;
#pragma unroll
            for (int jt = 0; jt < 2; ++jt) {
                if (jt <= it) {
#pragma unroll
                    for (int jj = 0; jj < 2; ++jj) { const bf16* Vp = VT + (size_t)(h * 256 + vcol) * MROWS + t0 + 32 * jt + 16 * jj + 4 * hi; acc = MFMA32(ld2x8(Vp), pack8(AT[jt], jj), acc); }
                }
            }
            const bf16* Sp = ST + ((size_t)item * 256 + vcol) * 128 + 8 * hi;
#pragma unroll
            for (int s = 0; s < 8; ++s) { const bf16x8 sf = *(const bf16x8*)(Sp + 16 * s); acc = MFMA32(sf, qf[s], acc); }
            Oa[vt] = acc;
        }
        float ss = 0.f;
#pragma unroll
        for (int vt = 0; vt < 2; ++vt)
#pragma unroll
            for (int r = 0; r < 16; ++r) ss += Oa[vt][r] * Oa[vt][r];
        ss += __shfl_xor(ss, 32);
        if (hi == 0) red[vp * 64 + 32 * it + l31] = ss;
        __syncthreads();
        const float tot = (red[32 * it + l31] + red[64 + 32 * it + l31]) + (red[128 + 32 * it + l31] + red[192 + 32 * it + l31]);
        const float rs = 1.0f / sqrtf(tot * (1.0f / 256.0f) + EPS);
        const size_t row = t0 + 32 * it + l31;
#pragma unroll
        for (int vt = 0; vt < 2; ++vt)
#pragma unroll
            for (int rg = 0; rg < 4; ++rg) { const int vb = 32 * (2 * vp + vt) + 8 * rg + 4 * hi;
                const f32x4 gn = *(const f32x4*)(gain + vb); const u32x2 rr = *(const u32x2*)(Rb + row * 1024 + h * 256 + vb);
                const float o0 = Oa[vt][4 * rg] * rs * gn.x * silu_f(bflo(rr.x)), o1 = Oa[vt][4 * rg + 1] * rs * gn.y * silu_f(bfhi(rr.x));
                const float o2 = Oa[vt][4 * rg + 2] * rs * gn.z * silu_f(bflo(rr.y)), o3 = Oa[vt][4 * rg + 3] * rs * gn.w * silu_f(bfhi(rr.y));
                u32x2 w; w.x = pkbf(o0, o1); w.y = pkbf(o2, o3); *(u32x2*)(O + row * 1024 + h * 256 + vb) = w; }
        __syncthreads();
    }
}

struct Params {
    const float *x, *c, *w_ada, *b_ada, *norm_mix, *norm_ffn, *attn_w_in, *attn_w_out, *gla_w_in, *gla_w_gate, *gla_b_gate, *gla_norm, *gla_w_out,
                *ffn_w_up, *ffn_conv_w, *ffn_conv_b, *ffn_w_down, *norm_final;
    float* out; unsigned char* ws;
};

typedef const __attribute__((address_space(4))) Params* kparams_t;
__device__ __forceinline__ kparams_t kp() { kparams_t q = (kparams_t)__builtin_amdgcn_kernarg_segment_ptr(); asm volatile("" : "+s"(q)); return q; }
#define PHASE_IDX int z_; asm volatile("s_mov_b32 %0, 0" : "=s"(z_)); const int tid = (int)threadIdx.x + z_, lane = tid & 63, wave = __builtin_amdgcn_readfirstlane(tid >> 6); \
    const int G = gridDim.x, bid = (int)blockIdx.x + z_, gw = bid * NWAVES + wave, ngw = G * NWAVES, gtid = bid * NTHR + tid, nthr = G * NTHR; \
    unsigned char* ws = kp()->ws; (void)lane; (void)gw; (void)ngw; (void)gtid; (void)nthr; (void)ws;
#define GSYNC() do { asm volatile("s_waitcnt vmcnt(0) lgkmcnt(0)" ::: "memory"); cg::this_grid().sync(); asm volatile("" ::: "memory"); } while (0)
#define LDSP ((LAS unsigned char*)lds_raw)

template <class Epi>
__device__ __forceinline__ void run_gemm(LAS unsigned char* lds, const bf16* A, const bf16* Bt, int M, int N, int K, int dil, int L, int rot, const Epi& E) {
    pg8::Gemm g{A, Bt, M, N, K, dil, L}; pg8::StaticOrder S; const int G = gridDim.x; S.init(M, N, G, (int)((blockIdx.x + rot) % G));
    pg8::gemm_phase<Epi, pg8::StaticOrder, true, true>((PG8_LAS unsigned char*)lds, g, S, E);
}

#define FFN_BLOCK(layer) do { \
    { PHASE_IDX; const float* ml = (const float*)(ws + WS_MOD) + (size_t)(layer) * 2 * 6144; \
      modulate_phase(kp()->out, (bf16*)(ws + WS_XN), kp()->norm_ffn + (layer) * DM, ml + 3 * 1024, ml + 4 * 1024, gw, ngw, lane); } \
    GSYNC(); \
    { unsigned char* ws = kp()->ws; pg8::EpiUp E{(bf16*)(ws + F_A), (bf16*)(ws + F_U)}; run_gemm(LDSP, (const bf16*)(ws + WS_XN), (const bf16*)(ws + W_UP), MROWS, 2 * FF, DM, 1, MROWS, 0, E); } \
    GSYNC(); \
    { PHASE_IDX; convgate_phase((const bf16*)(ws + F_A), (bf16*)(ws + F_U), kp()->ffn_conv_w + (size_t)(layer) * 3 * FF, kp()->ffn_conv_b + (size_t)(layer) * FF, gtid, nthr); } \
    GSYNC(); \
    { unsigned char* ws = kp()->ws; float* o = kp()->out; pg8::EpiRes E{o, o, (const float*)(ws + WS_MOD) + (size_t)(layer) * 2 * 6144 + 5 * 1024}; \
      run_gemm(LDSP, (const bf16*)(ws + F_U), (const bf16*)(ws + W_DOWN), MROWS, DM, FF, 1, MROWS, 0, E); } \
    GSYNC(); } while (0)

__global__ void __launch_bounds__(NTHR, 2) fwd_kernel(Params p_unused) {
    extern __shared__ __attribute__((aligned(16))) unsigned char lds_raw[];
    {
        PHASE_IDX;
        LAS unsigned char* lds = LDSP;
        float* mod = (float*)(ws + WS_MOD);
        LAS float* scr = (LAS float*)(lds + wave * 16384);
        LAS float* red = (LAS float*)(lds + 131072);
        const float* cvec = kp()->c; const float* b_ada = kp()->b_ada;
        for (int it = bid; it < 192; it += G) {
            const int layer = it / 96, ch = it % 96, n = ch * 64 + lane;
            const float* W = kp()->w_ada + (size_t)layer * 1024 * 6144;
            float a0 = 0.f, a1 = 0.f;
#pragma unroll 8
            for (int kk = 0; kk < 128; ++kk) { const int k = wave * 128 + kk; const float wv = W[(size_t)k * 6144 + n]; a0 += silu_f(cvec[k]) * wv; a1 += silu_f(cvec[1024 + k]) * wv; }
            red[(wave * 2 + 0) * 64 + lane] = a0; red[(wave * 2 + 1) * 64 + lane] = a1;
            __syncthreads();
            if (wave == 0) { float t0 = b_ada[layer * 6144 + n], t1 = t0;
                for (int w = 0; w < 8; ++w) { t0 += red[(w * 2) * 64 + lane]; t1 += red[(w * 2 + 1) * 64 + lane]; }
                mod[(size_t)(layer * 2 + 0) * 6144 + n] = t0; mod[(size_t)(layer * 2 + 1) * 6144 + n] = t1; }
            __syncthreads();
        }
        constexpr int I_IN = 16 * 288, I_O = 16 * 32, I_UP = 16 * 176, I_DN = 44 * 32;
        for (int it = gw; it < I_IN + I_O + I_UP + I_DN; it += ngw) {
            int r = it;
            if (r < I_IN) { transpose_item(kp()->attn_w_in, 1024, 9216, (bf16*)(ws + W_IN), 1, scr, r, lane); continue; } r -= I_IN;
            if (r < I_O) { transpose_item(kp()->attn_w_out, 1024, 1024, (bf16*)(ws + W_OUT), 0, scr, r, lane); continue; } r -= I_O;
            if (r < I_UP) { transpose_item(kp()->ffn_w_up, 1024, 2 * FF, (bf16*)(ws + W_UP), 0, scr, r, lane); continue; } r -= I_UP;
            transpose_item(kp()->ffn_w_down, FF, 1024, (bf16*)(ws + W_DOWN), 0, scr, r, lane);
        }
    }
    GSYNC();
#if STAGE >= 1
    { PHASE_IDX; const float* mod = (const float*)(ws + WS_MOD); modulate_phase(kp()->x, (bf16*)(ws + WS_XN), kp()->norm_mix, mod + 0 * 1024, mod + 1 * 1024, gw, ngw, lane); }
    GSYNC();
    for (int b = 0; b < 2; ++b) {
        for (int g = 0; g < 3; ++g) {
            unsigned char* ws = kp()->ws;
            const int dil = (g == 0) ? 1 : (g == 1 ? 4 : 16);
            pg8::EpiAttn E{(bf16*)(ws + A_Q) + (size_t)g * 8192 * 1024, (bf16*)(ws + A_K) + (size_t)g * 8192 * 1024, (bf16*)(ws + A_VT) + (size_t)g * 8192 * 1024};
            run_gemm(LDSP, (const bf16*)(ws + WS_XN) + (size_t)b * SEQ * DM, (const bf16*)(ws + W_IN) + (size_t)g * 3072 * 1024, SEQ, 3072, DM, dil, SEQ / dil, g * 128, E);
        }
        GSYNC();
        { PHASE_IDX; attn_phase((bf16*)(ws + A_Q), (const bf16*)(ws + A_K), (const bf16*)(ws + A_VT), (float*)(ws + A_LSE), gw, ngw, lane); }
        GSYNC();
        { PHASE_IDX; combine_phase((const bf16*)(ws + A_Q), (const float*)(ws + A_LSE), (bf16*)(ws + WS_XN) + (size_t)b * SEQ * DM, gtid, nthr); }
        GSYNC();
    }
    { unsigned char* ws = kp()->ws; pg8::EpiRes E{kp()->x, kp()->out, (const float*)(ws + WS_MOD) + 2 * 1024}; run_gemm(LDSP, (const bf16*)(ws + WS_XN), (const bf16*)(ws + W_OUT), MROWS, DM, DM, 1, MROWS, 0, E); }
    GSYNC();
#endif
#if STAGE >= 2
    FFN_BLOCK(0);
#endif
#if STAGE >= 3
    {
        {
            PHASE_IDX;
            const float* ml = (const float*)(ws + WS_MOD) + (size_t)2 * 6144;
            modulate_phase(kp()->out, (bf16*)(ws + WS_XN), kp()->norm_mix + DM, ml + 0 * 1024, ml + 1 * 1024, gw, ngw, lane);
            LAS float* scr = (LAS float*)(LDSP + wave * 16384);
            constexpr int I_IN = 16 * 97, I_O = 16 * 32, I_UP = 16 * 176, I_DN = 44 * 32;
            for (int it = gw; it < I_IN + I_O + I_UP + I_DN; it += ngw) {
                int r = it;
                if (r < I_IN) { transpose_item(kp()->gla_w_in, 1024, 3088, (bf16*)(ws + W_IN), 2, scr, r, lane); continue; } r -= I_IN;
                if (r < I_O) { transpose_item(kp()->gla_w_out, 1024, 1024, (bf16*)(ws + W_OUT), 0, scr, r, lane); continue; } r -= I_O;
                if (r < I_UP) { transpose_item(kp()->ffn_w_up + (size_t)1024 * 2 * FF, 1024, 2 * FF, (bf16*)(ws + W_UP), 0, scr, r, lane); continue; } r -= I_UP;
                transpose_item(kp()->ffn_w_down + (size_t)FF * 1024, FF, 1024, (bf16*)(ws + W_DOWN), 0, scr, r, lane);
            }
            for (int i = gtid; i < 240 * 1024 / 8; i += nthr) ((u32x4*)(ws + W_IN + (size_t)3088 * 1024 * 2))[i] = (u32x4){0u, 0u, 0u, 0u};
        }
        GSYNC();
        { unsigned char* ws = kp()->ws; pg8::EpiGla E{(bf16*)(ws + G_Q), (bf16*)(ws + G_K), (bf16*)(ws + G_VT), (bf16*)(ws + G_R), (float*)(ws + G_GL)};
          run_gemm(LDSP, (const bf16*)(ws + WS_XN), (const bf16*)(ws + W_IN), MROWS, 3328, DM, 1, MROWS, 0, E); }
        GSYNC();
        { PHASE_IDX; gla_g3_phase(LDSP, (bf16*)(ws + G_Q), (bf16*)(ws + G_K), (const bf16*)(ws + G_VT), (const float*)(ws + G_GL), kp()->gla_w_gate, kp()->gla_b_gate, (float*)(ws + G_DEC), (bf16*)(ws + G_ST), G); }
        GSYNC();
        { PHASE_IDX; gla_scan_phase((bf16*)(ws + G_ST), (const float*)(ws + G_DEC), gtid, nthr); }
        GSYNC();
        { PHASE_IDX; gla_g5_phase(LDSP, (const bf16*)(ws + G_Q), (const bf16*)(ws + G_K), (const bf16*)(ws + G_VT), (const bf16*)(ws + G_R), (const bf16*)(ws + G_ST), kp()->gla_norm, (bf16*)(ws + WS_XN), G); }
        GSYNC();
        { unsigned char* ws = kp()->ws; float* o = kp()->out; pg8::EpiRes E{o, o, (const float*)(ws + WS_MOD) + (size_t)2 * 6144 + 2 * 1024}; run_gemm(LDSP, (const bf16*)(ws + WS_XN), (const bf16*)(ws + W_OUT), MROWS, DM, DM, 1, MROWS, 0, E); }
        GSYNC();
    }
#endif
#if STAGE >= 4
    FFN_BLOCK(1);
#endif
    { PHASE_IDX;
#if STAGE >= 1
      final_norm_phase(kp()->out, kp()->out, kp()->norm_final, gw, ngw, lane);
#else
      final_norm_phase(kp()->x, kp()->out, kp()->norm_final, gw, ngw, lane);
#endif
    }
}

extern "C" void kernel_launch(void* const* d_in, const int* in_sizes, int n_in, void* d_out, int out_size, void* d_ws, size_t ws_size, hipStream_t stream) {
    static int grid = 0;
    if (grid == 0) {
        if (n_in != 18 || ws_size < WS_END) { fprintf(stderr, "kernel_launch: unexpected n_in %d / ws_size %zu\n", n_in, ws_size); grid = -1; return; }
        int dev = 0, cus = 0, per_cu = 0;
        hipGetDevice(&dev);
        hipDeviceGetAttribute(&cus, hipDeviceAttributeMultiprocessorCount, dev);
        hipFuncSetAttribute((const void*)fwd_kernel, hipFuncAttributeMaxDynamicSharedMemorySize, LDS_BYTES);
        hipOccupancyMaxActiveBlocksPerMultiprocessor(&per_cu, (const void*)fwd_kernel, NTHR, LDS_BYTES);
        if (per_cu < 1) { fprintf(stderr, "kernel_launch: occupancy query says %d blocks per CU\n", per_cu); grid = -1; return; }
        grid = cus;
    }
    if (grid < 0) return;
    Params p{};
    const float** pp = (const float**)&p;
    for (int i = 0; i < 18; ++i) pp[i] = (const float*)d_in[i];
    p.out = (float*)d_out; p.ws = (unsigned char*)d_ws;
    void* args[] = {&p};
    hipError_t e = hipLaunchCooperativeKernel((const void*)fwd_kernel, dim3(grid), dim3(NTHR), args, LDS_BYTES, stream);
    if (e != hipSuccess) fprintf(stderr, "cooperative launch failed: %s (grid %d)\n", hipGetErrorString(e), grid);
}
```

```cpp
#include <hip/hip_runtime.h>
#include <hip/hip_cooperative_groups.h>
#include <cstdio>
#include <cstdint>
namespace cg = cooperative_groups;
#ifndef STAGE
#define STAGE 4
#endif
namespace pg8 {
#define PG8_LAS __attribute__((address_space(3)))
typedef unsigned short bf16_t;
typedef short bf16x8 __attribute__((ext_vector_type(8)));
typedef float f32x4 __attribute__((ext_vector_type(4)));
typedef unsigned u32x4 __attribute__((ext_vector_type(4)));
constexpr int BM = 256, BK = 64, HALF = 128, HTB = HALF * BK * 2  , STAGE_BYTES = 8 * HTB, NXCD = 8, WGM = 8;

__host__ __device__ __forceinline__ int lds_byte(int r, int c) { const int st = (r >> 4) * 2 + (c >> 5), rr = r & 15, cc = c & 31, ob = rr * 64 + cc * 2; return st * 1024 + (ob ^ (((ob >> 9) & 1) << 5)); }
__host__ __device__ __forceinline__ void stage_rc(int b, int& R, int& C) { const int st = b / 1024, sb = b % 1024, swz = sb ^ (((sb >> 9) & 1) << 5); R = (st >> 1) * 16 + swz / 64; C = (st & 1) * 32 + (swz % 64) / 2; }
__host__ __device__ __forceinline__ int perm32(int rho) { const int n = rho >> 4, i = rho & 15; return 8 * (i >> 2) + 4 * n + (i & 3); }

struct Unit { int pm, pn; };
struct Gemm { const bf16_t* A; const bf16_t* Bt; int M, N, K; int dil, L;
    __device__ __forceinline__ size_t a_off(int pm) const { const int n0 = pm * 256; return (size_t)((n0 / L) + dil * (n0 % L)) * (size_t)K * 2; } };

struct StaticOrder {
    int nM, nN, nwg, G, c;
    __host__ __device__ void init(int M, int N, int G_, int c_) { nM = M / BM; nN = N / BM; nwg = nM * nN; G = G_; c = c_; }
    __host__ __device__ bool next(int i, Unit& u) const {
        const long L = (long)i * G + c; if (L >= nwg) return false;
        int wgid = (int)L; { const int q = nwg / NXCD, r = nwg % NXCD, xcd = wgid % NXCD, off = wgid / NXCD; wgid = (xcd < r ? xcd * (q + 1) : r * (q + 1) + (xcd - r) * q) + off; }
        const int nig = WGM * nN, gid = wgid / nig, fm = gid * WGM, gsz = (nM - fm) < WGM ? (nM - fm) : WGM;
        u.pm = fm + ((wgid % nig) % gsz); u.pn = (wgid % nig) / gsz; return true;
    }
    __device__ __forceinline__ void a_ready(const Unit&) const {}
    __device__ __forceinline__ void done(const Unit&) const {}
};

typedef unsigned u32x4 __attribute__((ext_vector_type(4)));
typedef float f32x2_t __attribute__((ext_vector_type(2))); typedef __bf16 bf16x2_t __attribute__((ext_vector_type(2)));
__device__ __forceinline__ unsigned cvt_pk_bf16(float lo, float hi) { f32x2_t v = {lo, hi}; bf16x2_t b = __builtin_convertvector(v, bf16x2_t); return __builtin_bit_cast(unsigned, b); }
__device__ __forceinline__ void store_rm_bf16(const f32x4 (&acc)[2][2][4][2], bf16_t* base, int ld, int row0, int col0) {
#pragma unroll
    for (int ai = 0; ai < 2; ++ai)
#pragma unroll
        for (int m = 0; m < 4; ++m) { bf16_t* rowp = base + (size_t)(row0 + ai * HALF + m * 16) * ld + col0;
#pragma unroll
            for (int bj = 0; bj < 2; ++bj) { const f32x4 v0 = acc[ai][bj][m][0], v1 = acc[ai][bj][m][1];
                u32x4 w; w.x = cvt_pk_bf16(v0[0], v0[1]); w.y = cvt_pk_bf16(v0[2], v0[3]); w.z = cvt_pk_bf16(v1[0], v1[1]); w.w = cvt_pk_bf16(v1[2], v1[3]);
                *(u32x4*)(rowp + bj * HALF) = w; } }
}
__device__ __forceinline__ void store_tr_bf16(const f32x4 (&acc)[2][2][4][2], bf16_t* base, size_t pitch, int row0, int col0) {
#pragma unroll
    for (int ai = 0; ai < 2; ++ai)
#pragma unroll
        for (int m = 0; m < 4; ++m) { bf16_t* rp = base + (row0 + ai * HALF + m * 16);
#pragma unroll
            for (int bj = 0; bj < 2; ++bj)
#pragma unroll
                for (int n = 0; n < 2; ++n) { const f32x4 v = acc[ai][bj][m][n]; const unsigned p0 = cvt_pk_bf16(v[0], v[1]), p1 = cvt_pk_bf16(v[2], v[3]);
                    bf16_t* cp = rp + (size_t)(col0 + bj * HALF + 4 * n) * pitch;
                    cp[0] = (bf16_t)(p0 & 0xffffu); cp[pitch] = (bf16_t)(p0 >> 16); cp[2 * pitch] = (bf16_t)(p1 & 0xffffu); cp[3 * pitch] = (bf16_t)(p1 >> 16); } }
}
struct EpiAttn {
    static constexpr bool PERM = true, AFTER_DRAIN = false;
    bf16_t* Q; bf16_t* Kb; bf16_t* VT;
    __device__ __forceinline__ void operator()(const f32x4 (&acc)[2][2][4][2], const Unit& u, int wr, int wc, int fr, int fq) const {
        const int row0 = u.pm * BM + wr * 64 + fr, col0 = (u.pn & 3) * BM + wc * 32 + 8 * fq;
        if (u.pn < 8) store_rm_bf16(acc, u.pn < 4 ? Q : Kb, 1024, row0, col0);
        else store_tr_bf16(acc, VT, 8192, row0, col0);
    }
};
struct EpiGla {
    static constexpr bool PERM = true, AFTER_DRAIN = false;
    bf16_t* Q; bf16_t* Kb; bf16_t* VT; bf16_t* R; float* GL;
    __device__ __forceinline__ void operator()(const f32x4 (&acc)[2][2][4][2], const Unit& u, int wr, int wc, int fr, int fq) const {
        const int row0 = u.pm * BM + wr * 64 + fr, cw = wc * 32 + 8 * fq;
        if (u.pn < 2) store_rm_bf16(acc, Q, 512, row0, u.pn * BM + cw);
        else if (u.pn < 4) store_rm_bf16(acc, Kb, 512, row0, (u.pn - 2) * BM + cw);
        else if (u.pn < 8) store_tr_bf16(acc, VT, 16384, row0, (u.pn - 4) * BM + cw);
        else if (u.pn < 12) store_rm_bf16(acc, R, 1024, row0, (u.pn - 8) * BM + cw);
        else if (wc == 0 && fq < 2) {
#pragma unroll
            for (int ai = 0; ai < 2; ++ai)
#pragma unroll
                for (int m = 0; m < 4; ++m) { float* gp = GL + (size_t)(row0 + ai * HALF + m * 16) * 16 + 8 * fq;
                    *(f32x4*)gp = acc[ai][0][m][0]; *(f32x4*)(gp + 4) = acc[ai][0][m][1]; }
        }
    }
};
struct EpiUp {
    static constexpr bool PERM = true, AFTER_DRAIN = false;
    bf16_t* Ab; bf16_t* Ub;
    __device__ __forceinline__ void operator()(const f32x4 (&acc)[2][2][4][2], const Unit& u, int wr, int wc, int fr, int fq) const {
        const int row0 = u.pm * BM + wr * 64 + fr, cw = wc * 32 + 8 * fq;
        if (u.pn < 11) store_rm_bf16(acc, Ab, 2816, row0, u.pn * BM + cw); else store_rm_bf16(acc, Ub, 2816, row0, (u.pn - 11) * BM + cw);
    }
};
struct EpiRes {
    static constexpr bool PERM = false, AFTER_DRAIN = false;
    const float* base; float* out; const float* gate;
    __device__ __forceinline__ void operator()(const f32x4 (&acc)[2][2][4][2], const Unit& u, int wr, int wc, int fr, int fq) const {
        const int row0 = u.pm * BM + wr * 64 + fr, col0 = u.pn * BM + wc * 32 + 4 * fq;
        const float* gp = gate + (size_t)((u.pm * BM) >> 13) * 6144 + col0;
        f32x4 gv[2][2];
#pragma unroll
        for (int bj = 0; bj < 2; ++bj)
#pragma unroll
            for (int n = 0; n < 2; ++n) gv[bj][n] = *(const f32x4*)(gp + bj * HALF + n * 16);
#pragma unroll
        for (int ai = 0; ai < 2; ++ai)
#pragma unroll
            for (int m = 0; m < 4; ++m) { const size_t off = (size_t)(row0 + ai * HALF + m * 16) * 1024 + col0;
#pragma unroll
                for (int bj = 0; bj < 2; ++bj)
#pragma unroll
                    for (int n = 0; n < 2; ++n) { const f32x4 bs = *(const f32x4*)(base + off + bj * HALF + n * 16);
                        *(f32x4*)(out + off + bj * HALF + n * 16) = bs + gv[bj][n] * acc[ai][bj][m][n]; } }
    }
};
template <class Epi, class Sched, bool ALIGN_EPI = false, bool SP2 = false>
__device__ __forceinline__ void gemm_phase(PG8_LAS unsigned char* lds, const Gemm g, const Sched& S, const Epi& E, const int tid_in) {
    const int tid = tid_in, wid = __builtin_amdgcn_readfirstlane(tid >> 6), lane = tid & 63, wr = wid >> 2, wc = wid & 3, fr = lane & 15, fq = lane >> 4;
    const int K = g.K, nt = K / BK, lda = g.dil * K;
    unsigned voffA[2], voffB[2];
#pragma unroll
    for (int i = 0; i < 2; ++i) { int R, C; stage_rc(tid * 16 + i * 8192, R, C); const int Rb = Epi::PERM ? ((R & ~31) + perm32(R & 31)) : R;
        voffA[i] = (unsigned)(R * lda + C) * 2u; voffB[i] = (unsigned)(Rb * K + C) * 2u; }
    const size_t kstep = (size_t)(BK * 2);
     const size_t hstepA = (size_t)HALF * lda * 2, hstepB = (size_t)HALF * K * 2;
    const size_t tstepB = 2 * hstepB;
    const unsigned ldsw = (unsigned)wid * 1024u;
    const int aoff = lds_byte(wr * 64 + fr, fq * 8), boff = lds_byte(wc * 32 + fr, fq * 8);
#define PG8_SA(b, h) (((b) * 2 + (h)) * HTB)
#define PG8_SB(b, h) ((4 + (b) * 2 + (h)) * HTB)
#define PG8_STAGE(bufoff, gbase, voff) do { _Pragma("unroll") for (int _i = 0; _i < 2; ++_i) \
        __builtin_amdgcn_global_load_lds((const unsigned*)((const char*)(gbase) + (voff)[_i]), (PG8_LAS unsigned*)(lds + (bufoff) + ldsw + _i * 8192), 16, 0, 0); } while (0)
#define PG8_LDA(dst, b, h) do { _Pragma("unroll") for (int m = 0; m < 4; ++m) _Pragma("unroll") for (int k = 0; k < 2; ++k) dst[m][k] = *(const PG8_LAS bf16x8*)(lds + PG8_SA(b, h) + aoff + m * 2048 + k * 1024); } while (0)
#define PG8_LDB(dst, b, h) do { _Pragma("unroll") for (int n = 0; n < 2; ++n) _Pragma("unroll") for (int k = 0; k < 2; ++k) dst[n][k] = *(const PG8_LAS bf16x8*)(lds + PG8_SB(b, h) + boff + n * 2048 + k * 1024); } while (0)
#define PG8_MMA(ai, bj, At, Bt) do { __builtin_amdgcn_s_setprio(1); _Pragma("unroll") for (int m = 0; m < 4; ++m) _Pragma("unroll") for (int n = 0; n < 2; ++n) _Pragma("unroll") for (int k = 0; k < 2; ++k) \
        acc[ai][bj][m][n] = __builtin_amdgcn_mfma_f32_16x16x32_bf16(Bt[n][k], At[m][k], acc[ai][bj][m][n], 0, 0, 0); __builtin_amdgcn_s_setprio(0); } while (0)
#define PG8_WAIT_V(n) asm volatile("s_waitcnt vmcnt(" #n ")" ::: "memory")
#define PG8_WAIT_L(n) asm volatile("s_waitcnt lgkmcnt(" #n ")" ::: "memory")
#define PG8_BAR __builtin_amdgcn_s_barrier()
#define PG8_SCHED __builtin_amdgcn_sched_barrier(0)
    Unit cur, nxt; int ui = 0;
    if (!S.next(0, cur)) return;
    f32x4 acc[2][2][4][2];
#pragma unroll
    for (int a = 0; a < 2; ++a)
#pragma unroll
        for (int b = 0; b < 2; ++b)
#pragma unroll
            for (int m = 0; m < 4; ++m)
#pragma unroll
                for (int n = 0; n < 2; ++n) acc[a][b][m][n] = (f32x4){0.f, 0.f, 0.f, 0.f};
    bf16x8 At[4][2], B0[2][2], B1[2][2];
    const char* cA = (const char*)g.A + g.a_off(cur.pm); const char* cB = (const char*)g.Bt + (size_t)cur.pn * tstepB;
    S.a_ready(cur);
    if constexpr (SP2) {
        PG8_STAGE(PG8_SB(0, 0), cB, voffB); PG8_STAGE(PG8_SB(0, 1), cB + hstepB, voffB); PG8_STAGE(PG8_SA(0, 0), cA, voffA); PG8_STAGE(PG8_SA(0, 1), cA + hstepA, voffA);
        if (wr == 1) PG8_BAR;
        PG8_WAIT_V(2); PG8_BAR;
        PG8_STAGE(PG8_SB(1, 0), cB + kstep, voffB); PG8_STAGE(PG8_SA(1, 0), cA + kstep, voffA); PG8_STAGE(PG8_SB(1, 1), cB + hstepB + kstep, voffB);
        PG8_WAIT_V(6); PG8_BAR;
    } else {
        PG8_STAGE(PG8_SB(0, 0), cB, voffB); PG8_STAGE(PG8_SA(0, 0), cA, voffA); PG8_STAGE(PG8_SB(0, 1), cB + hstepB, voffB); PG8_STAGE(PG8_SA(0, 1), cA + hstepA, voffA);
        if (wr == 1) PG8_BAR;
        PG8_WAIT_V(4); PG8_BAR;
        PG8_STAGE(PG8_SB(1, 0), cB + kstep, voffB); PG8_STAGE(PG8_SA(1, 0), cA + kstep, voffA); PG8_STAGE(PG8_SB(1, 1), cB + hstepB + kstep, voffB);
        PG8_WAIT_V(6); PG8_BAR;
    }
    for (;;) {
        const bool has_next = S.next(ui + 1, nxt);
        const char* nA = has_next ? (const char*)g.A + g.a_off(nxt.pm) : cA; const char* nB = has_next ? (const char*)g.Bt + (size_t)nxt.pn * tstepB : cB;
        for (int t = 0; t < nt; t += 2) {
            const bool last = (t == nt - 2);
            const char* a1 = cA + (size_t)(t + 1) * kstep;
            const char* a2 = last ? nA : cA + (size_t)(t + 2) * kstep; const char* b2 = last ? nB : cB + (size_t)(t + 2) * kstep;
            const char* a3 = a2 + kstep; const char* b3 = b2 + kstep;
            if (last && has_next) S.a_ready(nxt);
            if constexpr (SP2) {
            PG8_LDB(B0, 0, 0); PG8_LDB(B1, 0, 1); PG8_SCHED; PG8_LDA(At, 0, 0); PG8_STAGE(PG8_SA(1, 1), a1 + hstepA, voffA);
            PG8_WAIT_V(8); PG8_WAIT_L(0); PG8_BAR; PG8_MMA(0, 0, At, B0); PG8_MMA(0, 1, At, B1); PG8_BAR; PG8_SCHED;
            PG8_LDA(At, 0, 1); PG8_STAGE(PG8_SB(0, 0), b2, voffB); PG8_STAGE(PG8_SB(0, 1), b2 + hstepB, voffB); PG8_STAGE(PG8_SA(0, 0), a2, voffA);
            PG8_WAIT_V(8); PG8_WAIT_L(0); PG8_BAR; PG8_MMA(1, 0, At, B0); PG8_MMA(1, 1, At, B1); PG8_BAR; PG8_SCHED;
            PG8_LDB(B0, 1, 0); PG8_LDB(B1, 1, 1); PG8_SCHED; PG8_LDA(At, 1, 0); PG8_STAGE(PG8_SA(0, 1), a2 + hstepA, voffA);
            PG8_WAIT_V(8); PG8_WAIT_L(0); PG8_BAR; PG8_MMA(0, 0, At, B0); PG8_MMA(0, 1, At, B1); PG8_BAR; PG8_SCHED;
            PG8_LDA(At, 1, 1); PG8_STAGE(PG8_SB(1, 0), b3, voffB); PG8_STAGE(PG8_SB(1, 1), b3 + hstepB, voffB); PG8_STAGE(PG8_SA(1, 0), a3, voffA);
            PG8_WAIT_V(8); PG8_WAIT_L(0); PG8_BAR; PG8_MMA(1, 0, At, B0); PG8_MMA(1, 1, At, B1); PG8_BAR; PG8_SCHED;
            } else {
            PG8_LDB(B0, 0, 0); PG8_SCHED; PG8_LDA(At, 0, 0); PG8_STAGE(PG8_SA(1, 1), a1 + hstepA, voffA);
            PG8_WAIT_L(8); PG8_BAR; PG8_WAIT_L(0); PG8_MMA(0, 0, At, B0); PG8_BAR; PG8_SCHED;
            PG8_LDB(B1, 0, 1); PG8_STAGE(PG8_SB(0, 0), b2, voffB);
            PG8_BAR; PG8_WAIT_L(0); PG8_MMA(0, 1, At, B1); PG8_BAR;
            PG8_LDA(At, 0, 1); PG8_STAGE(PG8_SA(0, 0), a2, voffA);
            PG8_BAR; PG8_WAIT_L(0); PG8_MMA(1, 0, At, B0); PG8_BAR; PG8_SCHED;
            PG8_STAGE(PG8_SB(0, 1), b2 + hstepB, voffB);
            PG8_WAIT_V(6); PG8_BAR; PG8_MMA(1, 1, At, B1); PG8_BAR;
            PG8_LDB(B0, 1, 0); PG8_SCHED; PG8_LDA(At, 1, 0); PG8_STAGE(PG8_SA(0, 1), a2 + hstepA, voffA);
            PG8_WAIT_L(8); PG8_BAR; PG8_WAIT_L(0); PG8_MMA(0, 0, At, B0); PG8_BAR; PG8_SCHED;
            PG8_LDB(B1, 1, 1); PG8_STAGE(PG8_SB(1, 0), b3, voffB);
            PG8_BAR; PG8_WAIT_L(0); PG8_MMA(0, 1, At, B1); PG8_BAR;
            PG8_LDA(At, 1, 1); PG8_STAGE(PG8_SA(1, 0), a3, voffA);
            PG8_BAR; PG8_WAIT_L(0); PG8_MMA(1, 0, At, B0); PG8_BAR; PG8_SCHED;
            PG8_STAGE(PG8_SB(1, 1), b3 + hstepB, voffB);
            PG8_WAIT_V(6); PG8_BAR; PG8_MMA(1, 1, At, B1); PG8_BAR;
            }
        }
        if constexpr (ALIGN_EPI) { if (wr == 0) PG8_BAR; }
        if constexpr (!Epi::AFTER_DRAIN) { E(acc, cur, wr, wc, fr, fq); S.done(cur); }
        if (!has_next) break;
#pragma unroll
        for (int a = 0; a < 2; ++a)
#pragma unroll
            for (int b = 0; b < 2; ++b)
#pragma unroll
                for (int m = 0; m < 4; ++m)
#pragma unroll
                    for (int n = 0; n < 2; ++n) acc[a][b][m][n] = (f32x4){0.f, 0.f, 0.f, 0.f};
        cur = nxt; cA = nA; cB = nB; ++ui;
        if constexpr (ALIGN_EPI) { if (wr == 1) PG8_BAR; }
    }
    PG8_WAIT_V(0);
    if constexpr (!ALIGN_EPI) { if (wr == 0) PG8_BAR; }
    PG8_BAR;
    if constexpr (Epi::AFTER_DRAIN) { E.fused(acc, cur, wr, wc, fr, fq, lds, wid, lane); S.done(cur); }
#undef PG8_SA
#undef PG8_SB
#undef PG8_STAGE
#undef PG8_LDA
#undef PG8_LDB
#undef PG8_MMA
#undef PG8_WAIT_V
#undef PG8_WAIT_L
#undef PG8_BAR
#undef PG8_SCHED
}
}
#define LAS __attribute__((address_space(3)))
typedef unsigned short bf16;
typedef short bf16x8 __attribute__((ext_vector_type(8)));
typedef float f32x4 __attribute__((ext_vector_type(4)));
typedef float f32x2 __attribute__((ext_vector_type(2)));
typedef float f32x16 __attribute__((ext_vector_type(16)));
typedef unsigned u32x4 __attribute__((ext_vector_type(4)));
typedef unsigned u32x2 __attribute__((ext_vector_type(2)));
#define MFMA32(a, b, c) __builtin_amdgcn_mfma_f32_32x32x16_bf16((a), (b), (c), 0, 0, 0)

constexpr int NWAVES = 8, NTHR = 512;
constexpr int SEQ = 8192, DM = 1024, MROWS = 16384, FF = 2816;
constexpr float EPS = 1e-6f;
constexpr size_t MiB = 1u << 20;
constexpr size_t WS_MOD = 0;
constexpr size_t WS_W = 1 * MiB;
constexpr size_t W_IN = WS_W, W_OUT = WS_W + 18 * MiB, W_UP = WS_W + 20 * MiB, W_DOWN = WS_W + 31 * MiB;
constexpr size_t WS_XN = 38 * MiB;
constexpr size_t WS_BIG = 70 * MiB;
constexpr size_t A_Q = WS_BIG, A_K = WS_BIG + 48 * MiB, A_VT = WS_BIG + 96 * MiB, A_LSE = WS_BIG + 144 * MiB;
constexpr size_t F_A = WS_BIG, F_U = WS_BIG + 88 * MiB;
constexpr size_t G_Q = WS_BIG, G_K = WS_BIG + 16 * MiB, G_R = WS_BIG + 32 * MiB, G_VT = WS_BIG + 64 * MiB, G_GL = WS_BIG + 96 * MiB, G_DEC = WS_BIG + 97 * MiB, G_ST = WS_BIG + 98 * MiB;
constexpr size_t WS_END = 256 * MiB;
static_assert(G_ST + 64 * MiB <= WS_END && F_U + 88 * MiB <= WS_END && A_LSE + 2 * MiB <= WS_END, "ws map");
constexpr int LDS_BYTES = 147456;

__device__ __forceinline__ float wave_sum(float v, int lane) {
#pragma unroll
    for (int o = 1; o < 64; o <<= 1) v += __int_as_float(__builtin_amdgcn_ds_bpermute((lane ^ o) << 2, __float_as_int(v)));
    return v;
}
__device__ __forceinline__ float xor32_max(float v) { auto rr = __builtin_amdgcn_permlane32_swap(__float_as_uint(v), __float_as_uint(v), false, false); return fmaxf(__uint_as_float(rr[0]), __uint_as_float(rr[1])); }
__device__ __forceinline__ float xor32_sum(float v) { auto rr = __builtin_amdgcn_permlane32_swap(__float_as_uint(v), __float_as_uint(v), false, false); return __uint_as_float(rr[0]) + __uint_as_float(rr[1]); }
__device__ __forceinline__ unsigned pkbf(float lo, float hi) { return pg8::cvt_pk_bf16(lo, hi); }
__device__ __forceinline__ float bflo(unsigned w) { return __uint_as_float(w << 16); }
__device__ __forceinline__ float bfhi(unsigned w) { return __uint_as_float(w & 0xffff0000u); }
__device__ __forceinline__ float silu_f(float x) { return x / (1.0f + __expf(-x)); }
__device__ __forceinline__ int crow(int r, int hi) { return (r & 3) + 8 * (r >> 2) + 4 * hi; }
__device__ __forceinline__ bf16x8 pack8(const f32x16& x, int s) {
    u32x4 p; p.x = pkbf(x[8 * s], x[8 * s + 1]); p.y = pkbf(x[8 * s + 2], x[8 * s + 3]); p.z = pkbf(x[8 * s + 4], x[8 * s + 5]); p.w = pkbf(x[8 * s + 6], x[8 * s + 7]);
    return __builtin_bit_cast(bf16x8, p);
}
__device__ __forceinline__ bf16x8 ld2x8(const bf16* p) {
    const u32x2 a = *(const u32x2*)p, b = *(const u32x2*)(p + 8); u32x4 r; r.x = a.x; r.y = a.y; r.z = b.x; r.w = b.y; return __builtin_bit_cast(bf16x8, r);
}

__device__ __forceinline__ int remap_col(int mode, int n) {
    if (mode == 1) { const int blk = n >> 10, rest = n & 1023, which = blk / 3, g = blk - which * 3; return g * 3072 + which * 1024 + rest; }
    if (mode == 2) { return n < 2048 ? n : (n < 2064 ? 3072 + (n - 2048) : n - 16); }
    return n;
}
__device__ __forceinline__ void transpose_item(const float* W, int K, int N, bf16* WT, int mode, LAS float* scr, int item, int lane) {
    const int nblk = (N + 31) / 32, kb = item / nblk, nb = item % nblk, k0 = 64 * kb, n0 = 32 * nb;
    const int ncol = n0 + (lane & 31); const bool ok = ncol < N;
#pragma unroll 8
    for (int i = 0; i < 32; ++i) { const int kk = 2 * i + (lane >> 5); scr[kk * 33 + (lane & 31)] = ok ? W[(size_t)(k0 + kk) * N + ncol] : 0.f; }
    asm volatile("s_waitcnt lgkmcnt(0)" ::: "memory");
    const int c = lane & 7;
#pragma unroll
    for (int j = 0; j < 4; ++j) { const int n = (lane >> 3) + 8 * j; const LAS float* s = scr + (8 * c) * 33 + n;
        u32x4 o; o.x = pkbf(s[0 * 33], s[1 * 33]); o.y = pkbf(s[2 * 33], s[3 * 33]); o.z = pkbf(s[4 * 33], s[5 * 33]); o.w = pkbf(s[6 * 33], s[7 * 33]);
        if (n0 + n < N) *(u32x4*)(WT + (size_t)remap_col(mode, n0 + n) * K + k0 + 8 * c) = o; }
    asm volatile("s_waitcnt lgkmcnt(0)" ::: "memory");
}
__device__ __forceinline__ void modulate_phase(const float* xin, bf16* xn, const float* gain, const float* shift, const float* scale  , int gw, int ngw, int lane) {
    for (int b = 0; b < 2; ++b) {
        f32x4 A[4], B[4];
#pragma unroll
        for (int j = 0; j < 4; ++j) { const int c = 256 * j + 4 * lane; const f32x4 g = *(const f32x4*)(gain + c), sc = *(const f32x4*)(scale + b * 6144 + c); A[j] = g * (1.0f + sc); B[j] = *(const f32x4*)(shift + b * 6144 + c); }
        for (int m = gw; m < SEQ; m += ngw) {
            const size_t row = (size_t)b * SEQ + m; const f32x4* xr = (const f32x4*)(xin + row * DM) + lane;
            f32x4 v[4]; float s = 0.f;
#pragma unroll
            for (int j = 0; j < 4; ++j) { v[j] = xr[64 * j]; s += (v[j].x * v[j].x + v[j].y * v[j].y) + (v[j].z * v[j].z + v[j].w * v[j].w); }
            const float rs = 1.0f / sqrtf(wave_sum(s, lane) * (1.0f / DM) + EPS);
            u32x2* o8 = (u32x2*)(xn + row * DM) + lane;
#pragma unroll
            for (int j = 0; j < 4; ++j) { const f32x4 y = v[j] * rs * A[j] + B[j]; u32x2 w; w.x = pkbf(y.x, y.y); w.y = pkbf(y.z, y.w); o8[64 * j] = w; }
        }
    }
}
__device__ __forceinline__ void final_norm_phase(const float* xin, float* out, const float* gain, int gw, int ngw, int lane) {
    f32x4 A[4];
#pragma unroll
    for (int j = 0; j < 4; ++j) A[j] = *(const f32x4*)(gain + 256 * j + 4 * lane);
    for (int m = gw; m < MROWS; m += ngw) {
        const f32x4* xr = (const f32x4*)(xin + (size_t)m * DM) + lane; f32x4 v[4]; float s = 0.f;
#pragma unroll
        for (int j = 0; j < 4; ++j) { v[j] = xr[64 * j]; s += (v[j].x * v[j].x + v[j].y * v[j].y) + (v[j].z * v[j].z + v[j].w * v[j].w); }
        const float rs = 1.0f / sqrtf(wave_sum(s, lane) * (1.0f / DM) + EPS);
        f32x4* o = (f32x4*)(out + (size_t)m * DM) + lane;
#pragma unroll
        for (int j = 0; j < 4; ++j) o[64 * j] = v[j] * rs * A[j];
    }
}

__device__ __forceinline__ void attn_phase(LAS unsigned char* lds, bf16* Qg, const bf16* Kg, const bf16* VT, float* LSE, int tid, int bid) {
    const int lane = tid & 63, wave = __builtin_amdgcn_readfirstlane(tid >> 6), q = lane & 31, hi = lane >> 5;
    LAS unsigned char* Ks = lds;
    LAS unsigned char* Vs = lds + 55296;
    const int G = gridDim.x;
    u32x4 kreg[6], vreg[6];
#define ATT_LOAD(bu_) do { const int qb_ = (bu_) & 31, h_ = ((bu_) >> 5) & 15, g_ = (bu_) >> 9; const int L_ = (g_ == 0) ? 8192 : (g_ == 1 ? 2048 : 512); \
        const int n0b_ = 256 * qb_; const bool first_ = (n0b_ & (L_ - 1)) == 0; \
        const bf16* Kb_ = Kg + ((size_t)g_ * 8192 + n0b_ - 128) * 1024 + h_ * 64; const bf16* Vb_ = VT + ((size_t)g_ * 1024 + h_ * 64) * 8192 + (n0b_ - 128); \
        _Pragma("unroll") for (int i_ = 0; i_ < 6; ++i_) { const int idx_ = tid + 512 * i_; const int row_ = idx_ >> 3, ch_ = idx_ & 7, e_ = idx_ / 48, cv_ = idx_ - e_ * 48; \
            if (!first_ || row_ >= 128) kreg[i_] = *(const u32x4*)(Kb_ + (size_t)row_ * 1024 + ch_ * 8); \
            if (!first_ || cv_ >= 16) vreg[i_] = *(const u32x4*)(Vb_ + (size_t)e_ * 8192 + cv_ * 8); } } while (0)
    for (int bu = bid; bu < 1536; bu += G) {
        asm volatile("" : "+v"(tid));
        ATT_LOAD(bu);
        const int qb = bu & 31, h = (bu >> 5) & 15, g = bu >> 9;
        const int L = (g == 0) ? 8192 : (g == 1 ? 2048 : 512);
        const int n0 = 256 * qb + 32 * wave, m0 = n0 & (L - 1);
        const int kt_lo = (m0 >= 128) ? 0 : ((128 - m0) >> 5);
        bf16* Qp = Qg + ((size_t)g * 8192 + n0 + q) * 1024 + h * 64;
        bf16x8 qf[4];
#pragma unroll
        for (int s = 0; s < 4; ++s) qf[s] = *(const bf16x8*)(Qp + 16 * s + 8 * hi);
        __syncthreads();
#pragma unroll
        for (int i = 0; i < 6; ++i) { const int idx = tid + 512 * i; const int row = idx >> 3, ch = idx & 7, e = idx / 48, cv = idx - e * 48;
            *(LAS u32x4*)(Ks + row * 144 + ch * 16) = kreg[i]; *(LAS u32x4*)(Vs + e * 784 + cv * 16) = vreg[i]; }
        __syncthreads();
        f32x16 S[5];
#pragma unroll
        for (int kt = 0; kt < 5; ++kt) {
            f32x16 acc;
#pragma unroll
            for (int r = 0; r < 16; ++r) acc[r] = 0.f;
            if (kt >= kt_lo) {
                const LAS unsigned char* Kp = Ks + (32 * wave + 32 * kt + q) * 144 + 16 * hi;
#pragma unroll
                for (int s = 0; s < 4; ++s) { const bf16x8 kf = *(const LAS bf16x8*)(Kp + 32 * s); acc = MFMA32(kf, qf[s], acc); }
            }
#pragma unroll
            for (int r = 0; r < 16; ++r) {
                const int kk = crow(r, hi);
                bool valid = kt >= kt_lo;
                if (kt == 0) valid = valid && (kk >= q);
                if (kt == 4) valid = valid && (kk <= q);
                acc[r] = valid ? acc[r] : -1e30f;
            }
            S[kt] = acc;
        }
        float mx = -1e30f;
#pragma unroll
        for (int kt = 0; kt < 5; ++kt)
#pragma unroll
            for (int r = 0; r < 16; ++r) mx = fmaxf(mx, S[kt][r]);
        mx = xor32_max(mx);
        const float c2 = 0.125f * 1.4426950408889634f;
        float l = 0.f;
#pragma unroll
        for (int kt = 0; kt < 5; ++kt)
#pragma unroll
            for (int r = 0; r < 16; ++r) { const float p = exp2f((S[kt][r] - mx) * c2); S[kt][r] = p; l += p; }
        l = xor32_sum(l);
        f32x16 O[2];
#pragma unroll
        for (int r = 0; r < 16; ++r) { O[0][r] = 0.f; O[1][r] = 0.f; }
#pragma unroll
        for (int kt = 0; kt < 5; ++kt) {
            if (kt >= kt_lo) {
#pragma unroll
                for (int jj = 0; jj < 2; ++jj) {
                    const bf16x8 pf = pack8(S[kt], jj);
#pragma unroll
                    for (int et = 0; et < 2; ++et) {
                        const LAS unsigned char* Vp = Vs + (32 * et + q) * 784 + (32 * wave + 32 * kt + 16 * jj + 4 * hi) * 2;
                        const u32x2 a = *(const LAS u32x2*)Vp, b = *(const LAS u32x2*)(Vp + 16); u32x4 vv; vv.x = a.x; vv.y = a.y; vv.z = b.x; vv.w = b.y;
                        O[et] = MFMA32(__builtin_bit_cast(bf16x8, vv), pf, O[et]);
                    }
                }
            }
        }
        const float inv = 1.0f / l;
#pragma unroll
        for (int et = 0; et < 2; ++et)
#pragma unroll
            for (int rg = 0; rg < 4; ++rg) { u32x2 w; w.x = pkbf(O[et][4 * rg] * inv, O[et][4 * rg + 1] * inv); w.y = pkbf(O[et][4 * rg + 2] * inv, O[et][4 * rg + 3] * inv);
                *(u32x2*)(Qp + 32 * et + 8 * rg + 4 * hi) = w; }
        if (hi == 0) LSE[((size_t)g * 8192 + n0 + q) * 16 + h] = mx * 0.125f + __logf(l);
    }
#undef ATT_LOAD
}
__device__ __forceinline__ void combine_phase(const bf16* Qg, const float* LSE, bf16* O  , int gtid, int nthr) {
    for (int i = gtid; i < 8192 * 128; i += nthr) {
        const int t = i >> 7, ch = i & 127, head = ch >> 3;
        int np[3]; np[0] = t; np[1] = (t & 3) * 2048 + (t >> 2); np[2] = (t & 15) * 512 + (t >> 4);
        float ls[3];
#pragma unroll
        for (int g = 0; g < 3; ++g) ls[g] = LSE[((size_t)g * 8192 + np[g]) * 16 + head];
        const float mx = fmaxf(ls[0], fmaxf(ls[1], ls[2]));
        float w[3]; float sw = 0.f;
#pragma unroll
        for (int g = 0; g < 3; ++g) { w[g] = __expf(ls[g] - mx); sw += w[g]; }
        const float isw = 1.0f / sw;
        float acc[8];
#pragma unroll
        for (int e = 0; e < 8; ++e) acc[e] = 0.f;
#pragma unroll
        for (int g = 0; g < 3; ++g) { const u32x4 v = *(const u32x4*)(Qg + ((size_t)g * 8192 + np[g]) * 1024 + 8 * ch); const float wg = w[g] * isw;
            acc[0] += wg * bflo(v.x); acc[1] += wg * bfhi(v.x); acc[2] += wg * bflo(v.y); acc[3] += wg * bfhi(v.y);
            acc[4] += wg * bflo(v.z); acc[5] += wg * bfhi(v.z); acc[6] += wg * bflo(v.w); acc[7] += wg * bfhi(v.w); }
        u32x4 o; o.x = pkbf(acc[0], acc[1]); o.y = pkbf(acc[2], acc[3]); o.z = pkbf(acc[4], acc[5]); o.w = pkbf(acc[6], acc[7]);
        *(u32x4*)(O + (size_t)t * 1024 + 8 * ch) = o;
    }
}

__device__ __forceinline__ void convgate_phase(const bf16* Ab, bf16* Ub, const float* cw, const float* cb, int gtid, int nthr) {
    for (int it = gtid; it < 512 * 352; it += nthr) {
        const int rb = it / 352, ch = it - rb * 352, col = ch * 8, row0 = rb * 32;
        float w0[8], w1[8], w2[8], bb[8], a2[8], a1[8];
#pragma unroll
        for (int e = 0; e < 8; ++e) { w0[e] = cw[col + e]; w1[e] = cw[FF + col + e]; w2[e] = cw[2 * FF + col + e]; bb[e] = cb[col + e]; a2[e] = 0.f; a1[e] = 0.f; }
        if ((row0 & (SEQ - 1)) != 0) {
            const u32x4 p2 = *(const u32x4*)(Ab + (size_t)(row0 - 2) * FF + col), p1 = *(const u32x4*)(Ab + (size_t)(row0 - 1) * FF + col);
            a2[0] = bflo(p2.x); a2[1] = bfhi(p2.x); a2[2] = bflo(p2.y); a2[3] = bfhi(p2.y); a2[4] = bflo(p2.z); a2[5] = bfhi(p2.z); a2[6] = bflo(p2.w); a2[7] = bfhi(p2.w);
            a1[0] = bflo(p1.x); a1[1] = bfhi(p1.x); a1[2] = bflo(p1.y); a1[3] = bfhi(p1.y); a1[4] = bflo(p1.z); a1[5] = bfhi(p1.z); a1[6] = bflo(p1.w); a1[7] = bfhi(p1.w);
        }
#pragma unroll 4
        for (int r = 0; r < 32; ++r) {
            const size_t off = (size_t)(row0 + r) * FF + col;
            const u32x4 pa = *(const u32x4*)(Ab + off), pu = *(const u32x4*)(Ub + off);
            float a[8], uu[8], o[8];
            a[0] = bflo(pa.x); a[1] = bfhi(pa.x); a[2] = bflo(pa.y); a[3] = bfhi(pa.y); a[4] = bflo(pa.z); a[5] = bfhi(pa.z); a[6] = bflo(pa.w); a[7] = bfhi(pa.w);
            uu[0] = bflo(pu.x); uu[1] = bfhi(pu.x); uu[2] = bflo(pu.y); uu[3] = bfhi(pu.y); uu[4] = bflo(pu.z); uu[5] = bfhi(pu.z); uu[6] = bflo(pu.w); uu[7] = bfhi(pu.w);
#pragma unroll
            for (int e = 0; e < 8; ++e) { const float y = w0[e] * a2[e] + w1[e] * a1[e] + w2[e] * a[e] + bb[e]; o[e] = silu_f(y) * uu[e]; a2[e] = a1[e]; a1[e] = a[e]; }
            u32x4 w; w.x = pkbf(o[0], o[1]); w.y = pkbf(o[2], o[3]); w.z = pkbf(o[4], o[5]); w.w = pkbf(o[6], o[7]);
            *(u32x4*)(Ub + off) = w;
        }
    }
}
__device__ __forceinline__ void gla_g3_phase(LAS unsigned char* lds, bf16* Qb, bf16* Kb, const bf16* VT, const float* GL, const float* w_gate, const float* b_gate, float* DEC, bf16* ST, int G) {
    LAS float* Bc = (LAS float*)lds;
    LAS float* SEG = (LAS float*)(lds + 32768);
    LAS bf16* KET = (LAS bf16*)(lds + 36864);
    const int tid = threadIdx.x, lane = tid & 63, wave = tid >> 6, hi = lane >> 5, l31 = lane & 31;
    for (int item = blockIdx.x; item < 1024; item += G) {
        const int h = item & 3, c = (item >> 2) & 127, b = item >> 9; const size_t t0 = (size_t)b * SEQ + 64 * c;
        {
            const int k = tid & 127, jq = tid >> 7;
            float wg[16];
#pragma unroll
            for (int i = 0; i < 16; ++i) wg[i] = w_gate[i * 512 + h * 128 + k];
            const float bg = b_gate[h * 128 + k];
            float run = 0.f;
            for (int jj = 0; jj < 16; ++jj) { const int j = jq * 16 + jj; const float* gp = GL + (t0 + j) * 16; float z = bg;
#pragma unroll
                for (int i = 0; i < 16; ++i) z += gp[i] * wg[i];
                const float ls = fminf(z, 0.f) - log1pf(__expf(-fabsf(z)));
                run += ls * (1.0f / 16.0f); Bc[j * 128 + k] = run; }
            SEG[jq * 128 + k] = run;
            __syncthreads();
            float off = 0.f;
            for (int qq = 0; qq < jq; ++qq) off += SEG[qq * 128 + k];
            for (int jj = 0; jj < 16; ++jj) Bc[(jq * 16 + jj) * 128 + k] += off;
            __syncthreads();
            if (tid < 128) DEC[(size_t)item * 128 + tid] = __expf(Bc[63 * 128 + tid]);
        }
#pragma unroll
        for (int i = 0; i < 2; ++i) { const int idx = tid + 512 * i, j = idx >> 4, kc = (idx & 15) * 8;
            bf16* qp = Qb + (t0 + j) * 512 + h * 128 + kc; bf16* kp = Kb + (t0 + j) * 512 + h * 128 + kc;
            const u32x4 qv = *(const u32x4*)qp, kv = *(const u32x4*)kp;
            float qf[8], kf[8], qd[8], kd[8];
            qf[0] = bflo(qv.x); qf[1] = bfhi(qv.x); qf[2] = bflo(qv.y); qf[3] = bfhi(qv.y); qf[4] = bflo(qv.z); qf[5] = bfhi(qv.z); qf[6] = bflo(qv.w); qf[7] = bfhi(qv.w);
            kf[0] = bflo(kv.x); kf[1] = bfhi(kv.x); kf[2] = bflo(kv.y); kf[3] = bfhi(kv.y); kf[4] = bflo(kv.z); kf[5] = bfhi(kv.z); kf[6] = bflo(kv.w); kf[7] = bfhi(kv.w);
#pragma unroll
            for (int e = 0; e < 8; ++e) { const float bv = Bc[j * 128 + kc + e], bl = Bc[63 * 128 + kc + e];
                qd[e] = qf[e] * 0.08838834764831845f * __expf(bv); kd[e] = kf[e] * __expf(-bv);
                const float ke = kf[e] * __expf(bl - bv); KET[(kc + e) * 72 + j] = (bf16)(pkbf(ke, ke) & 0xffffu); }
            u32x4 qo, ko; qo.x = pkbf(qd[0], qd[1]); qo.y = pkbf(qd[2], qd[3]); qo.z = pkbf(qd[4], qd[5]); qo.w = pkbf(qd[6], qd[7]);
            ko.x = pkbf(kd[0], kd[1]); ko.y = pkbf(kd[2], kd[3]); ko.z = pkbf(kd[4], kd[5]); ko.w = pkbf(kd[6], kd[7]);
            *(u32x4*)qp = qo; *(u32x4*)kp = ko; }
        __syncthreads();
        {
            f32x16 acc[4];
#pragma unroll
            for (int kt = 0; kt < 4; ++kt)
#pragma unroll
                for (int r = 0; r < 16; ++r) acc[kt][r] = 0.f;
            const bf16* Vp = VT + (size_t)(h * 256 + 32 * wave + l31) * MROWS + t0 + 8 * hi;
#pragma unroll
            for (int s = 0; s < 4; ++s) { const bf16x8 vf = *(const bf16x8*)(Vp + 16 * s);
#pragma unroll
                for (int kt = 0; kt < 4; ++kt) { const bf16x8 af = *(const LAS bf16x8*)(KET + (32 * kt + l31) * 72 + 16 * s + 8 * hi); acc[kt] = MFMA32(af, vf, acc[kt]); } }
            bf16* Sp = ST + ((size_t)item * 256 + 32 * wave + l31) * 128;
#pragma unroll
            for (int kt = 0; kt < 4; ++kt)
#pragma unroll
                for (int rg = 0; rg < 4; ++rg) { u32x2 w; w.x = pkbf(acc[kt][4 * rg], acc[kt][4 * rg + 1]); w.y = pkbf(acc[kt][4 * rg + 2], acc[kt][4 * rg + 3]);
                    *(u32x2*)(Sp + 32 * kt + 8 * rg + 4 * hi) = w; }
        }
        __syncthreads();
    }
}
__device__ __forceinline__ void gla_scan_phase(bf16* ST, const float* DEC, int gtid, int nthr) {
    for (int e = gtid; e < 2 * 4 * 256 * 64; e += nthr) {
        const int kp = e & 63, v = (e >> 6) & 255, h = (e >> 14) & 3, b = e >> 16;
        float s0 = 0.f, s1 = 0.f;
#pragma unroll 8
        for (int c = 0; c < 128; ++c) { const size_t item = (size_t)(b * 128 + c) * 4 + h;
            unsigned* p = (unsigned*)(ST + (item * 256 + v) * 128 + 2 * kp); const unsigned ds = *p; const f32x2 dc = *(const f32x2*)(DEC + item * 128 + 2 * kp);
            *p = pkbf(s0, s1); s0 = dc.x * s0 + bflo(ds); s1 = dc.y * s1 + bfhi(ds); }
    }
}
__device__ __forceinline__ void gla_g5_phase(LAS unsigned char* lds, const bf16* Qb, const bf16* Kb, const bf16* VT, const bf16* Rb, const bf16* ST, const float* gain, bf16* O, int G) {
    LAS float* red = (LAS float*)lds;
    const int tid = threadIdx.x, lane = tid & 63, wave = tid >> 6, hi = lane >> 5, l31 = lane & 31;
    const int it = wave & 1, vp = wave >> 1;
    for (int item = blockIdx.x; item < 1024; item += G) {
        const int h = item & 3, c = (item >> 2) & 127, b = item >> 9; const size_t t0 = (size_t)b * SEQ + 64 * c;
        bf16x8 qf[8];
        const bf16* Qp = Qb + (t0 + 32 * it + l31) * 512 + h * 128 + 8 * hi;
#pragma unroll
        for (int s = 0; s < 8; ++s) qf[s] = *(const bf16x8*)(Qp + 16 * s);
        f32x16 AT[2];
#pragma unroll
        for (int jt = 0; jt < 2; ++jt) {
            f32x16 acc;
#pragma unroll
            for (int r = 0; r < 16; ++r) acc[r] = 0.f;
            if (jt <= it) {
                const bf16* Kp = Kb + (t0 + 32 * jt + l31) * 512 + h * 128 + 8 * hi;
#pragma unroll
                for (int s = 0; s < 8; ++s) { const bf16x8 kf = *(const bf16x8*)(Kp + 16 * s); acc = MFMA32(kf, qf[s], acc); }
                if (jt == it) {
#pragma unroll
                    for (int r = 0; r < 16; ++r) acc[r] = (crow(r, hi) <= l31) ? acc[r] : 0.f;
                }
            }
            AT[jt] = acc;
        }
        f32x16 Oa[2];
#pragma unroll
        for (int vt = 0; vt < 2; ++vt) {
            f32x16 acc;
#pragma unroll
            for (int r = 0; r < 16; ++r) acc[r] = 0.f;
            const int vcol = 32 * (2 * vp + vt) + l31;
#pragma unroll
            for (int jt = 0; jt < 2; ++jt) {
                if (jt <= it) {
#pragma unroll
                    for (int jj = 0; jj < 2; ++jj) { const bf16* Vp = VT + (size_t)(h * 256 + vcol) * MROWS + t0 + 32 * jt + 16 * jj + 4 * hi; acc = MFMA32(ld2x8(Vp), pack8(AT[jt], jj), acc); }
                }
            }
            const bf16* Sp = ST + ((size_t)item * 256 + vcol) * 128 + 8 * hi;
#pragma unroll
            for (int s = 0; s < 8; ++s) { const bf16x8 sf = *(const bf16x8*)(Sp + 16 * s); acc = MFMA32(sf, qf[s], acc); }
            Oa[vt] = acc;
        }
        float ss = 0.f;
#pragma unroll
        for (int vt = 0; vt < 2; ++vt)
#pragma unroll
            for (int r = 0; r < 16; ++r) ss += Oa[vt][r] * Oa[vt][r];
        ss = xor32_sum(ss);
        if (hi == 0) red[vp * 64 + 32 * it + l31] = ss;
        __syncthreads();
        const float tot = (red[32 * it + l31] + red[64 + 32 * it + l31]) + (red[128 + 32 * it + l31] + red[192 + 32 * it + l31]);
        const float rs = 1.0f / sqrtf(tot * (1.0f / 256.0f) + EPS);
        const size_t row = t0 + 32 * it + l31;
#pragma unroll
        for (int vt = 0; vt < 2; ++vt)
#pragma unroll
            for (int rg = 0; rg < 4; ++rg) { const int vb = 32 * (2 * vp + vt) + 8 * rg + 4 * hi;
                const f32x4 gn = *(const f32x4*)(gain + vb); const u32x2 rr = *(const u32x2*)(Rb + row * 1024 + h * 256 + vb);
                const float o0 = Oa[vt][4 * rg] * rs * gn.x * silu_f(bflo(rr.x)), o1 = Oa[vt][4 * rg + 1] * rs * gn.y * silu_f(bfhi(rr.x));
                const float o2 = Oa[vt][4 * rg + 2] * rs * gn.z * silu_f(bflo(rr.y)), o3 = Oa[vt][4 * rg + 3] * rs * gn.w * silu_f(bfhi(rr.y));
                u32x2 w; w.x = pkbf(o0, o1); w.y = pkbf(o2, o3); *(u32x2*)(O + row * 1024 + h * 256 + vb) = w; }
        __syncthreads();
    }
}

struct Params {
    const float *x, *c, *w_ada, *b_ada, *norm_mix, *norm_ffn, *attn_w_in, *attn_w_out, *gla_w_in, *gla_w_gate, *gla_b_gate, *gla_norm, *gla_w_out,
                *ffn_w_up, *ffn_conv_w, *ffn_conv_b, *ffn_w_down, *norm_final;
    float* out; unsigned char* ws;
};

typedef const __attribute__((address_space(4))) Params* kparams_t;
__device__ __forceinline__ kparams_t kp() { kparams_t q = (kparams_t)__builtin_amdgcn_kernarg_segment_ptr(); asm volatile("" : "+s"(q)); return q; }
#define PHASE_IDX int z_; asm volatile("s_mov_b32 %0, 0" : "=s"(z_)); const int tid = (int)threadIdx.x + z_, lane = tid & 63, wave = __builtin_amdgcn_readfirstlane(tid >> 6); \
    const int G = gridDim.x, bid = (int)blockIdx.x + z_, gw = bid * NWAVES + wave, ngw = G * NWAVES, gtid = bid * NTHR + tid, nthr = G * NTHR; \
    unsigned char* ws = kp()->ws; (void)lane; (void)gw; (void)ngw; (void)gtid; (void)nthr; (void)ws;
#define GSYNC() do { asm volatile("s_waitcnt vmcnt(0) lgkmcnt(0)" ::: "memory"); cg::this_grid().sync(); asm volatile("" ::: "memory"); } while (0)
#define LDSP ((LAS unsigned char*)lds_raw)

template <class Epi>
__device__ __forceinline__ void run_gemm(LAS unsigned char* lds, const bf16* A, const bf16* Bt, int M, int N, int K, int dil, int L, int rot, const Epi& E) {
    pg8::Gemm g{A, Bt, M, N, K, dil, L}; pg8::StaticOrder S; const int G = gridDim.x; S.init(M, N, G, (int)((blockIdx.x + rot) % G));
    int z_; asm volatile("s_mov_b32 %0, 0" : "=s"(z_));
    pg8::gemm_phase<Epi, pg8::StaticOrder, true, true>((PG8_LAS unsigned char*)lds, g, S, E, (int)threadIdx.x + z_);
}

#define FFN_BLOCK(layer) do { \
    { PHASE_IDX; const float* ml = (const float*)(ws + WS_MOD) + (size_t)(layer) * 2 * 6144; \
      modulate_phase(kp()->out, (bf16*)(ws + WS_XN), kp()->norm_ffn + (layer) * DM, ml + 3 * 1024, ml + 4 * 1024, gw, ngw, lane); } \
    GSYNC(); \
    { unsigned char* ws = kp()->ws; pg8::EpiUp E{(bf16*)(ws + F_A), (bf16*)(ws + F_U)}; run_gemm(LDSP, (const bf16*)(ws + WS_XN), (const bf16*)(ws + W_UP), MROWS, 2 * FF, DM, 1, MROWS, 0, E); } \
    GSYNC(); \
    { PHASE_IDX; convgate_phase((const bf16*)(ws + F_A), (bf16*)(ws + F_U), kp()->ffn_conv_w + (size_t)(layer) * 3 * FF, kp()->ffn_conv_b + (size_t)(layer) * FF, gtid, nthr); } \
    GSYNC(); \
    { unsigned char* ws = kp()->ws; float* o = kp()->out; pg8::EpiRes E{o, o, (const float*)(ws + WS_MOD) + (size_t)(layer) * 2 * 6144 + 5 * 1024}; \
      run_gemm(LDSP, (const bf16*)(ws + F_U), (const bf16*)(ws + W_DOWN), MROWS, DM, FF, 1, MROWS, 0, E); } \
    GSYNC(); } while (0)

__global__ void __launch_bounds__(NTHR, 2) fwd_kernel(Params p_unused) {
    extern __shared__ __attribute__((aligned(16))) unsigned char lds_raw[];
    {
        PHASE_IDX;
        LAS unsigned char* lds = LDSP;
        float* mod = (float*)(ws + WS_MOD);
        LAS float* scr = (LAS float*)(lds + wave * 16384);
        LAS float* red = (LAS float*)(lds + 131072);
        const float* cvec = kp()->c; const float* b_ada = kp()->b_ada;
        for (int it = bid; it < 192; it += G) {
            const int layer = it / 96, ch = it % 96, n = ch * 64 + lane;
            const float* W = kp()->w_ada + (size_t)layer * 1024 * 6144;
            float a0 = 0.f, a1 = 0.f;
#pragma unroll 8
            for (int kk = 0; kk < 128; ++kk) { const int k = wave * 128 + kk; const float wv = W[(size_t)k * 6144 + n]; a0 += silu_f(cvec[k]) * wv; a1 += silu_f(cvec[1024 + k]) * wv; }
            red[(wave * 2 + 0) * 64 + lane] = a0; red[(wave * 2 + 1) * 64 + lane] = a1;
            __syncthreads();
            if (wave == 0) { float t0 = b_ada[layer * 6144 + n], t1 = t0;
                for (int w = 0; w < 8; ++w) { t0 += red[(w * 2) * 64 + lane]; t1 += red[(w * 2 + 1) * 64 + lane]; }
                mod[(size_t)(layer * 2 + 0) * 6144 + n] = t0; mod[(size_t)(layer * 2 + 1) * 6144 + n] = t1; }
            __syncthreads();
        }
        constexpr int I_IN = 16 * 288, I_O = 16 * 32, I_UP = 16 * 176, I_DN = 44 * 32;
        for (int it = gw; it < I_IN + I_O + I_UP + I_DN; it += ngw) {
            int r = it;
            if (r < I_IN) { transpose_item(kp()->attn_w_in, 1024, 9216, (bf16*)(ws + W_IN), 1, scr, r, lane); continue; } r -= I_IN;
            if (r < I_O) { transpose_item(kp()->attn_w_out, 1024, 1024, (bf16*)(ws + W_OUT), 0, scr, r, lane); continue; } r -= I_O;
            if (r < I_UP) { transpose_item(kp()->ffn_w_up, 1024, 2 * FF, (bf16*)(ws + W_UP), 0, scr, r, lane); continue; } r -= I_UP;
            transpose_item(kp()->ffn_w_down, FF, 1024, (bf16*)(ws + W_DOWN), 0, scr, r, lane);
        }
    }
    GSYNC();
#if STAGE >= 1
    { PHASE_IDX; const float* mod = (const float*)(ws + WS_MOD); modulate_phase(kp()->x, (bf16*)(ws + WS_XN), kp()->norm_mix, mod + 0 * 1024, mod + 1 * 1024, gw, ngw, lane); }
    GSYNC();
    for (int b = 0; b < 2; ++b) {
        for (int g = 0; g < 3; ++g) {
            unsigned char* ws = kp()->ws;
            const int dil = (g == 0) ? 1 : (g == 1 ? 4 : 16);
            pg8::EpiAttn E{(bf16*)(ws + A_Q) + (size_t)g * 8192 * 1024, (bf16*)(ws + A_K) + (size_t)g * 8192 * 1024, (bf16*)(ws + A_VT) + (size_t)g * 8192 * 1024};
            run_gemm(LDSP, (const bf16*)(ws + WS_XN) + (size_t)b * SEQ * DM, (const bf16*)(ws + W_IN) + (size_t)g * 3072 * 1024, SEQ, 3072, DM, dil, SEQ / dil, g * 128, E);
        }
        GSYNC();
        { PHASE_IDX; attn_phase(LDSP, (bf16*)(ws + A_Q), (const bf16*)(ws + A_K), (const bf16*)(ws + A_VT), (float*)(ws + A_LSE), tid, bid); }
        GSYNC();
        { PHASE_IDX; combine_phase((const bf16*)(ws + A_Q), (const float*)(ws + A_LSE), (bf16*)(ws + WS_XN) + (size_t)b * SEQ * DM, gtid, nthr); }
        GSYNC();
    }
    { unsigned char* ws = kp()->ws; pg8::EpiRes E{kp()->x, kp()->out, (const float*)(ws + WS_MOD) + 2 * 1024}; run_gemm(LDSP, (const bf16*)(ws + WS_XN), (const bf16*)(ws + W_OUT), MROWS, DM, DM, 1, MROWS, 0, E); }
    GSYNC();
#endif
#if STAGE >= 2
    FFN_BLOCK(0);
#endif
#if STAGE >= 3
    {
        {
            PHASE_IDX;
            const float* ml = (const float*)(ws + WS_MOD) + (size_t)2 * 6144;
            modulate_phase(kp()->out, (bf16*)(ws + WS_XN), kp()->norm_mix + DM, ml + 0 * 1024, ml + 1 * 1024, gw, ngw, lane);
            LAS float* scr = (LAS float*)(LDSP + wave * 16384);
            constexpr int I_IN = 16 * 97, I_O = 16 * 32, I_UP = 16 * 176, I_DN = 44 * 32;
            for (int it = gw; it < I_IN + I_O + I_UP + I_DN; it += ngw) {
                int r = it;
                if (r < I_IN) { transpose_item(kp()->gla_w_in, 1024, 3088, (bf16*)(ws + W_IN), 2, scr, r, lane); continue; } r -= I_IN;
                if (r < I_O) { transpose_item(kp()->gla_w_out, 1024, 1024, (bf16*)(ws + W_OUT), 0, scr, r, lane); continue; } r -= I_O;
                if (r < I_UP) { transpose_item(kp()->ffn_w_up + (size_t)1024 * 2 * FF, 1024, 2 * FF, (bf16*)(ws + W_UP), 0, scr, r, lane); continue; } r -= I_UP;
                transpose_item(kp()->ffn_w_down + (size_t)FF * 1024, FF, 1024, (bf16*)(ws + W_DOWN), 0, scr, r, lane);
            }
            for (int i = gtid; i < 240 * 1024 / 8; i += nthr) ((u32x4*)(ws + W_IN + (size_t)3088 * 1024 * 2))[i] = (u32x4){0u, 0u, 0u, 0u};
        }
        GSYNC();
        { unsigned char* ws = kp()->ws; pg8::EpiGla E{(bf16*)(ws + G_Q), (bf16*)(ws + G_K), (bf16*)(ws + G_VT), (bf16*)(ws + G_R), (float*)(ws + G_GL)};
          run_gemm(LDSP, (const bf16*)(ws + WS_XN), (const bf16*)(ws + W_IN), MROWS, 3328, DM, 1, MROWS, 0, E); }
        GSYNC();
        { PHASE_IDX; gla_g3_phase(LDSP, (bf16*)(ws + G_Q), (bf16*)(ws + G_K), (const bf16*)(ws + G_VT), (const float*)(ws + G_GL), kp()->gla_w_gate, kp()->gla_b_gate, (float*)(ws + G_DEC), (bf16*)(ws + G_ST), G); }
        GSYNC();
        { PHASE_IDX; gla_scan_phase((bf16*)(ws + G_ST), (const float*)(ws + G_DEC), gtid, nthr); }
        GSYNC();
        { PHASE_IDX; gla_g5_phase(LDSP, (const bf16*)(ws + G_Q), (const bf16*)(ws + G_K), (const bf16*)(ws + G_VT), (const bf16*)(ws + G_R), (const bf16*)(ws + G_ST), kp()->gla_norm, (bf16*)(ws + WS_XN), G); }
        GSYNC();
        { unsigned char* ws = kp()->ws; float* o = kp()->out; pg8::EpiRes E{o, o, (const float*)(ws + WS_MOD) + (size_t)2 * 6144 + 2 * 1024}; run_gemm(LDSP, (const bf16*)(ws + WS_XN), (const bf16*)(ws + W_OUT), MROWS, DM, DM, 1, MROWS, 0, E); }
        GSYNC();
    }
#endif
#if STAGE >= 4
    FFN_BLOCK(1);
#endif
    { PHASE_IDX;
#if STAGE >= 1
      final_norm_phase(kp()->out, kp()->out, kp()->norm_final, gw, ngw, lane);
#else
      final_norm_phase(kp()->x, kp()->out, kp()->norm_final, gw, ngw, lane);
#endif
    }
}

extern "C" void kernel_launch(void* const* d_in, const int* in_sizes, int n_in, void* d_out, int out_size, void* d_ws, size_t ws_size, hipStream_t stream) {
    static int grid = 0;
    if (grid == 0) {
        if (n_in != 18 || ws_size < WS_END) { fprintf(stderr, "kernel_launch: unexpected n_in %d / ws_size %zu\n", n_in, ws_size); grid = -1; return; }
        int dev = 0, cus = 0, per_cu = 0;
        hipGetDevice(&dev);
        hipDeviceGetAttribute(&cus, hipDeviceAttributeMultiprocessorCount, dev);
        hipFuncSetAttribute((const void*)fwd_kernel, hipFuncAttributeMaxDynamicSharedMemorySize, LDS_BYTES);
        hipOccupancyMaxActiveBlocksPerMultiprocessor(&per_cu, (const void*)fwd_kernel, NTHR, LDS_BYTES);
        if (per_cu < 1) { fprintf(stderr, "kernel_launch: occupancy query says %d blocks per CU\n", per_cu); grid = -1; return; }
        grid = cus;
    }
    if (grid < 0) return;
    Params p{};
    const float** pp = (const float**)&p;
    for (int i = 0; i < 18; ++i) pp[i] = (const float*)d_in[i];
    p.out = (float*)d_out; p.ws = (unsigned char*)d_ws;
    void* args[] = {&p};
    hipError_t e = hipLaunchCooperativeKernel((const void*)fwd_kernel, dim3(grid), dim3(NTHR), args, LDS_BYTES, stream);
    if (e != hipSuccess) fprintf(stderr, "cooperative launch failed: %s (grid %d)\n", hipGetErrorString(e), grid);
}
```

```cpp
#include <hip/hip_runtime.h>
#include <hip/hip_cooperative_groups.h>
#include <cstdio>
#include <cstdint>
namespace cg = cooperative_groups;
#ifndef STAGE
#define STAGE 4
#endif
namespace pg8 {
#define PG8_LAS __attribute__((address_space(3)))
typedef unsigned short bf16_t;
typedef short bf16x8 __attribute__((ext_vector_type(8)));
typedef float f32x4 __attribute__((ext_vector_type(4)));
typedef unsigned u32x4 __attribute__((ext_vector_type(4)));
constexpr int BM = 256, BK = 64, HALF = 128, HTB = HALF * BK * 2  , STAGE_BYTES = 8 * HTB, NXCD = 8, WGM = 8;

__host__ __device__ __forceinline__ int lds_byte(int r, int c) { const int st = (r >> 4) * 2 + (c >> 5), rr = r & 15, cc = c & 31, ob = rr * 64 + cc * 2; return st * 1024 + (ob ^ (((ob >> 9) & 1) << 5)); }
__host__ __device__ __forceinline__ void stage_rc(int b, int& R, int& C) { const int st = b / 1024, sb = b % 1024, swz = sb ^ (((sb >> 9) & 1) << 5); R = (st >> 1) * 16 + swz / 64; C = (st & 1) * 32 + (swz % 64) / 2; }
__host__ __device__ __forceinline__ int perm32(int rho) { const int n = rho >> 4, i = rho & 15; return 8 * (i >> 2) + 4 * n + (i & 3); }

struct Unit { int pm, pn; };
struct Gemm { const bf16_t* A; const bf16_t* Bt; int M, N, K; int dil, L;
    __device__ __forceinline__ size_t a_off(int pm) const { const int n0 = pm * 256; return (size_t)((n0 / L) + dil * (n0 % L)) * (size_t)K * 2; } };

struct StaticOrder {
    int nM, nN, nwg, G, c;
    __host__ __device__ void init(int M, int N, int G_, int c_) { nM = M / BM; nN = N / BM; nwg = nM * nN; G = G_; c = c_; }
    __host__ __device__ bool next(int i, Unit& u) const {
        const long L = (long)i * G + c; if (L >= nwg) return false;
        int wgid = (int)L; { const int q = nwg / NXCD, r = nwg % NXCD, xcd = wgid % NXCD, off = wgid / NXCD; wgid = (xcd < r ? xcd * (q + 1) : r * (q + 1) + (xcd - r) * q) + off; }
        const int nig = WGM * nN, gid = wgid / nig, fm = gid * WGM, gsz = (nM - fm) < WGM ? (nM - fm) : WGM;
        u.pm = fm + ((wgid % nig) % gsz); u.pn = (wgid % nig) / gsz; return true;
    }
    __device__ __forceinline__ void a_ready(const Unit&) const {}
    __device__ __forceinline__ void done(const Unit&) const {}
};

typedef unsigned u32x4 __attribute__((ext_vector_type(4)));
typedef float f32x2_t __attribute__((ext_vector_type(2))); typedef __bf16 bf16x2_t __attribute__((ext_vector_type(2)));
__device__ __forceinline__ unsigned cvt_pk_bf16(float lo, float hi) { f32x2_t v = {lo, hi}; bf16x2_t b = __builtin_convertvector(v, bf16x2_t); return __builtin_bit_cast(unsigned, b); }
__device__ __forceinline__ void store_rm_bf16(const f32x4 (&acc)[2][2][4][2], bf16_t* base, int ld, int row0, int col0) {
#pragma unroll
    for (int ai = 0; ai < 2; ++ai)
#pragma unroll
        for (int m = 0; m < 4; ++m) { bf16_t* rowp = base + (size_t)(row0 + ai * HALF + m * 16) * ld + col0;
#pragma unroll
            for (int bj = 0; bj < 2; ++bj) { const f32x4 v0 = acc[ai][bj][m][0], v1 = acc[ai][bj][m][1];
                u32x4 w; w.x = cvt_pk_bf16(v0[0], v0[1]); w.y = cvt_pk_bf16(v0[2], v0[3]); w.z = cvt_pk_bf16(v1[0], v1[1]); w.w = cvt_pk_bf16(v1[2], v1[3]);
                *(u32x4*)(rowp + bj * HALF) = w; } }
}
__device__ __forceinline__ void store_tr_bf16(const f32x4 (&acc)[2][2][4][2], bf16_t* base, size_t pitch, int row0, int col0) {
#pragma unroll
    for (int ai = 0; ai < 2; ++ai)
#pragma unroll
        for (int m = 0; m < 4; ++m) { bf16_t* rp = base + (row0 + ai * HALF + m * 16);
#pragma unroll
            for (int bj = 0; bj < 2; ++bj)
#pragma unroll
                for (int n = 0; n < 2; ++n) { const f32x4 v = acc[ai][bj][m][n]; const unsigned p0 = cvt_pk_bf16(v[0], v[1]), p1 = cvt_pk_bf16(v[2], v[3]);
                    bf16_t* cp = rp + (size_t)(col0 + bj * HALF + 4 * n) * pitch;
                    cp[0] = (bf16_t)(p0 & 0xffffu); cp[pitch] = (bf16_t)(p0 >> 16); cp[2 * pitch] = (bf16_t)(p1 & 0xffffu); cp[3 * pitch] = (bf16_t)(p1 >> 16); } }
}
struct EpiAttn {
    static constexpr bool PERM = true, AFTER_DRAIN = false;
    bf16_t* Q; bf16_t* Kb; bf16_t* VT;
    __device__ __forceinline__ void operator()(const f32x4 (&acc)[2][2][4][2], const Unit& u, int wr, int wc, int fr, int fq) const {
        const int row0 = u.pm * BM + wr * 64 + fr, col0 = (u.pn & 3) * BM + wc * 32 + 8 * fq;
        if (u.pn < 8) store_rm_bf16(acc, u.pn < 4 ? Q : Kb, 1024, row0, col0);
        else store_tr_bf16(acc, VT, 8192, row0, col0);
    }
};
struct EpiGla {
    static constexpr bool PERM = true, AFTER_DRAIN = false;
    bf16_t* Q; bf16_t* Kb; bf16_t* VT; bf16_t* R; float* GL;
    __device__ __forceinline__ void operator()(const f32x4 (&acc)[2][2][4][2], const Unit& u, int wr, int wc, int fr, int fq) const {
        const int row0 = u.pm * BM + wr * 64 + fr, cw = wc * 32 + 8 * fq;
        if (u.pn < 2) store_rm_bf16(acc, Q, 512, row0, u.pn * BM + cw);
        else if (u.pn < 4) store_rm_bf16(acc, Kb, 512, row0, (u.pn - 2) * BM + cw);
        else if (u.pn < 8) store_tr_bf16(acc, VT, 16384, row0, (u.pn - 4) * BM + cw);
        else if (u.pn < 12) store_rm_bf16(acc, R, 1024, row0, (u.pn - 8) * BM + cw);
        else if (wc == 0 && fq < 2) {
#pragma unroll
            for (int ai = 0; ai < 2; ++ai)
#pragma unroll
                for (int m = 0; m < 4; ++m) { float* gp = GL + (size_t)(row0 + ai * HALF + m * 16) * 16 + 8 * fq;
                    *(f32x4*)gp = acc[ai][0][m][0]; *(f32x4*)(gp + 4) = acc[ai][0][m][1]; }
        }
    }
};
struct EpiUp {
    static constexpr bool PERM = true, AFTER_DRAIN = false;
    bf16_t* Ab; bf16_t* Ub;
    __device__ __forceinline__ void operator()(const f32x4 (&acc)[2][2][4][2], const Unit& u, int wr, int wc, int fr, int fq) const {
        const int row0 = u.pm * BM + wr * 64 + fr, cw = wc * 32 + 8 * fq;
        if (u.pn < 11) store_rm_bf16(acc, Ab, 2816, row0, u.pn * BM + cw); else store_rm_bf16(acc, Ub, 2816, row0, (u.pn - 11) * BM + cw);
    }
};
struct EpiRes {
    static constexpr bool PERM = false, AFTER_DRAIN = false;
    const float* base; float* out; const float* gate;
    __device__ __forceinline__ void operator()(const f32x4 (&acc)[2][2][4][2], const Unit& u, int wr, int wc, int fr, int fq) const {
        const int row0 = u.pm * BM + wr * 64 + fr, col0 = u.pn * BM + wc * 32 + 4 * fq;
        const float* gp = gate + (size_t)((u.pm * BM) >> 13) * 6144 + col0;
        f32x4 gv[2][2];
#pragma unroll
        for (int bj = 0; bj < 2; ++bj)
#pragma unroll
            for (int n = 0; n < 2; ++n) gv[bj][n] = *(const f32x4*)(gp + bj * HALF + n * 16);
#pragma unroll
        for (int ai = 0; ai < 2; ++ai)
#pragma unroll
            for (int m = 0; m < 4; ++m) { const size_t off = (size_t)(row0 + ai * HALF + m * 16) * 1024 + col0;
#pragma unroll
                for (int bj = 0; bj < 2; ++bj)
#pragma unroll
                    for (int n = 0; n < 2; ++n) { const f32x4 bs = *(const f32x4*)(base + off + bj * HALF + n * 16);
                        *(f32x4*)(out + off + bj * HALF + n * 16) = bs + gv[bj][n] * acc[ai][bj][m][n]; } }
    }
};
template <class Epi, class Sched, bool ALIGN_EPI = false, bool SP2 = false>
__device__ __forceinline__ void gemm_phase(PG8_LAS unsigned char* lds, const Gemm g, const Sched& S, const Epi& E, const int tid_in) {
    const int tid = tid_in, wid = __builtin_amdgcn_readfirstlane(tid >> 6), lane = tid & 63, wr = wid >> 2, wc = wid & 3, fr = lane & 15, fq = lane >> 4;
    const int K = g.K, nt = K / BK, lda = g.dil * K;
    unsigned voffA[2], voffB[2];
#pragma unroll
    for (int i = 0; i < 2; ++i) { int R, C; stage_rc(tid * 16 + i * 8192, R, C); const int Rb = Epi::PERM ? ((R & ~31) + perm32(R & 31)) : R;
        voffA[i] = (unsigned)(R * lda + C) * 2u; voffB[i] = (unsigned)(Rb * K + C) * 2u; }
    const size_t kstep = (size_t)(BK * 2);
     const size_t hstepA = (size_t)HALF * lda * 2, hstepB = (size_t)HALF * K * 2;
    const size_t tstepB = 2 * hstepB;
    const unsigned ldsw = (unsigned)wid * 1024u;
    const int aoff = lds_byte(wr * 64 + fr, fq * 8), boff = lds_byte(wc * 32 + fr, fq * 8);
#define PG8_SA(b, h) (((b) * 2 + (h)) * HTB)
#define PG8_SB(b, h) ((4 + (b) * 2 + (h)) * HTB)
#define PG8_STAGE(bufoff, gbase, voff) do { _Pragma("unroll") for (int _i = 0; _i < 2; ++_i) \
        __builtin_amdgcn_global_load_lds((const unsigned*)((const char*)(gbase) + (voff)[_i]), (PG8_LAS unsigned*)(lds + (bufoff) + ldsw + _i * 8192), 16, 0, 0); } while (0)
#define PG8_LDA(dst, b, h) do { _Pragma("unroll") for (int m = 0; m < 4; ++m) _Pragma("unroll") for (int k = 0; k < 2; ++k) dst[m][k] = *(const PG8_LAS bf16x8*)(lds + PG8_SA(b, h) + aoff + m * 2048 + k * 1024); } while (0)
#define PG8_LDB(dst, b, h) do { _Pragma("unroll") for (int n = 0; n < 2; ++n) _Pragma("unroll") for (int k = 0; k < 2; ++k) dst[n][k] = *(const PG8_LAS bf16x8*)(lds + PG8_SB(b, h) + boff + n * 2048 + k * 1024); } while (0)
#define PG8_MMA(ai, bj, At, Bt) do { __builtin_amdgcn_s_setprio(1); _Pragma("unroll") for (int m = 0; m < 4; ++m) _Pragma("unroll") for (int n = 0; n < 2; ++n) _Pragma("unroll") for (int k = 0; k < 2; ++k) \
        acc[ai][bj][m][n] = __builtin_amdgcn_mfma_f32_16x16x32_bf16(Bt[n][k], At[m][k], acc[ai][bj][m][n], 0, 0, 0); __builtin_amdgcn_s_setprio(0); } while (0)
#define PG8_WAIT_V(n) asm volatile("s_waitcnt vmcnt(" #n ")" ::: "memory")
#define PG8_WAIT_L(n) asm volatile("s_waitcnt lgkmcnt(" #n ")" ::: "memory")
#define PG8_BAR __builtin_amdgcn_s_barrier()
#define PG8_SCHED __builtin_amdgcn_sched_barrier(0)
    Unit cur, nxt; int ui = 0;
    if (!S.next(0, cur)) return;
    f32x4 acc[2][2][4][2];
#pragma unroll
    for (int a = 0; a < 2; ++a)
#pragma unroll
        for (int b = 0; b < 2; ++b)
#pragma unroll
            for (int m = 0; m < 4; ++m)
#pragma unroll
                for (int n = 0; n < 2; ++n) acc[a][b][m][n] = (f32x4){0.f, 0.f, 0.f, 0.f};
    bf16x8 At[4][2], B0[2][2], B1[2][2];
    const char* cA = (const char*)g.A + g.a_off(cur.pm); const char* cB = (const char*)g.Bt + (size_t)cur.pn * tstepB;
    S.a_ready(cur);
    if constexpr (SP2) {
        PG8_STAGE(PG8_SB(0, 0), cB, voffB); PG8_STAGE(PG8_SB(0, 1), cB + hstepB, voffB); PG8_STAGE(PG8_SA(0, 0), cA, voffA); PG8_STAGE(PG8_SA(0, 1), cA + hstepA, voffA);
        if (wr == 1) PG8_BAR;
        PG8_WAIT_V(2); PG8_BAR;
        PG8_STAGE(PG8_SB(1, 0), cB + kstep, voffB); PG8_STAGE(PG8_SA(1, 0), cA + kstep, voffA); PG8_STAGE(PG8_SB(1, 1), cB + hstepB + kstep, voffB);
        PG8_WAIT_V(6); PG8_BAR;
    } else {
        PG8_STAGE(PG8_SB(0, 0), cB, voffB); PG8_STAGE(PG8_SA(0, 0), cA, voffA); PG8_STAGE(PG8_SB(0, 1), cB + hstepB, voffB); PG8_STAGE(PG8_SA(0, 1), cA + hstepA, voffA);
        if (wr == 1) PG8_BAR;
        PG8_WAIT_V(4); PG8_BAR;
        PG8_STAGE(PG8_SB(1, 0), cB + kstep, voffB); PG8_STAGE(PG8_SA(1, 0), cA + kstep, voffA); PG8_STAGE(PG8_SB(1, 1), cB + hstepB + kstep, voffB);
        PG8_WAIT_V(6); PG8_BAR;
    }
    for (;;) {
        const bool has_next = S.next(ui + 1, nxt);
        const char* nA = has_next ? (const char*)g.A + g.a_off(nxt.pm) : cA; const char* nB = has_next ? (const char*)g.Bt + (size_t)nxt.pn * tstepB : cB;
        for (int t = 0; t < nt; t += 2) {
            const bool last = (t == nt - 2);
            const char* a1 = cA + (size_t)(t + 1) * kstep;
            const char* a2 = last ? nA : cA + (size_t)(t + 2) * kstep; const char* b2 = last ? nB : cB + (size_t)(t + 2) * kstep;
            const char* a3 = a2 + kstep; const char* b3 = b2 + kstep;
            if (last && has_next) S.a_ready(nxt);
            if constexpr (SP2) {
            PG8_LDB(B0, 0, 0); PG8_LDB(B1, 0, 1); PG8_SCHED; PG8_LDA(At, 0, 0); PG8_STAGE(PG8_SA(1, 1), a1 + hstepA, voffA);
            PG8_WAIT_V(8); PG8_WAIT_L(0); PG8_BAR; PG8_MMA(0, 0, At, B0); PG8_MMA(0, 1, At, B1); PG8_BAR; PG8_SCHED;
            PG8_LDA(At, 0, 1); PG8_STAGE(PG8_SB(0, 0), b2, voffB); PG8_STAGE(PG8_SB(0, 1), b2 + hstepB, voffB); PG8_STAGE(PG8_SA(0, 0), a2, voffA);
            PG8_WAIT_V(8); PG8_WAIT_L(0); PG8_BAR; PG8_MMA(1, 0, At, B0); PG8_MMA(1, 1, At, B1); PG8_BAR; PG8_SCHED;
            PG8_LDB(B0, 1, 0); PG8_LDB(B1, 1, 1); PG8_SCHED; PG8_LDA(At, 1, 0); PG8_STAGE(PG8_SA(0, 1), a2 + hstepA, voffA);
            PG8_WAIT_V(8); PG8_WAIT_L(0); PG8_BAR; PG8_MMA(0, 0, At, B0); PG8_MMA(0, 1, At, B1); PG8_BAR; PG8_SCHED;
            PG8_LDA(At, 1, 1); PG8_STAGE(PG8_SB(1, 0), b3, voffB); PG8_STAGE(PG8_SB(1, 1), b3 + hstepB, voffB); PG8_STAGE(PG8_SA(1, 0), a3, voffA);
            PG8_WAIT_V(8); PG8_WAIT_L(0); PG8_BAR; PG8_MMA(1, 0, At, B0); PG8_MMA(1, 1, At, B1); PG8_BAR; PG8_SCHED;
            } else {
            PG8_LDB(B0, 0, 0); PG8_SCHED; PG8_LDA(At, 0, 0); PG8_STAGE(PG8_SA(1, 1), a1 + hstepA, voffA);
            PG8_WAIT_L(8); PG8_BAR; PG8_WAIT_L(0); PG8_MMA(0, 0, At, B0); PG8_BAR; PG8_SCHED;
            PG8_LDB(B1, 0, 1); PG8_STAGE(PG8_SB(0, 0), b2, voffB);
            PG8_BAR; PG8_WAIT_L(0); PG8_MMA(0, 1, At, B1); PG8_BAR;
            PG8_LDA(At, 0, 1); PG8_STAGE(PG8_SA(0, 0), a2, voffA);
            PG8_BAR; PG8_WAIT_L(0); PG8_MMA(1, 0, At, B0); PG8_BAR; PG8_SCHED;
            PG8_STAGE(PG8_SB(0, 1), b2 + hstepB, voffB);
            PG8_WAIT_V(6); PG8_BAR; PG8_MMA(1, 1, At, B1); PG8_BAR;
            PG8_LDB(B0, 1, 0); PG8_SCHED; PG8_LDA(At, 1, 0); PG8_STAGE(PG8_SA(0, 1), a2 + hstepA, voffA);
            PG8_WAIT_L(8); PG8_BAR; PG8_WAIT_L(0); PG8_MMA(0, 0, At, B0); PG8_BAR; PG8_SCHED;
            PG8_LDB(B1, 1, 1); PG8_STAGE(PG8_SB(1, 0), b3, voffB);
            PG8_BAR; PG8_WAIT_L(0); PG8_MMA(0, 1, At, B1); PG8_BAR;
            PG8_LDA(At, 1, 1); PG8_STAGE(PG8_SA(1, 0), a3, voffA);
            PG8_BAR; PG8_WAIT_L(0); PG8_MMA(1, 0, At, B0); PG8_BAR; PG8_SCHED;
            PG8_STAGE(PG8_SB(1, 1), b3 + hstepB, voffB);
            PG8_WAIT_V(6); PG8_BAR; PG8_MMA(1, 1, At, B1); PG8_BAR;
            }
        }
        if constexpr (ALIGN_EPI) { if (wr == 0) PG8_BAR; }
        if constexpr (!Epi::AFTER_DRAIN) { E(acc, cur, wr, wc, fr, fq); S.done(cur); }
        if (!has_next) break;
#pragma unroll
        for (int a = 0; a < 2; ++a)
#pragma unroll
            for (int b = 0; b < 2; ++b)
#pragma unroll
                for (int m = 0; m < 4; ++m)
#pragma unroll
                    for (int n = 0; n < 2; ++n) acc[a][b][m][n] = (f32x4){0.f, 0.f, 0.f, 0.f};
        cur = nxt; cA = nA; cB = nB; ++ui;
        if constexpr (ALIGN_EPI) { if (wr == 1) PG8_BAR; }
    }
    PG8_WAIT_V(0);
    if constexpr (!ALIGN_EPI) { if (wr == 0) PG8_BAR; }
    PG8_BAR;
    if constexpr (Epi::AFTER_DRAIN) { E.fused(acc, cur, wr, wc, fr, fq, lds, wid, lane); S.done(cur); }
#undef PG8_SA
#undef PG8_SB
#undef PG8_STAGE
#undef PG8_LDA
#undef PG8_LDB
#undef PG8_MMA
#undef PG8_WAIT_V
#undef PG8_WAIT_L
#undef PG8_BAR
#undef PG8_SCHED
}
}
#define LAS __attribute__((address_space(3)))
typedef unsigned short bf16;
typedef short bf16x8 __attribute__((ext_vector_type(8)));
typedef float f32x4 __attribute__((ext_vector_type(4)));
typedef float f32x2 __attribute__((ext_vector_type(2)));
typedef float f32x16 __attribute__((ext_vector_type(16)));
typedef unsigned u32x4 __attribute__((ext_vector_type(4)));
typedef unsigned u32x2 __attribute__((ext_vector_type(2)));
#define MFMA32(a, b, c) __builtin_amdgcn_mfma_f32_32x32x16_bf16((a), (b), (c), 0, 0, 0)

constexpr int NWAVES = 8, NTHR = 512;
constexpr int SEQ = 8192, DM = 1024, MROWS = 16384, FF = 2816;
constexpr float EPS = 1e-6f;
constexpr size_t MiB = 1u << 20;
constexpr size_t WS_MOD = 0;
constexpr size_t WS_W = 1 * MiB;
constexpr size_t W_IN = WS_W, W_OUT = WS_W + 18 * MiB, W_UP = WS_W + 20 * MiB, W_DOWN = WS_W + 31 * MiB;
constexpr size_t WS_XN = 38 * MiB;
constexpr size_t WS_BIG = 70 * MiB;
constexpr size_t A_Q = WS_BIG, A_K = WS_BIG + 48 * MiB, A_VT = WS_BIG + 96 * MiB, A_LSE = WS_BIG + 144 * MiB;
constexpr size_t F_A = WS_BIG, F_U = WS_BIG + 88 * MiB;
constexpr size_t G_Q = WS_BIG, G_K = WS_BIG + 16 * MiB, G_R = WS_BIG + 32 * MiB, G_VT = WS_BIG + 64 * MiB, G_GL = WS_BIG + 96 * MiB, G_DEC = WS_BIG + 97 * MiB, G_ST = WS_BIG + 98 * MiB;
constexpr size_t WS_END = 256 * MiB;
static_assert(G_ST + 64 * MiB <= WS_END && F_U + 88 * MiB <= WS_END && A_LSE + 2 * MiB <= WS_END, "ws map");
constexpr int LDS_BYTES = 147456;

__device__ __forceinline__ float wave_sum(float v, int lane) {
#pragma unroll
    for (int o = 1; o < 64; o <<= 1) v += __int_as_float(__builtin_amdgcn_ds_bpermute((lane ^ o) << 2, __float_as_int(v)));
    return v;
}
__device__ __forceinline__ float xor32_max(float v) { auto rr = __builtin_amdgcn_permlane32_swap(__float_as_uint(v), __float_as_uint(v), false, false); return fmaxf(__uint_as_float(rr[0]), __uint_as_float(rr[1])); }
__device__ __forceinline__ float xor32_sum(float v) { auto rr = __builtin_amdgcn_permlane32_swap(__float_as_uint(v), __float_as_uint(v), false, false); return __uint_as_float(rr[0]) + __uint_as_float(rr[1]); }
__device__ __forceinline__ unsigned pkbf(float lo, float hi) { return pg8::cvt_pk_bf16(lo, hi); }
__device__ __forceinline__ float bflo(unsigned w) { return __uint_as_float(w << 16); }
__device__ __forceinline__ float bfhi(unsigned w) { return __uint_as_float(w & 0xffff0000u); }
__device__ __forceinline__ float silu_f(float x) { return x * __builtin_amdgcn_rcpf(1.0f + __builtin_amdgcn_exp2f(-1.4426950408889634f * x)); }
__device__ __forceinline__ int crow(int r, int hi) { return (r & 3) + 8 * (r >> 2) + 4 * hi; }
__device__ __forceinline__ bf16x8 pack8(const f32x16& x, int s) {
    u32x4 p; p.x = pkbf(x[8 * s], x[8 * s + 1]); p.y = pkbf(x[8 * s + 2], x[8 * s + 3]); p.z = pkbf(x[8 * s + 4], x[8 * s + 5]); p.w = pkbf(x[8 * s + 6], x[8 * s + 7]);
    return __builtin_bit_cast(bf16x8, p);
}
__device__ __forceinline__ bf16x8 ld2x8(const bf16* p) {
    const u32x2 a = *(const u32x2*)p, b = *(const u32x2*)(p + 8); u32x4 r; r.x = a.x; r.y = a.y; r.z = b.x; r.w = b.y; return __builtin_bit_cast(bf16x8, r);
}

__device__ __forceinline__ int remap_col(int mode, int n) {
    if (mode == 1) { const int blk = n >> 10, rest = n & 1023, which = blk / 3, g = blk - which * 3; return g * 3072 + which * 1024 + rest; }
    if (mode == 2) { return n < 2048 ? n : (n < 2064 ? 3072 + (n - 2048) : n - 16); }
    return n;
}
__device__ __forceinline__ void transpose_item(const float* W, int K, int N, bf16* WT, int mode, LAS float* scr, int item, int lane) {
    const int nblk = (N + 31) / 32, kb = item / nblk, nb = item % nblk, k0 = 64 * kb, n0 = 32 * nb;
    const int ncol = n0 + (lane & 31); const bool ok = ncol < N;
#pragma unroll 8
    for (int i = 0; i < 32; ++i) { const int kk = 2 * i + (lane >> 5); scr[kk * 33 + (lane & 31)] = ok ? W[(size_t)(k0 + kk) * N + ncol] : 0.f; }
    asm volatile("s_waitcnt lgkmcnt(0)" ::: "memory");
    const int c = lane & 7;
#pragma unroll
    for (int j = 0; j < 4; ++j) { const int n = (lane >> 3) + 8 * j; const LAS float* s = scr + (8 * c) * 33 + n;
        u32x4 o; o.x = pkbf(s[0 * 33], s[1 * 33]); o.y = pkbf(s[2 * 33], s[3 * 33]); o.z = pkbf(s[4 * 33], s[5 * 33]); o.w = pkbf(s[6 * 33], s[7 * 33]);
        if (n0 + n < N) *(u32x4*)(WT + (size_t)remap_col(mode, n0 + n) * K + k0 + 8 * c) = o; }
    asm volatile("s_waitcnt lgkmcnt(0)" ::: "memory");
}
__device__ __forceinline__ void modulate_phase(const float* xin, bf16* xn, const float* gain, const float* shift, const float* scale  , int gw, int ngw, int lane) {
    for (int b = 0; b < 2; ++b) {
        f32x4 A[4], B[4];
#pragma unroll
        for (int j = 0; j < 4; ++j) { const int c = 256 * j + 4 * lane; const f32x4 g = *(const f32x4*)(gain + c), sc = *(const f32x4*)(scale + b * 6144 + c); A[j] = g * (1.0f + sc); B[j] = *(const f32x4*)(shift + b * 6144 + c); }
        for (int m0 = gw; m0 < SEQ; m0 += 4 * ngw) {
            f32x4 v[4][4]; float s[4];
#pragma unroll
            for (int r = 0; r < 4; ++r) { const int m = m0 + r * ngw; s[r] = 0.f;
                if (m < SEQ) { const f32x4* xr = (const f32x4*)(xin + ((size_t)b * SEQ + m) * DM) + lane;
#pragma unroll
                    for (int j = 0; j < 4; ++j) v[r][j] = xr[64 * j]; } }
#pragma unroll
            for (int r = 0; r < 4; ++r) { if (m0 + r * ngw < SEQ) {
#pragma unroll
                for (int j = 0; j < 4; ++j) s[r] += (v[r][j].x * v[r][j].x + v[r][j].y * v[r][j].y) + (v[r][j].z * v[r][j].z + v[r][j].w * v[r][j].w); } }
#pragma unroll
            for (int r = 0; r < 4; ++r) s[r] = wave_sum(s[r], lane);
#pragma unroll
            for (int r = 0; r < 4; ++r) { const int m = m0 + r * ngw;
                if (m < SEQ) { const float rs = 1.0f / sqrtf(s[r] * (1.0f / DM) + EPS); u32x2* o8 = (u32x2*)(xn + ((size_t)b * SEQ + m) * DM) + lane;
#pragma unroll
                    for (int j = 0; j < 4; ++j) { const f32x4 y = v[r][j] * rs * A[j] + B[j]; u32x2 w; w.x = pkbf(y.x, y.y); w.y = pkbf(y.z, y.w); o8[64 * j] = w; } } }
        }
    }
}
__device__ __forceinline__ void final_norm_phase(const float* xin, float* out, const float* gain, int gw, int ngw, int lane) {
    f32x4 A[4];
#pragma unroll
    for (int j = 0; j < 4; ++j) A[j] = *(const f32x4*)(gain + 256 * j + 4 * lane);
    for (int m0 = gw; m0 < MROWS; m0 += 4 * ngw) {
        f32x4 v[4][4]; float s[4];
#pragma unroll
        for (int r = 0; r < 4; ++r) { const int m = m0 + r * ngw; s[r] = 0.f;
            if (m < MROWS) { const f32x4* xr = (const f32x4*)(xin + (size_t)m * DM) + lane;
#pragma unroll
                for (int j = 0; j < 4; ++j) v[r][j] = xr[64 * j]; } }
#pragma unroll
        for (int r = 0; r < 4; ++r) { if (m0 + r * ngw < MROWS) {
#pragma unroll
            for (int j = 0; j < 4; ++j) s[r] += (v[r][j].x * v[r][j].x + v[r][j].y * v[r][j].y) + (v[r][j].z * v[r][j].z + v[r][j].w * v[r][j].w); } }
#pragma unroll
        for (int r = 0; r < 4; ++r) s[r] = wave_sum(s[r], lane);
#pragma unroll
        for (int r = 0; r < 4; ++r) { const int m = m0 + r * ngw;
            if (m < MROWS) { const float rs = 1.0f / sqrtf(s[r] * (1.0f / DM) + EPS); f32x4* o = (f32x4*)(out + (size_t)m * DM) + lane;
#pragma unroll
                for (int j = 0; j < 4; ++j) o[64 * j] = v[r][j] * rs * A[j]; } }
    }
}

__device__ __forceinline__ void attn_phase(LAS unsigned char* lds, bf16* Qg, const bf16* Kg, const bf16* VT, float* LSE, int tid, int bid) {
    const int lane = tid & 63, wave = __builtin_amdgcn_readfirstlane(tid >> 6), q = lane & 31, hi = lane >> 5;
    LAS unsigned char* Ks = lds;
    LAS unsigned char* Vs = lds + 55296;
    const int G = gridDim.x;
    u32x4 kreg[6], vreg[6];
#define ATT_LOAD(bu_) do { const int qb_ = (bu_) & 31, h_ = ((bu_) >> 5) & 15, g_ = (bu_) >> 9; const int L_ = (g_ == 0) ? 8192 : (g_ == 1 ? 2048 : 512); \
        const int n0b_ = 256 * qb_; const bool first_ = (n0b_ & (L_ - 1)) == 0; \
        const bf16* Kb_ = Kg + ((size_t)g_ * 8192 + n0b_ - 128) * 1024 + h_ * 64; const bf16* Vb_ = VT + ((size_t)g_ * 1024 + h_ * 64) * 8192 + (n0b_ - 128); \
        _Pragma("unroll") for (int i_ = 0; i_ < 6; ++i_) { const int idx_ = tid + 512 * i_; const int row_ = idx_ >> 3, ch_ = idx_ & 7, e_ = idx_ / 48, cv_ = idx_ - e_ * 48; \
            if (!first_ || row_ >= 128) kreg[i_] = *(const u32x4*)(Kb_ + (size_t)row_ * 1024 + ch_ * 8); \
            if (!first_ || cv_ >= 16) vreg[i_] = *(const u32x4*)(Vb_ + (size_t)e_ * 8192 + cv_ * 8); } } while (0)
    if (bid < 1536) ATT_LOAD(bid);
    for (int bu = bid; bu < 1536; bu += G) {
        asm volatile("" : "+v"(tid));
        const int qb = bu & 31, h = (bu >> 5) & 15, g = bu >> 9;
        const int L = (g == 0) ? 8192 : (g == 1 ? 2048 : 512);
        const int n0 = 256 * qb + 32 * wave, m0 = n0 & (L - 1);
        const int kt_lo = (m0 >= 128) ? 0 : ((128 - m0) >> 5);
        bf16* Qp = Qg + ((size_t)g * 8192 + n0 + q) * 1024 + h * 64;
        bf16x8 qf[4];
#pragma unroll
        for (int s = 0; s < 4; ++s) qf[s] = *(const bf16x8*)(Qp + 16 * s + 8 * hi);
        __syncthreads();
#pragma unroll
        for (int i = 0; i < 6; ++i) { const int idx = tid + 512 * i; const int row = idx >> 3, ch = idx & 7, e = idx / 48, cv = idx - e * 48;
            *(LAS u32x4*)(Ks + row * 144 + ch * 16) = kreg[i]; *(LAS u32x4*)(Vs + e * 784 + cv * 16) = vreg[i]; }
        __syncthreads();
        if (bu + G < 1536) ATT_LOAD(bu + G);
        f32x16 S[5];
#pragma unroll
        for (int kt = 0; kt < 5; ++kt) {
            f32x16 acc;
#pragma unroll
            for (int r = 0; r < 16; ++r) acc[r] = 0.f;
            if (kt >= kt_lo) {
                const LAS unsigned char* Kp = Ks + (32 * wave + 32 * kt + q) * 144 + 16 * hi;
#pragma unroll
                for (int s = 0; s < 4; ++s) { const bf16x8 kf = *(const LAS bf16x8*)(Kp + 32 * s); acc = MFMA32(kf, qf[s], acc); }
            }
#pragma unroll
            for (int r = 0; r < 16; ++r) {
                const int kk = crow(r, hi);
                bool valid = kt >= kt_lo;
                if (kt == 0) valid = valid && (kk >= q);
                if (kt == 4) valid = valid && (kk <= q);
                acc[r] = valid ? acc[r] : -1e30f;
            }
            S[kt] = acc;
        }
        float mx = -1e30f;
#pragma unroll
        for (int kt = 0; kt < 5; ++kt)
#pragma unroll
            for (int r = 0; r < 16; ++r) mx = fmaxf(mx, S[kt][r]);
        mx = xor32_max(mx);
        const float c2 = 0.125f * 1.4426950408889634f;
        float l = 0.f;
#pragma unroll
        for (int kt = 0; kt < 5; ++kt)
#pragma unroll
            for (int r = 0; r < 16; ++r) { const float p = exp2f((S[kt][r] - mx) * c2); S[kt][r] = p; l += p; }
        l = xor32_sum(l);
        f32x16 O[2];
#pragma unroll
        for (int r = 0; r < 16; ++r) { O[0][r] = 0.f; O[1][r] = 0.f; }
#pragma unroll
        for (int kt = 0; kt < 5; ++kt) {
            if (kt >= kt_lo) {
#pragma unroll
                for (int jj = 0; jj < 2; ++jj) {
                    const bf16x8 pf = pack8(S[kt], jj);
#pragma unroll
                    for (int et = 0; et < 2; ++et) {
                        const LAS unsigned char* Vp = Vs + (32 * et + q) * 784 + (32 * wave + 32 * kt + 16 * jj + 4 * hi) * 2;
                        const u32x2 a = *(const LAS u32x2*)Vp, b = *(const LAS u32x2*)(Vp + 16); u32x4 vv; vv.x = a.x; vv.y = a.y; vv.z = b.x; vv.w = b.y;
                        O[et] = MFMA32(__builtin_bit_cast(bf16x8, vv), pf, O[et]);
                    }
                }
            }
        }
        const float inv = 1.0f / l;
#pragma unroll
        for (int et = 0; et < 2; ++et)
#pragma unroll
            for (int rg = 0; rg < 4; ++rg) { u32x2 w; w.x = pkbf(O[et][4 * rg] * inv, O[et][4 * rg + 1] * inv); w.y = pkbf(O[et][4 * rg + 2] * inv, O[et][4 * rg + 3] * inv);
                *(u32x2*)(Qp + 32 * et + 8 * rg + 4 * hi) = w; }
        if (hi == 0) LSE[((size_t)g * 8192 + n0 + q) * 16 + h] = mx * 0.125f + __logf(l);
    }
#undef ATT_LOAD
}
__device__ __forceinline__ void combine_phase(const bf16* Qg, const float* LSE, bf16* O  , int gtid, int nthr) {
    for (int i = gtid; i < 8192 * 128; i += nthr) {
        const int t = i >> 7, ch = i & 127, head = ch >> 3;
        int np[3]; np[0] = t; np[1] = (t & 3) * 2048 + (t >> 2); np[2] = (t & 15) * 512 + (t >> 4);
        float ls[3];
#pragma unroll
        for (int g = 0; g < 3; ++g) ls[g] = LSE[((size_t)g * 8192 + np[g]) * 16 + head];
        const float mx = fmaxf(ls[0], fmaxf(ls[1], ls[2]));
        float w[3]; float sw = 0.f;
#pragma unroll
        for (int g = 0; g < 3; ++g) { w[g] = __expf(ls[g] - mx); sw += w[g]; }
        const float isw = 1.0f / sw;
        float acc[8];
#pragma unroll
        for (int e = 0; e < 8; ++e) acc[e] = 0.f;
#pragma unroll
        for (int g = 0; g < 3; ++g) { const u32x4 v = *(const u32x4*)(Qg + ((size_t)g * 8192 + np[g]) * 1024 + 8 * ch); const float wg = w[g] * isw;
            acc[0] += wg * bflo(v.x); acc[1] += wg * bfhi(v.x); acc[2] += wg * bflo(v.y); acc[3] += wg * bfhi(v.y);
            acc[4] += wg * bflo(v.z); acc[5] += wg * bfhi(v.z); acc[6] += wg * bflo(v.w); acc[7] += wg * bfhi(v.w); }
        u32x4 o; o.x = pkbf(acc[0], acc[1]); o.y = pkbf(acc[2], acc[3]); o.z = pkbf(acc[4], acc[5]); o.w = pkbf(acc[6], acc[7]);
        *(u32x4*)(O + (size_t)t * 1024 + 8 * ch) = o;
    }
}

__device__ __forceinline__ void convgate_phase(const bf16* Ab, bf16* Ub, const float* cw, const float* cb, int gtid, int nthr) {
    for (int it = gtid; it < 1024 * 352; it += nthr) {
        const int rb = it / 352, ch = it - rb * 352, col = ch * 8, row0 = rb * 16;
        float w0[8], w1[8], w2[8], bb[8], a2[8], a1[8];
#pragma unroll
        for (int e = 0; e < 8; ++e) { w0[e] = cw[col + e]; w1[e] = cw[FF + col + e]; w2[e] = cw[2 * FF + col + e]; bb[e] = cb[col + e]; a2[e] = 0.f; a1[e] = 0.f; }
        if ((row0 & (SEQ - 1)) != 0) {
            const u32x4 p2 = *(const u32x4*)(Ab + (size_t)(row0 - 2) * FF + col), p1 = *(const u32x4*)(Ab + (size_t)(row0 - 1) * FF + col);
            a2[0] = bflo(p2.x); a2[1] = bfhi(p2.x); a2[2] = bflo(p2.y); a2[3] = bfhi(p2.y); a2[4] = bflo(p2.z); a2[5] = bfhi(p2.z); a2[6] = bflo(p2.w); a2[7] = bfhi(p2.w);
            a1[0] = bflo(p1.x); a1[1] = bfhi(p1.x); a1[2] = bflo(p1.y); a1[3] = bfhi(p1.y); a1[4] = bflo(p1.z); a1[5] = bfhi(p1.z); a1[6] = bflo(p1.w); a1[7] = bfhi(p1.w);
        }
#pragma unroll 8
        for (int r = 0; r < 16; ++r) {
            const size_t off = (size_t)(row0 + r) * FF + col;
            const u32x4 pa = *(const u32x4*)(Ab + off), pu = *(const u32x4*)(Ub + off);
            float a[8], uu[8], o[8];
            a[0] = bflo(pa.x); a[1] = bfhi(pa.x); a[2] = bflo(pa.y); a[3] = bfhi(pa.y); a[4] = bflo(pa.z); a[5] = bfhi(pa.z); a[6] = bflo(pa.w); a[7] = bfhi(pa.w);
            uu[0] = bflo(pu.x); uu[1] = bfhi(pu.x); uu[2] = bflo(pu.y); uu[3] = bfhi(pu.y); uu[4] = bflo(pu.z); uu[5] = bfhi(pu.z); uu[6] = bflo(pu.w); uu[7] = bfhi(pu.w);
#pragma unroll
            for (int e = 0; e < 8; ++e) { const float y = w0[e] * a2[e] + w1[e] * a1[e] + w2[e] * a[e] + bb[e]; o[e] = silu_f(y) * uu[e]; a2[e] = a1[e]; a1[e] = a[e]; }
            u32x4 w; w.x = pkbf(o[0], o[1]); w.y = pkbf(o[2], o[3]); w.z = pkbf(o[4], o[5]); w.w = pkbf(o[6], o[7]);
            *(u32x4*)(Ub + off) = w;
        }
    }
}
__device__ __forceinline__ void gla_g3_phase(LAS unsigned char* lds, bf16* Qb, bf16* Kb, const bf16* VT, const float* GL, const float* w_gate, const float* b_gate, float* DEC, bf16* ST, int G) {
    LAS float* Bc = (LAS float*)lds;
    LAS float* SEG = (LAS float*)(lds + 32768);
    LAS bf16* KET = (LAS bf16*)(lds + 36864);
    const int tid = threadIdx.x, lane = tid & 63, wave = tid >> 6, hi = lane >> 5, l31 = lane & 31;
    for (int item = blockIdx.x; item < 1024; item += G) {
        const int h = item & 3, c = (item >> 2) & 127, b = item >> 9; const size_t t0 = (size_t)b * SEQ + 64 * c;
        {
            const int k = tid & 127, jq = tid >> 7;
            float wg[16];
#pragma unroll
            for (int i = 0; i < 16; ++i) wg[i] = w_gate[i * 512 + h * 128 + k];
            const float bg = b_gate[h * 128 + k];
            float run = 0.f;
            for (int jj = 0; jj < 16; ++jj) { const int j = jq * 16 + jj; const float* gp = GL + (t0 + j) * 16; float z = bg;
#pragma unroll
                for (int i = 0; i < 16; ++i) z += gp[i] * wg[i];
                const float ls = fminf(z, 0.f) - log1pf(__expf(-fabsf(z)));
                run += ls * (1.0f / 16.0f); Bc[j * 128 + k] = run; }
            SEG[jq * 128 + k] = run;
            __syncthreads();
            float off = 0.f;
            for (int qq = 0; qq < jq; ++qq) off += SEG[qq * 128 + k];
            for (int jj = 0; jj < 16; ++jj) Bc[(jq * 16 + jj) * 128 + k] += off;
            __syncthreads();
            if (tid < 128) DEC[(size_t)item * 128 + tid] = __expf(Bc[63 * 128 + tid]);
        }
#pragma unroll
        for (int i = 0; i < 2; ++i) { const int idx = tid + 512 * i, j = idx >> 4, kc = (idx & 15) * 8;
            bf16* qp = Qb + (t0 + j) * 512 + h * 128 + kc; bf16* kp = Kb + (t0 + j) * 512 + h * 128 + kc;
            const u32x4 qv = *(const u32x4*)qp, kv = *(const u32x4*)kp;
            float qf[8], kf[8], qd[8], kd[8];
            qf[0] = bflo(qv.x); qf[1] = bfhi(qv.x); qf[2] = bflo(qv.y); qf[3] = bfhi(qv.y); qf[4] = bflo(qv.z); qf[5] = bfhi(qv.z); qf[6] = bflo(qv.w); qf[7] = bfhi(qv.w);
            kf[0] = bflo(kv.x); kf[1] = bfhi(kv.x); kf[2] = bflo(kv.y); kf[3] = bfhi(kv.y); kf[4] = bflo(kv.z); kf[5] = bfhi(kv.z); kf[6] = bflo(kv.w); kf[7] = bfhi(kv.w);
#pragma unroll
            for (int e = 0; e < 8; ++e) { const float bv = Bc[j * 128 + kc + e], bl = Bc[63 * 128 + kc + e];
                qd[e] = qf[e] * 0.08838834764831845f * __expf(bv); kd[e] = kf[e] * __expf(-bv);
                const float ke = kf[e] * __expf(bl - bv); KET[(kc + e) * 72 + j] = (bf16)(pkbf(ke, ke) & 0xffffu); }
            u32x4 qo, ko; qo.x = pkbf(qd[0], qd[1]); qo.y = pkbf(qd[2], qd[3]); qo.z = pkbf(qd[4], qd[5]); qo.w = pkbf(qd[6], qd[7]);
            ko.x = pkbf(kd[0], kd[1]); ko.y = pkbf(kd[2], kd[3]); ko.z = pkbf(kd[4], kd[5]); ko.w = pkbf(kd[6], kd[7]);
            *(u32x4*)qp = qo; *(u32x4*)kp = ko; }
        __syncthreads();
        {
            f32x16 acc[4];
#pragma unroll
            for (int kt = 0; kt < 4; ++kt)
#pragma unroll
                for (int r = 0; r < 16; ++r) acc[kt][r] = 0.f;
            const bf16* Vp = VT + (size_t)(h * 256 + 32 * wave + l31) * MROWS + t0 + 8 * hi;
#pragma unroll
            for (int s = 0; s < 4; ++s) { const bf16x8 vf = *(const bf16x8*)(Vp + 16 * s);
#pragma unroll
                for (int kt = 0; kt < 4; ++kt) { const bf16x8 af = *(const LAS bf16x8*)(KET + (32 * kt + l31) * 72 + 16 * s + 8 * hi); acc[kt] = MFMA32(af, vf, acc[kt]); } }
            bf16* Sp = ST + ((size_t)item * 256 + 32 * wave + l31) * 128;
#pragma unroll
            for (int kt = 0; kt < 4; ++kt)
#pragma unroll
                for (int rg = 0; rg < 4; ++rg) { u32x2 w; w.x = pkbf(acc[kt][4 * rg], acc[kt][4 * rg + 1]); w.y = pkbf(acc[kt][4 * rg + 2], acc[kt][4 * rg + 3]);
                    *(u32x2*)(Sp + 32 * kt + 8 * rg + 4 * hi) = w; }
        }
        __syncthreads();
    }
}
__device__ __forceinline__ void gla_scan_phase(bf16* ST, const float* DEC, int gtid, int nthr) {
    for (int e = gtid; e < 2 * 4 * 256 * 64; e += nthr) {
        const int kp = e & 63, v = (e >> 6) & 255, h = (e >> 14) & 3, b = e >> 16;
        float s0 = 0.f, s1 = 0.f;
        for (int c0 = 0; c0 < 128; c0 += 16) {
            unsigned ds[16]; f32x2 dc[16];
#pragma unroll
            for (int u = 0; u < 16; ++u) { const size_t item = (size_t)(b * 128 + c0 + u) * 4 + h; ds[u] = *(const unsigned*)(ST + (item * 256 + v) * 128 + 2 * kp); dc[u] = *(const f32x2*)(DEC + item * 128 + 2 * kp); }
#pragma unroll
            for (int u = 0; u < 16; ++u) { const size_t item = (size_t)(b * 128 + c0 + u) * 4 + h;
                *(unsigned*)(ST + (item * 256 + v) * 128 + 2 * kp) = pkbf(s0, s1); s0 = dc[u].x * s0 + bflo(ds[u]); s1 = dc[u].y * s1 + bfhi(ds[u]); }
        }
    }
}
__device__ __forceinline__ void gla_g5_phase(LAS unsigned char* lds, const bf16* Qb, const bf16* Kb, const bf16* VT, const bf16* Rb, const bf16* ST, const float* gain, bf16* O, int G) {
    LAS float* red = (LAS float*)lds;
    const int tid = threadIdx.x, lane = tid & 63, wave = tid >> 6, hi = lane >> 5, l31 = lane & 31;
    const int it = wave & 1, vp = wave >> 1;
    for (int item = blockIdx.x; item < 1024; item += G) {
        const int h = item & 3, c = (item >> 2) & 127, b = item >> 9; const size_t t0 = (size_t)b * SEQ + 64 * c;
        bf16x8 qf[8];
        const bf16* Qp = Qb + (t0 + 32 * it + l31) * 512 + h * 128 + 8 * hi;
#pragma unroll
        for (int s = 0; s < 8; ++s) qf[s] = *(const bf16x8*)(Qp + 16 * s);
        f32x16 AT[2];
#pragma unroll
        for (int jt = 0; jt < 2; ++jt) {
            f32x16 acc;
#pragma unroll
            for (int r = 0; r < 16; ++r) acc[r] = 0.f;
            if (jt <= it) {
                const bf16* Kp = Kb + (t0 + 32 * jt + l31) * 512 + h * 128 + 8 * hi;
#pragma unroll
                for (int s = 0; s < 8; ++s) { const bf16x8 kf = *(const bf16x8*)(Kp + 16 * s); acc = MFMA32(kf, qf[s], acc); }
                if (jt == it) {
#pragma unroll
                    for (int r = 0; r < 16; ++r) acc[r] = (crow(r, hi) <= l31) ? acc[r] : 0.f;
                }
            }
            AT[jt] = acc;
        }
        f32x16 Oa[2];
#pragma unroll
        for (int vt = 0; vt < 2; ++vt) {
            f32x16 acc;
#pragma unroll
            for (int r = 0; r < 16; ++r) acc[r] = 0.f;
            const int vcol = 32 * (2 * vp + vt) + l31;
#pragma unroll
            for (int jt = 0; jt < 2; ++jt) {
                if (jt <= it) {
#pragma unroll
                    for (int jj = 0; jj < 2; ++jj) { const bf16* Vp = VT + (size_t)(h * 256 + vcol) * MROWS + t0 + 32 * jt + 16 * jj + 4 * hi; acc = MFMA32(ld2x8(Vp), pack8(AT[jt], jj), acc); }
                }
            }
            const bf16* Sp = ST + ((size_t)item * 256 + vcol) * 128 + 8 * hi;
#pragma unroll
            for (int s = 0; s < 8; ++s) { const bf16x8 sf = *(const bf16x8*)(Sp + 16 * s); acc = MFMA32(sf, qf[s], acc); }
            Oa[vt] = acc;
        }
        float ss = 0.f;
#pragma unroll
        for (int vt = 0; vt < 2; ++vt)
#pragma unroll
            for (int r = 0; r < 16; ++r) ss += Oa[vt][r] * Oa[vt][r];
        ss = xor32_sum(ss);
        if (hi == 0) red[vp * 64 + 32 * it + l31] = ss;
        __syncthreads();
        const float tot = (red[32 * it + l31] + red[64 + 32 * it + l31]) + (red[128 + 32 * it + l31] + red[192 + 32 * it + l31]);
        const float rs = 1.0f / sqrtf(tot * (1.0f / 256.0f) + EPS);
        const size_t row = t0 + 32 * it + l31;
#pragma unroll
        for (int vt = 0; vt < 2; ++vt)
#pragma unroll
            for (int rg = 0; rg < 4; ++rg) { const int vb = 32 * (2 * vp + vt) + 8 * rg + 4 * hi;
                const f32x4 gn = *(const f32x4*)(gain + vb); const u32x2 rr = *(const u32x2*)(Rb + row * 1024 + h * 256 + vb);
                const float o0 = Oa[vt][4 * rg] * rs * gn.x * silu_f(bflo(rr.x)), o1 = Oa[vt][4 * rg + 1] * rs * gn.y * silu_f(bfhi(rr.x));
                const float o2 = Oa[vt][4 * rg + 2] * rs * gn.z * silu_f(bflo(rr.y)), o3 = Oa[vt][4 * rg + 3] * rs * gn.w * silu_f(bfhi(rr.y));
                u32x2 w; w.x = pkbf(o0, o1); w.y = pkbf(o2, o3); *(u32x2*)(O + row * 1024 + h * 256 + vb) = w; }
        __syncthreads();
    }
}

#define XB_TMO      128
#define XB_XCNT(j)  (256  + 64 * (j))
#define XB_XSUB(j)  (1280 + 64 * (j))
#define XB_XGEN(j)  (2304 + 64 * (j))
#define XB_TOP      3328
#define XB_TOPGEN   3392
#define XCD_BAR_WORDS 3456
#define XB_SPIN_CAP (1u << 18)

__device__ __forceinline__ unsigned xb_ld(unsigned* p)              { return __hip_atomic_load(p, __ATOMIC_RELAXED, __HIP_MEMORY_SCOPE_AGENT); }
__device__ __forceinline__ unsigned xb_add(unsigned* p, unsigned v) { return __hip_atomic_fetch_add(p, v, __ATOMIC_RELAXED, __HIP_MEMORY_SCOPE_AGENT); }
__device__ __forceinline__ unsigned xb_xcc_id() { return (unsigned)__builtin_amdgcn_s_getreg((3 << 11) | 20) & 0xFu; }
#define XB_SPIN(cond, bar) do { unsigned _sp = 0; while (cond) { __builtin_amdgcn_s_sleep(1); \
    if ((++_sp & 255u) == 0u) { if (xb_ld(&(bar)[XB_TMO])) break; if (_sp > XB_SPIN_CAP) { atomicAdd(&(bar)[XB_TMO], 1u); break; } } } } while (0)

struct XcdBarrier {
    unsigned* bar; unsigned x;
    volatile LAS unsigned* st;
};

__device__ __forceinline__ XcdBarrier xcd_barrier_post(unsigned* bar, volatile LAS unsigned* st) {
    XcdBarrier b; b.bar = bar; b.x = xb_xcc_id(); b.st = st;
    if (threadIdx.x == 0) (void)xb_add(&bar[XB_XCNT(b.x)], 1u);
    return b;
}
__device__ __forceinline__ void xcd_barrier_complete(unsigned* bar, unsigned x, unsigned& nloc, unsigned& nx) {
    const unsigned G = gridDim.x * gridDim.y * gridDim.z;
    unsigned sum, cnt, mine, sp = 0u;
    for (;;) {
        sum = 0u; cnt = 0u; mine = 0u;
#pragma unroll
        for (unsigned j = 0; j < 16; ++j) { const unsigned c = xb_ld(&bar[XB_XCNT(j)]); sum += c; cnt += (c > 0u) ? 1u : 0u; mine = (j == x) ? c : mine; }
        if (sum == G) break;
        __builtin_amdgcn_s_sleep(1);
        if ((++sp & 255u) == 0u) { if (xb_ld(&bar[XB_TMO])) break; if (sp > XB_SPIN_CAP) { atomicAdd(&bar[XB_TMO], 1u); break; } }
    }
    nloc = mine > 0u ? mine : 1u; nx = cnt > 0u ? cnt : 1u;
}

__device__ __forceinline__ void xcd_barrier(const XcdBarrier& b) {
    asm volatile("s_waitcnt vmcnt(0)" ::: "memory");
    __syncthreads();
    if (threadIdx.x == 0) {
        unsigned* bar = b.bar;
        __builtin_amdgcn_s_waitcnt(0);
        unsigned nloc = b.st[0], nx = b.st[1];
        if (nloc == 0u) { xcd_barrier_complete(bar, b.x, nloc, nx); b.st[0] = nloc; b.st[1] = nx; }
        const unsigned old = xb_add(&bar[XB_XSUB(b.x)], 1u);
        const unsigned gen = old / nloc;
        if (old + 1u == (gen + 1u) * nloc) {
            __builtin_amdgcn_fence(__ATOMIC_RELEASE, "agent");
            asm volatile("s_waitcnt vmcnt(0)" ::: "memory");
            const unsigned og = xb_add(&bar[XB_TOP], 1u);
            const unsigned tg = og / nx;
            if (og + 1u == (tg + 1u) * nx) xb_add(&bar[XB_TOPGEN], 1u);
            else XB_SPIN(xb_ld(&bar[XB_TOPGEN]) == tg, bar);
            __builtin_amdgcn_fence(__ATOMIC_ACQUIRE, "agent");
            xb_add(&bar[XB_XGEN(b.x)], 1u);
            asm volatile("s_waitcnt vmcnt(0)" ::: "memory");
        } else {
            XB_SPIN(xb_ld(&bar[XB_XGEN(b.x)]) == gen, bar);
            __builtin_amdgcn_fence(__ATOMIC_ACQUIRE, "agent");
            asm volatile("s_waitcnt vmcnt(0)" ::: "memory");
        }
    }
    __syncthreads();
}

constexpr size_t WS_BAR = 262144;
constexpr int MISC_OFF = 147200;
struct Params {
    const float *x, *c, *w_ada, *b_ada, *norm_mix, *norm_ffn, *attn_w_in, *attn_w_out, *gla_w_in, *gla_w_gate, *gla_b_gate, *gla_norm, *gla_w_out,
                *ffn_w_up, *ffn_conv_w, *ffn_conv_b, *ffn_w_down, *norm_final;
    float* out; unsigned char* ws;
};

typedef const __attribute__((address_space(4))) Params* kparams_t;
__device__ __forceinline__ kparams_t kp() { kparams_t q = (kparams_t)__builtin_amdgcn_kernarg_segment_ptr(); asm volatile("" : "+s"(q)); return q; }
#define PHASE_IDX int z_; asm volatile("s_mov_b32 %0, 0" : "=s"(z_)); const int tid = (int)threadIdx.x + z_, lane = tid & 63, wave = __builtin_amdgcn_readfirstlane(tid >> 6); \
    const int G = gridDim.x, bid = (int)blockIdx.x + z_, gw = bid * NWAVES + wave, ngw = G * NWAVES, gtid = bid * NTHR + tid, nthr = G * NTHR; \
    unsigned char* ws = kp()->ws; (void)lane; (void)gw; (void)ngw; (void)gtid; (void)nthr; (void)ws;
#define GSYNC_CG() do { asm volatile("s_waitcnt vmcnt(0) lgkmcnt(0)" ::: "memory"); cg::this_grid().sync(); asm volatile("" ::: "memory"); } while (0)
#define GSYNC() do { XcdBarrier b_; b_.bar = (unsigned*)(kp()->ws + WS_BAR); b_.x = xb_xcc_id(); b_.st = (volatile LAS unsigned*)(LDSP + MISC_OFF); xcd_barrier(b_); asm volatile("" ::: "memory"); } while (0)
#ifdef PROBE_GROUP
#define TSBUF ((unsigned long long*)(kp()->ws + 819200))
#undef GSYNC
#define GSYNC() do { XcdBarrier b_; b_.bar = (unsigned*)(kp()->ws + WS_BAR); b_.x = xb_xcc_id(); b_.st = (volatile LAS unsigned*)(LDSP + MISC_OFF); xcd_barrier(b_); asm volatile("" ::: "memory"); \
    if (threadIdx.x == 0 && blockIdx.x == 0) { unsigned long long* tb_ = TSBUF; const unsigned long long k_ = tb_[63]; tb_[k_] = __builtin_amdgcn_s_memrealtime(); tb_[63] = k_ + 1; } } while (0)
#endif
#define LDSP ((LAS unsigned char*)lds_raw)

template <class Epi>
__device__ __forceinline__ void run_gemm(LAS unsigned char* lds, const bf16* A, const bf16* Bt, int M, int N, int K, int dil, int L, int rot, const Epi& E) {
    pg8::Gemm g{A, Bt, M, N, K, dil, L}; pg8::StaticOrder S; const int G = gridDim.x; S.init(M, N, G, (int)((blockIdx.x + rot) % G));
    int z_; asm volatile("s_mov_b32 %0, 0" : "=s"(z_));
    pg8::gemm_phase<Epi, pg8::StaticOrder, true, true>((PG8_LAS unsigned char*)lds, g, S, E, (int)threadIdx.x + z_);
}

#define FFN_BLOCK(layer) do { \
    { PHASE_IDX; const float* ml = (const float*)(ws + WS_MOD) + (size_t)(layer) * 2 * 6144; \
      modulate_phase(kp()->out, (bf16*)(ws + WS_XN), kp()->norm_ffn + (layer) * DM, ml + 3 * 1024, ml + 4 * 1024, gw, ngw, lane); } \
    GSYNC(); \
    { unsigned char* ws = kp()->ws; pg8::EpiUp E{(bf16*)(ws + F_A), (bf16*)(ws + F_U)}; run_gemm(LDSP, (const bf16*)(ws + WS_XN), (const bf16*)(ws + W_UP), MROWS, 2 * FF, DM, 1, MROWS, 0, E); } \
    GSYNC(); \
    { PHASE_IDX; convgate_phase((const bf16*)(ws + F_A), (bf16*)(ws + F_U), kp()->ffn_conv_w + (size_t)(layer) * 3 * FF, kp()->ffn_conv_b + (size_t)(layer) * FF, gtid, nthr); } \
    GSYNC(); \
    { unsigned char* ws = kp()->ws; float* o = kp()->out; pg8::EpiRes E{o, o, (const float*)(ws + WS_MOD) + (size_t)(layer) * 2 * 6144 + 5 * 1024}; \
      run_gemm(LDSP, (const bf16*)(ws + F_U), (const bf16*)(ws + W_DOWN), MROWS, DM, FF, 1, MROWS, 0, E); } \
    GSYNC(); } while (0)

__global__ void __launch_bounds__(NTHR, 2) fwd_kernel(Params p_unused) {
    extern __shared__ __attribute__((aligned(16))) unsigned char lds_raw[];
#ifdef PROBE_GROUP
    if (threadIdx.x == 0 && blockIdx.x == 0) { unsigned long long* tb_ = TSBUF; tb_[62] = __builtin_amdgcn_s_memrealtime(); tb_[63] = 0; }
#endif
    if (threadIdx.x == 0) { volatile LAS unsigned* st_ = (volatile LAS unsigned*)(LDSP + MISC_OFF); st_[0] = 0u; st_[1] = 0u; }
    __syncthreads();
    (void)xcd_barrier_post((unsigned*)(kp()->ws + WS_BAR), (volatile LAS unsigned*)(LDSP + MISC_OFF));
    {
        PHASE_IDX;
        LAS unsigned char* lds = LDSP;
        float* mod = (float*)(ws + WS_MOD);
        LAS float* scr = (LAS float*)(lds + wave * 16384);
        LAS float* red = (LAS float*)(lds + 131072);
        const float* cvec = kp()->c; const float* b_ada = kp()->b_ada;
        for (int it = bid; it < 192; it += G) {
            const int layer = it / 96, ch = it % 96, n = ch * 64 + lane;
            const float* W = kp()->w_ada + (size_t)layer * 1024 * 6144;
            float a0 = 0.f, a1 = 0.f;
#pragma unroll 8
            for (int kk = 0; kk < 128; ++kk) { const int k = wave * 128 + kk; const float wv = W[(size_t)k * 6144 + n]; a0 += silu_f(cvec[k]) * wv; a1 += silu_f(cvec[1024 + k]) * wv; }
            red[(wave * 2 + 0) * 64 + lane] = a0; red[(wave * 2 + 1) * 64 + lane] = a1;
            __syncthreads();
            if (wave == 0) { float t0 = b_ada[layer * 6144 + n], t1 = t0;
                for (int w = 0; w < 8; ++w) { t0 += red[(w * 2) * 64 + lane]; t1 += red[(w * 2 + 1) * 64 + lane]; }
                mod[(size_t)(layer * 2 + 0) * 6144 + n] = t0; mod[(size_t)(layer * 2 + 1) * 6144 + n] = t1; }
            __syncthreads();
        }
        constexpr int I_IN = 16 * 288, I_O = 16 * 32, I_UP = 16 * 176, I_DN = 44 * 32;
        for (int it = gw; it < I_IN + I_O + I_UP + I_DN; it += ngw) {
            int r = it;
            if (r < I_IN) { transpose_item(kp()->attn_w_in, 1024, 9216, (bf16*)(ws + W_IN), 1, scr, r, lane); continue; } r -= I_IN;
            if (r < I_O) { transpose_item(kp()->attn_w_out, 1024, 1024, (bf16*)(ws + W_OUT), 0, scr, r, lane); continue; } r -= I_O;
            if (r < I_UP) { transpose_item(kp()->ffn_w_up, 1024, 2 * FF, (bf16*)(ws + W_UP), 0, scr, r, lane); continue; } r -= I_UP;
            transpose_item(kp()->ffn_w_down, FF, 1024, (bf16*)(ws + W_DOWN), 0, scr, r, lane);
        }
    }
    GSYNC_CG();
#if STAGE >= 1
    { PHASE_IDX; const float* mod = (const float*)(ws + WS_MOD); modulate_phase(kp()->x, (bf16*)(ws + WS_XN), kp()->norm_mix, mod + 0 * 1024, mod + 1 * 1024, gw, ngw, lane); }
    GSYNC();
    for (int b = 0; b < 2; ++b) {
        for (int g = 0; g < 3; ++g) {
            unsigned char* ws = kp()->ws;
            const int dil = (g == 0) ? 1 : (g == 1 ? 4 : 16);
            pg8::EpiAttn E{(bf16*)(ws + A_Q) + (size_t)g * 8192 * 1024, (bf16*)(ws + A_K) + (size_t)g * 8192 * 1024, (bf16*)(ws + A_VT) + (size_t)g * 8192 * 1024};
            run_gemm(LDSP, (const bf16*)(ws + WS_XN) + (size_t)b * SEQ * DM, (const bf16*)(ws + W_IN) + (size_t)g * 3072 * 1024, SEQ, 3072, DM, dil, SEQ / dil, g * 128, E);
        }
        GSYNC();
        { PHASE_IDX; attn_phase(LDSP, (bf16*)(ws + A_Q), (const bf16*)(ws + A_K), (const bf16*)(ws + A_VT), (float*)(ws + A_LSE), tid, bid); }
        GSYNC();
        { PHASE_IDX; combine_phase((const bf16*)(ws + A_Q), (const float*)(ws + A_LSE), (bf16*)(ws + WS_XN) + (size_t)b * SEQ * DM, gtid, nthr); }
        GSYNC();
    }
    { unsigned char* ws = kp()->ws; pg8::EpiRes E{kp()->x, kp()->out, (const float*)(ws + WS_MOD) + 2 * 1024}; run_gemm(LDSP, (const bf16*)(ws + WS_XN), (const bf16*)(ws + W_OUT), MROWS, DM, DM, 1, MROWS, 0, E); }
    GSYNC();
#endif
#if STAGE >= 2
    FFN_BLOCK(0);
#endif
#if STAGE >= 3
    {
        {
            PHASE_IDX;
            const float* ml = (const float*)(ws + WS_MOD) + (size_t)2 * 6144;
            modulate_phase(kp()->out, (bf16*)(ws + WS_XN), kp()->norm_mix + DM, ml + 0 * 1024, ml + 1 * 1024, gw, ngw, lane);
            LAS float* scr = (LAS float*)(LDSP + wave * 16384);
            constexpr int I_IN = 16 * 97, I_O = 16 * 32, I_UP = 16 * 176, I_DN = 44 * 32;
            for (int it = gw; it < I_IN + I_O + I_UP + I_DN; it += ngw) {
                int r = it;
                if (r < I_IN) { transpose_item(kp()->gla_w_in, 1024, 3088, (bf16*)(ws + W_IN), 2, scr, r, lane); continue; } r -= I_IN;
                if (r < I_O) { transpose_item(kp()->gla_w_out, 1024, 1024, (bf16*)(ws + W_OUT), 0, scr, r, lane); continue; } r -= I_O;
                if (r < I_UP) { transpose_item(kp()->ffn_w_up + (size_t)1024 * 2 * FF, 1024, 2 * FF, (bf16*)(ws + W_UP), 0, scr, r, lane); continue; } r -= I_UP;
                transpose_item(kp()->ffn_w_down + (size_t)FF * 1024, FF, 1024, (bf16*)(ws + W_DOWN), 0, scr, r, lane);
            }
            for (int i = gtid; i < 240 * 1024 / 8; i += nthr) ((u32x4*)(ws + W_IN + (size_t)3088 * 1024 * 2))[i] = (u32x4){0u, 0u, 0u, 0u};
        }
        GSYNC();
        { unsigned char* ws = kp()->ws; pg8::EpiGla E{(bf16*)(ws + G_Q), (bf16*)(ws + G_K), (bf16*)(ws + G_VT), (bf16*)(ws + G_R), (float*)(ws + G_GL)};
          run_gemm(LDSP, (const bf16*)(ws + WS_XN), (const bf16*)(ws + W_IN), MROWS, 3328, DM, 1, MROWS, 0, E); }
        GSYNC();
        { PHASE_IDX; gla_g3_phase(LDSP, (bf16*)(ws + G_Q), (bf16*)(ws + G_K), (const bf16*)(ws + G_VT), (const float*)(ws + G_GL), kp()->gla_w_gate, kp()->gla_b_gate, (float*)(ws + G_DEC), (bf16*)(ws + G_ST), G); }
        GSYNC();
        { PHASE_IDX; gla_scan_phase((bf16*)(ws + G_ST), (const float*)(ws + G_DEC), gtid, nthr); }
        GSYNC();
        { PHASE_IDX; gla_g5_phase(LDSP, (const bf16*)(ws + G_Q), (const bf16*)(ws + G_K), (const bf16*)(ws + G_VT), (const bf16*)(ws + G_R), (const bf16*)(ws + G_ST), kp()->gla_norm, (bf16*)(ws + WS_XN), G); }
        GSYNC();
        { unsigned char* ws = kp()->ws; float* o = kp()->out; pg8::EpiRes E{o, o, (const float*)(ws + WS_MOD) + (size_t)2 * 6144 + 2 * 1024}; run_gemm(LDSP, (const bf16*)(ws + WS_XN), (const bf16*)(ws + W_OUT), MROWS, DM, DM, 1, MROWS, 0, E); }
        GSYNC();
    }
#endif
#if STAGE >= 4
    FFN_BLOCK(1);
#endif
    { PHASE_IDX;
#if STAGE >= 1
      final_norm_phase(kp()->out, kp()->out, kp()->norm_final, gw, ngw, lane);
#else
      final_norm_phase(kp()->x, kp()->out, kp()->norm_final, gw, ngw, lane);
#endif
    }
#ifdef PROBE_GROUP
    if (threadIdx.x == 0 && blockIdx.x == 0) {
        unsigned long long* tb_ = TSBUF; const unsigned long long tend = __builtin_amdgcn_s_memrealtime();
        unsigned long long d[24]; d[0] = tb_[0] - tb_[62]; for (int k = 1; k < 23; ++k) d[k] = tb_[k] - tb_[k - 1]; d[23] = tend - tb_[22];
        unsigned long long sel = 0;
        if (PROBE_GROUP == 1) sel = d[2] + d[5] + d[8] + d[10] + d[12] + d[14] + d[18] + d[20] + d[22];
        if (PROBE_GROUP == 2) sel = d[3] + d[6];
        if (PROBE_GROUP == 3) sel = d[15] + d[16] + d[17];
        if (PROBE_GROUP == 4) sel = d[1] + d[9] + d[13] + d[19] + d[23];
        if (PROBE_GROUP == 5) sel = d[11] + d[21];
        if (PROBE_GROUP == 6) sel = d[0];
        if (PROBE_GROUP == 7) sel = d[4] + d[7];
        if (PROBE_GROUP == 8) sel = d[10] + d[20];
        if (PROBE_GROUP == 9) sel = d[2] + d[5];
        if (PROBE_GROUP == 10) sel = d[16];
        if (PROBE_GROUP == 11) sel = d[15];
        const unsigned long long t0 = __builtin_amdgcn_s_memrealtime();
        while (__builtin_amdgcn_s_memrealtime() - t0 < 2 * sel) __builtin_amdgcn_s_sleep(8);
    }
#endif
}

extern "C" void kernel_launch(void* const* d_in, const int* in_sizes, int n_in, void* d_out, int out_size, void* d_ws, size_t ws_size, hipStream_t stream) {
    static int grid = 0;
    if (grid == 0) {
        if (n_in != 18 || ws_size < WS_END) { fprintf(stderr, "kernel_launch: unexpected n_in %d / ws_size %zu\n", n_in, ws_size); grid = -1; return; }
        int dev = 0, cus = 0, per_cu = 0;
        hipGetDevice(&dev);
        hipDeviceGetAttribute(&cus, hipDeviceAttributeMultiprocessorCount, dev);
        hipFuncSetAttribute((const void*)fwd_kernel, hipFuncAttributeMaxDynamicSharedMemorySize, LDS_BYTES);
        hipOccupancyMaxActiveBlocksPerMultiprocessor(&per_cu, (const void*)fwd_kernel, NTHR, LDS_BYTES);
        if (per_cu < 1) { fprintf(stderr, "kernel_launch: occupancy query says %d blocks per CU\n", per_cu); grid = -1; return; }
        grid = cus;
    }
    if (grid < 0) return;
    if (hipMemsetAsync((char*)d_ws + WS_BAR, 0, 16384, stream) != hipSuccess) { fprintf(stderr, "kernel_launch: memset of barrier words failed\n"); return; }
    Params p{};
    const float** pp = (const float**)&p;
    for (int i = 0; i < 18; ++i) pp[i] = (const float*)d_in[i];
    p.out = (float*)d_out; p.ws = (unsigned char*)d_ws;
    void* args[] = {&p};
    hipError_t e = hipLaunchCooperativeKernel((const void*)fwd_kernel, dim3(grid), dim3(NTHR), args, LDS_BYTES, stream);
    if (e != hipSuccess) fprintf(stderr, "cooperative launch failed: %s (grid %d)\n", hipGetErrorString(e), grid);
}
```

```cpp
#include <hip/hip_runtime.h>
#include <hip/hip_cooperative_groups.h>
#include <cstdio>
#include <cstdint>
namespace cg = cooperative_groups;
#ifndef STAGE
#define STAGE 4
#endif
namespace pg8 {
#define PG8_LAS __attribute__((address_space(3)))
typedef unsigned short bf16_t;
typedef short bf16x8 __attribute__((ext_vector_type(8)));
typedef float f32x4 __attribute__((ext_vector_type(4)));
typedef unsigned u32x4 __attribute__((ext_vector_type(4)));
constexpr int BM = 256, BK = 64, HALF = 128, HTB = HALF * BK * 2  , STAGE_BYTES = 8 * HTB, NXCD = 8, WGM = 8;

__host__ __device__ __forceinline__ int lds_byte(int r, int c) { const int st = (r >> 4) * 2 + (c >> 5), rr = r & 15, cc = c & 31, ob = rr * 64 + cc * 2; return st * 1024 + (ob ^ (((ob >> 9) & 1) << 5)); }
__host__ __device__ __forceinline__ void stage_rc(int b, int& R, int& C) { const int st = b / 1024, sb = b % 1024, swz = sb ^ (((sb >> 9) & 1) << 5); R = (st >> 1) * 16 + swz / 64; C = (st & 1) * 32 + (swz % 64) / 2; }
__host__ __device__ __forceinline__ int perm32(int rho) { const int n = rho >> 4, i = rho & 15; return 8 * (i >> 2) + 4 * n + (i & 3); }

struct Unit { int pm, pn; };
struct Gemm { const bf16_t* A; const bf16_t* Bt; int M, N, K; int dil, L;
    __device__ __forceinline__ size_t a_off(int pm) const { const int n0 = pm * 256; return (size_t)((n0 / L) + dil * (n0 % L)) * (size_t)K * 2; } };

struct StaticOrder {
    int nM, nN, nwg, G, c;
    __host__ __device__ void init(int M, int N, int G_, int c_) { nM = M / BM; nN = N / BM; nwg = nM * nN; G = G_; c = c_; }
    __host__ __device__ bool next(int i, Unit& u) const {
        const long L = (long)i * G + c; if (L >= nwg) return false;
        int wgid = (int)L; { const int q = nwg / NXCD, r = nwg % NXCD, xcd = wgid % NXCD, off = wgid / NXCD; wgid = (xcd < r ? xcd * (q + 1) : r * (q + 1) + (xcd - r) * q) + off; }
        const int nig = WGM * nN, gid = wgid / nig, fm = gid * WGM, gsz = (nM - fm) < WGM ? (nM - fm) : WGM;
        u.pm = fm + ((wgid % nig) % gsz); u.pn = (wgid % nig) / gsz; return true;
    }
    __device__ __forceinline__ void a_ready(const Unit&) const {}
    __device__ __forceinline__ void done(const Unit&) const {}
};

typedef unsigned u32x4 __attribute__((ext_vector_type(4)));
typedef float f32x2_t __attribute__((ext_vector_type(2))); typedef __bf16 bf16x2_t __attribute__((ext_vector_type(2)));
__device__ __forceinline__ unsigned cvt_pk_bf16(float lo, float hi) { f32x2_t v = {lo, hi}; bf16x2_t b = __builtin_convertvector(v, bf16x2_t); return __builtin_bit_cast(unsigned, b); }
__device__ __forceinline__ void store_rm_bf16(const f32x4 (&acc)[2][2][4][2], bf16_t* base, int ld, int row0, int col0) {
#pragma unroll
    for (int ai = 0; ai < 2; ++ai)
#pragma unroll
        for (int m = 0; m < 4; ++m) { bf16_t* rowp = base + (size_t)(row0 + ai * HALF + m * 16) * ld + col0;
#pragma unroll
            for (int bj = 0; bj < 2; ++bj) { const f32x4 v0 = acc[ai][bj][m][0], v1 = acc[ai][bj][m][1];
                u32x4 w; w.x = cvt_pk_bf16(v0[0], v0[1]); w.y = cvt_pk_bf16(v0[2], v0[3]); w.z = cvt_pk_bf16(v1[0], v1[1]); w.w = cvt_pk_bf16(v1[2], v1[3]);
                *(u32x4*)(rowp + bj * HALF) = w; } }
}
__device__ __forceinline__ void store_tr_bf16(const f32x4 (&acc)[2][2][4][2], bf16_t* base, size_t pitch, int row0, int col0) {
#pragma unroll
    for (int ai = 0; ai < 2; ++ai)
#pragma unroll
        for (int m = 0; m < 4; ++m) { bf16_t* rp = base + (row0 + ai * HALF + m * 16);
#pragma unroll
            for (int bj = 0; bj < 2; ++bj)
#pragma unroll
                for (int n = 0; n < 2; ++n) { const f32x4 v = acc[ai][bj][m][n]; const unsigned p0 = cvt_pk_bf16(v[0], v[1]), p1 = cvt_pk_bf16(v[2], v[3]);
                    bf16_t* cp = rp + (size_t)(col0 + bj * HALF + 4 * n) * pitch;
                    cp[0] = (bf16_t)(p0 & 0xffffu); cp[pitch] = (bf16_t)(p0 >> 16); cp[2 * pitch] = (bf16_t)(p1 & 0xffffu); cp[3 * pitch] = (bf16_t)(p1 >> 16); } }
}
struct EpiAttn {
    static constexpr bool PERM = true, AFTER_DRAIN = false;
    bf16_t* Q; bf16_t* Kb; bf16_t* VT;
    __device__ __forceinline__ void operator()(const f32x4 (&acc)[2][2][4][2], const Unit& u, int wr, int wc, int fr, int fq) const {
        const int row0 = u.pm * BM + wr * 64 + fr, col0 = (u.pn & 3) * BM + wc * 32 + 8 * fq;
        if (u.pn < 8) store_rm_bf16(acc, u.pn < 4 ? Q : Kb, 1024, row0, col0);
        else store_tr_bf16(acc, VT, 8192, row0, col0);
    }
};
struct EpiGla {
    static constexpr bool PERM = true, AFTER_DRAIN = false;
    bf16_t* Q; bf16_t* Kb; bf16_t* VT; bf16_t* R; float* GL;
    __device__ __forceinline__ void operator()(const f32x4 (&acc)[2][2][4][2], const Unit& u, int wr, int wc, int fr, int fq) const {
        const int row0 = u.pm * BM + wr * 64 + fr, cw = wc * 32 + 8 * fq;
        if (u.pn < 2) store_rm_bf16(acc, Q, 512, row0, u.pn * BM + cw);
        else if (u.pn < 4) store_rm_bf16(acc, Kb, 512, row0, (u.pn - 2) * BM + cw);
        else if (u.pn < 8) store_tr_bf16(acc, VT, 16384, row0, (u.pn - 4) * BM + cw);
        else if (u.pn < 12) store_rm_bf16(acc, R, 1024, row0, (u.pn - 8) * BM + cw);
        else if (wc == 0 && fq < 2) {
#pragma unroll
            for (int ai = 0; ai < 2; ++ai)
#pragma unroll
                for (int m = 0; m < 4; ++m) { float* gp = GL + (size_t)(row0 + ai * HALF + m * 16) * 16 + 8 * fq;
                    *(f32x4*)gp = acc[ai][0][m][0]; *(f32x4*)(gp + 4) = acc[ai][0][m][1]; }
        }
    }
};
struct EpiUp {
    static constexpr bool PERM = true, AFTER_DRAIN = false;
    bf16_t* Ab; bf16_t* Ub;
    __device__ __forceinline__ void operator()(const f32x4 (&acc)[2][2][4][2], const Unit& u, int wr, int wc, int fr, int fq) const {
        const int row0 = u.pm * BM + wr * 64 + fr, cw = wc * 32 + 8 * fq;
        if (u.pn < 11) store_rm_bf16(acc, Ab, 2816, row0, u.pn * BM + cw); else store_rm_bf16(acc, Ub, 2816, row0, (u.pn - 11) * BM + cw);
    }
};
struct EpiRes {
    static constexpr bool PERM = false, AFTER_DRAIN = false;
    const float* base; float* out; const float* gate;
    __device__ __forceinline__ void operator()(const f32x4 (&acc)[2][2][4][2], const Unit& u, int wr, int wc, int fr, int fq) const {
        const int row0 = u.pm * BM + wr * 64 + fr, col0 = u.pn * BM + wc * 32 + 4 * fq;
        const float* gp = gate + (size_t)((u.pm * BM) >> 13) * 6144 + col0;
        f32x4 gv[2][2];
#pragma unroll
        for (int bj = 0; bj < 2; ++bj)
#pragma unroll
            for (int n = 0; n < 2; ++n) gv[bj][n] = *(const f32x4*)(gp + bj * HALF + n * 16);
#pragma unroll
        for (int ai = 0; ai < 2; ++ai)
#pragma unroll
            for (int m = 0; m < 4; ++m) { const size_t off = (size_t)(row0 + ai * HALF + m * 16) * 1024 + col0;
#pragma unroll
                for (int bj = 0; bj < 2; ++bj)
#pragma unroll
                    for (int n = 0; n < 2; ++n) { const f32x4 bs = *(const f32x4*)(base + off + bj * HALF + n * 16);
                        *(f32x4*)(out + off + bj * HALF + n * 16) = bs + gv[bj][n] * acc[ai][bj][m][n]; } }
    }
};
template <class Epi, class Sched, bool ALIGN_EPI = false, bool SP2 = false>
__device__ __forceinline__ void gemm_phase(PG8_LAS unsigned char* lds, const Gemm g, const Sched& S, const Epi& E, const int tid_in) {
    const int tid = tid_in, wid = __builtin_amdgcn_readfirstlane(tid >> 6), lane = tid & 63, wr = wid >> 2, wc = wid & 3, fr = lane & 15, fq = lane >> 4;
    const int K = g.K, nt = K / BK, lda = g.dil * K;
    unsigned voffA[2], voffB[2];
#pragma unroll
    for (int i = 0; i < 2; ++i) { int R, C; stage_rc(tid * 16 + i * 8192, R, C); const int Rb = Epi::PERM ? ((R & ~31) + perm32(R & 31)) : R;
        voffA[i] = (unsigned)(R * lda + C) * 2u; voffB[i] = (unsigned)(Rb * K + C) * 2u; }
    const size_t kstep = (size_t)(BK * 2);
     const size_t hstepA = (size_t)HALF * lda * 2, hstepB = (size_t)HALF * K * 2;
    const size_t tstepB = 2 * hstepB;
    const unsigned ldsw = (unsigned)wid * 1024u;
    const int aoff = lds_byte(wr * 64 + fr, fq * 8), boff = lds_byte(wc * 32 + fr, fq * 8);
#define PG8_SA(b, h) (((b) * 2 + (h)) * HTB)
#define PG8_SB(b, h) ((4 + (b) * 2 + (h)) * HTB)
#define PG8_STAGE(bufoff, gbase, voff) do { _Pragma("unroll") for (int _i = 0; _i < 2; ++_i) \
        __builtin_amdgcn_global_load_lds((const unsigned*)((const char*)(gbase) + (voff)[_i]), (PG8_LAS unsigned*)(lds + (bufoff) + ldsw + _i * 8192), 16, 0, 0); } while (0)
#define PG8_LDA(dst, b, h) do { _Pragma("unroll") for (int m = 0; m < 4; ++m) _Pragma("unroll") for (int k = 0; k < 2; ++k) dst[m][k] = *(const PG8_LAS bf16x8*)(lds + PG8_SA(b, h) + aoff + m * 2048 + k * 1024); } while (0)
#define PG8_LDB(dst, b, h) do { _Pragma("unroll") for (int n = 0; n < 2; ++n) _Pragma("unroll") for (int k = 0; k < 2; ++k) dst[n][k] = *(const PG8_LAS bf16x8*)(lds + PG8_SB(b, h) + boff + n * 2048 + k * 1024); } while (0)
#define PG8_MMA(ai, bj, At, Bt) do { __builtin_amdgcn_s_setprio(1); _Pragma("unroll") for (int m = 0; m < 4; ++m) _Pragma("unroll") for (int n = 0; n < 2; ++n) _Pragma("unroll") for (int k = 0; k < 2; ++k) \
        acc[ai][bj][m][n] = __builtin_amdgcn_mfma_f32_16x16x32_bf16(Bt[n][k], At[m][k], acc[ai][bj][m][n], 0, 0, 0); __builtin_amdgcn_s_setprio(0); } while (0)
#define PG8_WAIT_V(n) asm volatile("s_waitcnt vmcnt(" #n ")" ::: "memory")
#define PG8_WAIT_L(n) asm volatile("s_waitcnt lgkmcnt(" #n ")" ::: "memory")
#define PG8_BAR __builtin_amdgcn_s_barrier()
#define PG8_SCHED __builtin_amdgcn_sched_barrier(0)
    Unit cur, nxt; int ui = 0;
    if (!S.next(0, cur)) return;
    f32x4 acc[2][2][4][2];
#pragma unroll
    for (int a = 0; a < 2; ++a)
#pragma unroll
        for (int b = 0; b < 2; ++b)
#pragma unroll
            for (int m = 0; m < 4; ++m)
#pragma unroll
                for (int n = 0; n < 2; ++n) acc[a][b][m][n] = (f32x4){0.f, 0.f, 0.f, 0.f};
    bf16x8 At[4][2], B0[2][2], B1[2][2];
    const char* cA = (const char*)g.A + g.a_off(cur.pm); const char* cB = (const char*)g.Bt + (size_t)cur.pn * tstepB;
    S.a_ready(cur);
    if constexpr (SP2) {
        PG8_STAGE(PG8_SB(0, 0), cB, voffB); PG8_STAGE(PG8_SB(0, 1), cB + hstepB, voffB); PG8_STAGE(PG8_SA(0, 0), cA, voffA); PG8_STAGE(PG8_SA(0, 1), cA + hstepA, voffA);
        if (wr == 1) PG8_BAR;
        PG8_WAIT_V(2); PG8_BAR;
        PG8_STAGE(PG8_SB(1, 0), cB + kstep, voffB); PG8_STAGE(PG8_SA(1, 0), cA + kstep, voffA); PG8_STAGE(PG8_SB(1, 1), cB + hstepB + kstep, voffB);
        PG8_WAIT_V(6); PG8_BAR;
    } else {
        PG8_STAGE(PG8_SB(0, 0), cB, voffB); PG8_STAGE(PG8_SA(0, 0), cA, voffA); PG8_STAGE(PG8_SB(0, 1), cB + hstepB, voffB); PG8_STAGE(PG8_SA(0, 1), cA + hstepA, voffA);
        if (wr == 1) PG8_BAR;
        PG8_WAIT_V(4); PG8_BAR;
        PG8_STAGE(PG8_SB(1, 0), cB + kstep, voffB); PG8_STAGE(PG8_SA(1, 0), cA + kstep, voffA); PG8_STAGE(PG8_SB(1, 1), cB + hstepB + kstep, voffB);
        PG8_WAIT_V(6); PG8_BAR;
    }
    for (;;) {
        const bool has_next = S.next(ui + 1, nxt);
        const char* nA = has_next ? (const char*)g.A + g.a_off(nxt.pm) : cA; const char* nB = has_next ? (const char*)g.Bt + (size_t)nxt.pn * tstepB : cB;
        for (int t = 0; t < nt; t += 2) {
            const bool last = (t == nt - 2);
            const char* a1 = cA + (size_t)(t + 1) * kstep;
            const char* a2 = last ? nA : cA + (size_t)(t + 2) * kstep; const char* b2 = last ? nB : cB + (size_t)(t + 2) * kstep;
            const char* a3 = a2 + kstep; const char* b3 = b2 + kstep;
            if (last && has_next) S.a_ready(nxt);
            if constexpr (SP2) {
            PG8_LDB(B0, 0, 0); PG8_LDB(B1, 0, 1); PG8_SCHED; PG8_LDA(At, 0, 0); PG8_STAGE(PG8_SA(1, 1), a1 + hstepA, voffA);
            PG8_WAIT_V(8); PG8_WAIT_L(0); PG8_BAR; PG8_MMA(0, 0, At, B0); PG8_MMA(0, 1, At, B1); PG8_BAR; PG8_SCHED;
            PG8_LDA(At, 0, 1); PG8_STAGE(PG8_SB(0, 0), b2, voffB); PG8_STAGE(PG8_SB(0, 1), b2 + hstepB, voffB); PG8_STAGE(PG8_SA(0, 0), a2, voffA);
            PG8_WAIT_V(8); PG8_WAIT_L(0); PG8_BAR; PG8_MMA(1, 0, At, B0); PG8_MMA(1, 1, At, B1); PG8_BAR; PG8_SCHED;
            PG8_LDB(B0, 1, 0); PG8_LDB(B1, 1, 1); PG8_SCHED; PG8_LDA(At, 1, 0); PG8_STAGE(PG8_SA(0, 1), a2 + hstepA, voffA);
            PG8_WAIT_V(8); PG8_WAIT_L(0); PG8_BAR; PG8_MMA(0, 0, At, B0); PG8_MMA(0, 1, At, B1); PG8_BAR; PG8_SCHED;
            PG8_LDA(At, 1, 1); PG8_STAGE(PG8_SB(1, 0), b3, voffB); PG8_STAGE(PG8_SB(1, 1), b3 + hstepB, voffB); PG8_STAGE(PG8_SA(1, 0), a3, voffA);
            PG8_WAIT_V(8); PG8_WAIT_L(0); PG8_BAR; PG8_MMA(1, 0, At, B0); PG8_MMA(1, 1, At, B1); PG8_BAR; PG8_SCHED;
            } else {
            PG8_LDB(B0, 0, 0); PG8_SCHED; PG8_LDA(At, 0, 0); PG8_STAGE(PG8_SA(1, 1), a1 + hstepA, voffA);
            PG8_WAIT_L(8); PG8_BAR; PG8_WAIT_L(0); PG8_MMA(0, 0, At, B0); PG8_BAR; PG8_SCHED;
            PG8_LDB(B1, 0, 1); PG8_STAGE(PG8_SB(0, 0), b2, voffB);
            PG8_BAR; PG8_WAIT_L(0); PG8_MMA(0, 1, At, B1); PG8_BAR;
            PG8_LDA(At, 0, 1); PG8_STAGE(PG8_SA(0, 0), a2, voffA);
            PG8_BAR; PG8_WAIT_L(0); PG8_MMA(1, 0, At, B0); PG8_BAR; PG8_SCHED;
            PG8_STAGE(PG8_SB(0, 1), b2 + hstepB, voffB);
            PG8_WAIT_V(6); PG8_BAR; PG8_MMA(1, 1, At, B1); PG8_BAR;
            PG8_LDB(B0, 1, 0); PG8_SCHED; PG8_LDA(At, 1, 0); PG8_STAGE(PG8_SA(0, 1), a2 + hstepA, voffA);
            PG8_WAIT_L(8); PG8_BAR; PG8_WAIT_L(0); PG8_MMA(0, 0, At, B0); PG8_BAR; PG8_SCHED;
            PG8_LDB(B1, 1, 1); PG8_STAGE(PG8_SB(1, 0), b3, voffB);
            PG8_BAR; PG8_WAIT_L(0); PG8_MMA(0, 1, At, B1); PG8_BAR;
            PG8_LDA(At, 1, 1); PG8_STAGE(PG8_SA(1, 0), a3, voffA);
            PG8_BAR; PG8_WAIT_L(0); PG8_MMA(1, 0, At, B0); PG8_BAR; PG8_SCHED;
            PG8_STAGE(PG8_SB(1, 1), b3 + hstepB, voffB);
            PG8_WAIT_V(6); PG8_BAR; PG8_MMA(1, 1, At, B1); PG8_BAR;
            }
        }
        if constexpr (ALIGN_EPI) { if (wr == 0) PG8_BAR; }
        if constexpr (!Epi::AFTER_DRAIN) { E(acc, cur, wr, wc, fr, fq); S.done(cur); }
        if (!has_next) break;
#pragma unroll
        for (int a = 0; a < 2; ++a)
#pragma unroll
            for (int b = 0; b < 2; ++b)
#pragma unroll
                for (int m = 0; m < 4; ++m)
#pragma unroll
                    for (int n = 0; n < 2; ++n) acc[a][b][m][n] = (f32x4){0.f, 0.f, 0.f, 0.f};
        cur = nxt; cA = nA; cB = nB; ++ui;
        if constexpr (ALIGN_EPI) { if (wr == 1) PG8_BAR; }
    }
    PG8_WAIT_V(0);
    if constexpr (!ALIGN_EPI) { if (wr == 0) PG8_BAR; }
    PG8_BAR;
    if constexpr (Epi::AFTER_DRAIN) { E.fused(acc, cur, wr, wc, fr, fq, lds, wid, lane); S.done(cur); }
#undef PG8_SA
#undef PG8_SB
#undef PG8_STAGE
#undef PG8_LDA
#undef PG8_LDB
#undef PG8_MMA
#undef PG8_WAIT_V
#undef PG8_WAIT_L
#undef PG8_BAR
#undef PG8_SCHED
}
}
#define LAS __attribute__((address_space(3)))
typedef unsigned short bf16;
typedef short bf16x8 __attribute__((ext_vector_type(8)));
typedef float f32x4 __attribute__((ext_vector_type(4)));
typedef float f32x2 __attribute__((ext_vector_type(2)));
typedef float f32x16 __attribute__((ext_vector_type(16)));
typedef unsigned u32x4 __attribute__((ext_vector_type(4)));
typedef unsigned u32x2 __attribute__((ext_vector_type(2)));
#define MFMA32(a, b, c) __builtin_amdgcn_mfma_f32_32x32x16_bf16((a), (b), (c), 0, 0, 0)

constexpr int NWAVES = 8, NTHR = 512;
constexpr int SEQ = 8192, DM = 1024, MROWS = 16384, FF = 2816;
constexpr float EPS = 1e-6f;
constexpr size_t MiB = 1u << 20;
constexpr size_t WS_MOD = 0;
constexpr size_t WS_W = 1 * MiB;
constexpr size_t W_IN = WS_W, W_OUT = WS_W + 18 * MiB, W_UP = WS_W + 20 * MiB, W_DOWN = WS_W + 31 * MiB;
constexpr size_t WS_XN = 38 * MiB;
constexpr size_t WS_BIG = 70 * MiB;
constexpr size_t A_Q = WS_BIG, A_K = WS_BIG + 48 * MiB, A_VT = WS_BIG + 96 * MiB, A_LSE = WS_BIG + 144 * MiB;
constexpr size_t F_A = WS_BIG, F_U = WS_BIG + 88 * MiB;
constexpr size_t G_Q = WS_BIG, G_K = WS_BIG + 16 * MiB, G_R = WS_BIG + 32 * MiB, G_VT = WS_BIG + 64 * MiB, G_GL = WS_BIG + 96 * MiB, G_DEC = WS_BIG + 97 * MiB, G_ST = WS_BIG + 98 * MiB;
constexpr size_t WS_END = 256 * MiB;
static_assert(G_ST + 64 * MiB <= WS_END && F_U + 88 * MiB <= WS_END && A_LSE + 2 * MiB <= WS_END, "ws map");
constexpr int LDS_BYTES = 147456;

__device__ __forceinline__ float wave_sum(float v, int lane) {
#pragma unroll
    for (int o = 1; o < 64; o <<= 1) v += __int_as_float(__builtin_amdgcn_ds_bpermute((lane ^ o) << 2, __float_as_int(v)));
    return v;
}
__device__ __forceinline__ float xor32_max(float v) { auto rr = __builtin_amdgcn_permlane32_swap(__float_as_uint(v), __float_as_uint(v), false, false); return fmaxf(__uint_as_float(rr[0]), __uint_as_float(rr[1])); }
__device__ __forceinline__ float xor32_sum(float v) { auto rr = __builtin_amdgcn_permlane32_swap(__float_as_uint(v), __float_as_uint(v), false, false); return __uint_as_float(rr[0]) + __uint_as_float(rr[1]); }
__device__ __forceinline__ unsigned pkbf(float lo, float hi) { return pg8::cvt_pk_bf16(lo, hi); }
__device__ __forceinline__ float bflo(unsigned w) { return __uint_as_float(w << 16); }
__device__ __forceinline__ float bfhi(unsigned w) { return __uint_as_float(w & 0xffff0000u); }
__device__ __forceinline__ float silu_f(float x) { return x * __builtin_amdgcn_rcpf(1.0f + __builtin_amdgcn_exp2f(-1.4426950408889634f * x)); }
__device__ __forceinline__ int crow(int r, int hi) { return (r & 3) + 8 * (r >> 2) + 4 * hi; }
__device__ __forceinline__ bf16x8 pack8(const f32x16& x, int s) {
    u32x4 p; p.x = pkbf(x[8 * s], x[8 * s + 1]); p.y = pkbf(x[8 * s + 2], x[8 * s + 3]); p.z = pkbf(x[8 * s + 4], x[8 * s + 5]); p.w = pkbf(x[8 * s + 6], x[8 * s + 7]);
    return __builtin_bit_cast(bf16x8, p);
}
__device__ __forceinline__ bf16x8 ld2x8(const bf16* p) {
    const u32x2 a = *(const u32x2*)p, b = *(const u32x2*)(p + 8); u32x4 r; r.x = a.x; r.y = a.y; r.z = b.x; r.w = b.y; return __builtin_bit_cast(bf16x8, r);
}

__device__ __forceinline__ int remap_col(int mode, int n) {
    if (mode == 1) { const int blk = n >> 10, rest = n & 1023, which = blk / 3, g = blk - which * 3; return g * 3072 + which * 1024 + rest; }
    if (mode == 2) { return n < 2048 ? n : (n < 2064 ? 3072 + (n - 2048) : n - 16); }
    return n;
}
__device__ __forceinline__ void transpose_item(const float* W, int K, int N, bf16* WT, int mode, LAS float* scr, int item, int lane) {
    const int nblk = (N + 31) / 32, kb = item / nblk, nb = item % nblk, k0 = 64 * kb, n0 = 32 * nb;
    const int ncol = n0 + (lane & 31); const bool ok = ncol < N;
#pragma unroll 8
    for (int i = 0; i < 32; ++i) { const int kk = 2 * i + (lane >> 5); scr[kk * 33 + (lane & 31)] = ok ? W[(size_t)(k0 + kk) * N + ncol] : 0.f; }
    asm volatile("s_waitcnt lgkmcnt(0)" ::: "memory");
    const int c = lane & 7;
#pragma unroll
    for (int j = 0; j < 4; ++j) { const int n = (lane >> 3) + 8 * j; const LAS float* s = scr + (8 * c) * 33 + n;
        u32x4 o; o.x = pkbf(s[0 * 33], s[1 * 33]); o.y = pkbf(s[2 * 33], s[3 * 33]); o.z = pkbf(s[4 * 33], s[5 * 33]); o.w = pkbf(s[6 * 33], s[7 * 33]);
        if (n0 + n < N) *(u32x4*)(WT + (size_t)remap_col(mode, n0 + n) * K + k0 + 8 * c) = o; }
    asm volatile("s_waitcnt lgkmcnt(0)" ::: "memory");
}
__device__ __forceinline__ void modulate_phase(const float* xin, bf16* xn, const float* gain, const float* shift, const float* scale  , int gw, int ngw, int lane) {
    for (int b = 0; b < 2; ++b) {
        f32x4 A[4], B[4];
#pragma unroll
        for (int j = 0; j < 4; ++j) { const int c = 256 * j + 4 * lane; const f32x4 g = *(const f32x4*)(gain + c), sc = *(const f32x4*)(scale + b * 6144 + c); A[j] = g * (1.0f + sc); B[j] = *(const f32x4*)(shift + b * 6144 + c); }
        for (int m0 = gw; m0 < SEQ; m0 += 4 * ngw) {
            f32x4 v[4][4]; float s[4];
#pragma unroll
            for (int r = 0; r < 4; ++r) { const int m = m0 + r * ngw; s[r] = 0.f;
                if (m < SEQ) { const f32x4* xr = (const f32x4*)(xin + ((size_t)b * SEQ + m) * DM) + lane;
#pragma unroll
                    for (int j = 0; j < 4; ++j) v[r][j] = xr[64 * j]; } }
#pragma unroll
            for (int r = 0; r < 4; ++r) { if (m0 + r * ngw < SEQ) {
#pragma unroll
                for (int j = 0; j < 4; ++j) s[r] += (v[r][j].x * v[r][j].x + v[r][j].y * v[r][j].y) + (v[r][j].z * v[r][j].z + v[r][j].w * v[r][j].w); } }
#pragma unroll
            for (int r = 0; r < 4; ++r) s[r] = wave_sum(s[r], lane);
#pragma unroll
            for (int r = 0; r < 4; ++r) { const int m = m0 + r * ngw;
                if (m < SEQ) { const float rs = 1.0f / sqrtf(s[r] * (1.0f / DM) + EPS); u32x2* o8 = (u32x2*)(xn + ((size_t)b * SEQ + m) * DM) + lane;
#pragma unroll
                    for (int j = 0; j < 4; ++j) { const f32x4 y = v[r][j] * rs * A[j] + B[j]; u32x2 w; w.x = pkbf(y.x, y.y); w.y = pkbf(y.z, y.w); o8[64 * j] = w; } } }
        }
    }
}
__device__ __forceinline__ void final_norm_phase(const float* xin, float* out, const float* gain, int gw, int ngw, int lane) {
    f32x4 A[4];
#pragma unroll
    for (int j = 0; j < 4; ++j) A[j] = *(const f32x4*)(gain + 256 * j + 4 * lane);
    for (int m0 = gw; m0 < MROWS; m0 += 4 * ngw) {
        f32x4 v[4][4]; float s[4];
#pragma unroll
        for (int r = 0; r < 4; ++r) { const int m = m0 + r * ngw; s[r] = 0.f;
            if (m < MROWS) { const f32x4* xr = (const f32x4*)(xin + (size_t)m * DM) + lane;
#pragma unroll
                for (int j = 0; j < 4; ++j) v[r][j] = xr[64 * j]; } }
#pragma unroll
        for (int r = 0; r < 4; ++r) { if (m0 + r * ngw < MROWS) {
#pragma unroll
            for (int j = 0; j < 4; ++j) s[r] += (v[r][j].x * v[r][j].x + v[r][j].y * v[r][j].y) + (v[r][j].z * v[r][j].z + v[r][j].w * v[r][j].w); } }
#pragma unroll
        for (int r = 0; r < 4; ++r) s[r] = wave_sum(s[r], lane);
#pragma unroll
        for (int r = 0; r < 4; ++r) { const int m = m0 + r * ngw;
            if (m < MROWS) { const float rs = 1.0f / sqrtf(s[r] * (1.0f / DM) + EPS); f32x4* o = (f32x4*)(out + (size_t)m * DM) + lane;
#pragma unroll
                for (int j = 0; j < 4; ++j) o[64 * j] = v[r][j] * rs * A[j]; } }
    }
}

__device__ __forceinline__ void attn_phase(LAS unsigned char* lds, bf16* Qg, const bf16* Kg, const bf16* VT, float* LSE, int tid, int bid) {
    const int lane = tid & 63, wave = __builtin_amdgcn_readfirstlane(tid >> 6), q = lane & 31, hi = lane >> 5;
    LAS unsigned char* Ks = lds;
    LAS unsigned char* Vs = lds + 55296;
    const int G = gridDim.x;
    u32x4 kreg[6], vreg[6];
#define ATT_LOAD(bu_) do { const int qb_ = (bu_) & 31, h_ = ((bu_) >> 5) & 15, g_ = (bu_) >> 9; const int L_ = (g_ == 0) ? 8192 : (g_ == 1 ? 2048 : 512); \
        const int n0b_ = 256 * qb_; const bool first_ = (n0b_ & (L_ - 1)) == 0; \
        const bf16* Kb_ = Kg + ((size_t)g_ * 8192 + n0b_ - 128) * 1024 + h_ * 64; const bf16* Vb_ = VT + ((size_t)g_ * 1024 + h_ * 64) * 8192 + (n0b_ - 128); \
        _Pragma("unroll") for (int i_ = 0; i_ < 6; ++i_) { const int idx_ = tid + 512 * i_; const int row_ = idx_ >> 3, ch_ = idx_ & 7, e_ = idx_ / 48, cv_ = idx_ - e_ * 48; \
            if (!first_ || row_ >= 128) kreg[i_] = *(const u32x4*)(Kb_ + (size_t)row_ * 1024 + ch_ * 8); \
            if (!first_ || cv_ >= 16) vreg[i_] = *(const u32x4*)(Vb_ + (size_t)e_ * 8192 + cv_ * 8); } } while (0)
    if (bid < 1536) ATT_LOAD(bid);
    for (int bu = bid; bu < 1536; bu += G) {
        asm volatile("" : "+v"(tid));
        const int qb = bu & 31, h = (bu >> 5) & 15, g = bu >> 9;
        const int L = (g == 0) ? 8192 : (g == 1 ? 2048 : 512);
        const int n0 = 256 * qb + 32 * wave, m0 = n0 & (L - 1);
        const int kt_lo = (m0 >= 128) ? 0 : ((128 - m0) >> 5);
        bf16* Qp = Qg + ((size_t)g * 8192 + n0 + q) * 1024 + h * 64;
        bf16x8 qf[4];
#pragma unroll
        for (int s = 0; s < 4; ++s) qf[s] = *(const bf16x8*)(Qp + 16 * s + 8 * hi);
        __syncthreads();
#pragma unroll
        for (int i = 0; i < 6; ++i) { const int idx = tid + 512 * i; const int row = idx >> 3, ch = idx & 7, e = idx / 48, cv = idx - e * 48;
            *(LAS u32x4*)(Ks + row * 144 + ch * 16) = kreg[i]; *(LAS u32x4*)(Vs + e * 784 + cv * 16) = vreg[i]; }
        __syncthreads();
        if (bu + G < 1536) ATT_LOAD(bu + G);
        f32x16 S[5];
#pragma unroll
        for (int kt = 0; kt < 5; ++kt) {
            f32x16 acc;
#pragma unroll
            for (int r = 0; r < 16; ++r) acc[r] = 0.f;
            if (kt >= kt_lo) {
                const LAS unsigned char* Kp = Ks + (32 * wave + 32 * kt + q) * 144 + 16 * hi;
#pragma unroll
                for (int s = 0; s < 4; ++s) { const bf16x8 kf = *(const LAS bf16x8*)(Kp + 32 * s); acc = MFMA32(kf, qf[s], acc); }
            }
#pragma unroll
            for (int r = 0; r < 16; ++r) {
                const int kk = crow(r, hi);
                bool valid = kt >= kt_lo;
                if (kt == 0) valid = valid && (kk >= q);
                if (kt == 4) valid = valid && (kk <= q);
                acc[r] = valid ? acc[r] : -1e30f;
            }
            S[kt] = acc;
        }
        float mx = -1e30f;
#pragma unroll
        for (int kt = 0; kt < 5; ++kt)
#pragma unroll
            for (int r = 0; r < 16; ++r) mx = fmaxf(mx, S[kt][r]);
        mx = xor32_max(mx);
        const float c2 = 0.125f * 1.4426950408889634f;
        float l = 0.f;
#pragma unroll
        for (int kt = 0; kt < 5; ++kt)
#pragma unroll
            for (int r = 0; r < 16; ++r) { const float p = exp2f((S[kt][r] - mx) * c2); S[kt][r] = p; l += p; }
        l = xor32_sum(l);
        f32x16 O[2];
#pragma unroll
        for (int r = 0; r < 16; ++r) { O[0][r] = 0.f; O[1][r] = 0.f; }
#pragma unroll
        for (int kt = 0; kt < 5; ++kt) {
            if (kt >= kt_lo) {
#pragma unroll
                for (int jj = 0; jj < 2; ++jj) {
                    const bf16x8 pf = pack8(S[kt], jj);
#pragma unroll
                    for (int et = 0; et < 2; ++et) {
                        const LAS unsigned char* Vp = Vs + (32 * et + q) * 784 + (32 * wave + 32 * kt + 16 * jj + 4 * hi) * 2;
                        const u32x2 a = *(const LAS u32x2*)Vp, b = *(const LAS u32x2*)(Vp + 16); u32x4 vv; vv.x = a.x; vv.y = a.y; vv.z = b.x; vv.w = b.y;
                        O[et] = MFMA32(__builtin_bit_cast(bf16x8, vv), pf, O[et]);
                    }
                }
            }
        }
        const float inv = 1.0f / l;
#pragma unroll
        for (int et = 0; et < 2; ++et)
#pragma unroll
            for (int rg = 0; rg < 4; ++rg) { u32x2 w; w.x = pkbf(O[et][4 * rg] * inv, O[et][4 * rg + 1] * inv); w.y = pkbf(O[et][4 * rg + 2] * inv, O[et][4 * rg + 3] * inv);
                *(u32x2*)(Qp + 32 * et + 8 * rg + 4 * hi) = w; }
        if (hi == 0) LSE[((size_t)g * 8192 + n0 + q) * 16 + h] = mx * 0.125f + __logf(l);
    }
#undef ATT_LOAD
}
__device__ __forceinline__ void combine_phase(const bf16* Qg, const float* LSE, bf16* O  , int gtid, int nthr) {
    for (int i = gtid; i < 8192 * 128; i += nthr) {
        const int t = i >> 7, ch = i & 127, head = ch >> 3;
        int np[3]; np[0] = t; np[1] = (t & 3) * 2048 + (t >> 2); np[2] = (t & 15) * 512 + (t >> 4);
        float ls[3];
#pragma unroll
        for (int g = 0; g < 3; ++g) ls[g] = LSE[((size_t)g * 8192 + np[g]) * 16 + head];
        const float mx = fmaxf(ls[0], fmaxf(ls[1], ls[2]));
        float w[3]; float sw = 0.f;
#pragma unroll
        for (int g = 0; g < 3; ++g) { w[g] = __expf(ls[g] - mx); sw += w[g]; }
        const float isw = 1.0f / sw;
        float acc[8];
#pragma unroll
        for (int e = 0; e < 8; ++e) acc[e] = 0.f;
#pragma unroll
        for (int g = 0; g < 3; ++g) { const u32x4 v = *(const u32x4*)(Qg + ((size_t)g * 8192 + np[g]) * 1024 + 8 * ch); const float wg = w[g] * isw;
            acc[0] += wg * bflo(v.x); acc[1] += wg * bfhi(v.x); acc[2] += wg * bflo(v.y); acc[3] += wg * bfhi(v.y);
            acc[4] += wg * bflo(v.z); acc[5] += wg * bfhi(v.z); acc[6] += wg * bflo(v.w); acc[7] += wg * bfhi(v.w); }
        u32x4 o; o.x = pkbf(acc[0], acc[1]); o.y = pkbf(acc[2], acc[3]); o.z = pkbf(acc[4], acc[5]); o.w = pkbf(acc[6], acc[7]);
        *(u32x4*)(O + (size_t)t * 1024 + 8 * ch) = o;
    }
}

__device__ __forceinline__ void convgate_phase(const bf16* Ab, bf16* Ub, const float* cw, const float* cb, int gtid, int nthr) {
    for (int it = gtid; it < 1024 * 352; it += nthr) {
        const int rb = it / 352, ch = it - rb * 352, col = ch * 8, row0 = rb * 16;
        float w0[8], w1[8], w2[8], bb[8], a2[8], a1[8];
#pragma unroll
        for (int e = 0; e < 8; ++e) { w0[e] = cw[col + e]; w1[e] = cw[FF + col + e]; w2[e] = cw[2 * FF + col + e]; bb[e] = cb[col + e]; a2[e] = 0.f; a1[e] = 0.f; }
        if ((row0 & (SEQ - 1)) != 0) {
            const u32x4 p2 = *(const u32x4*)(Ab + (size_t)(row0 - 2) * FF + col), p1 = *(const u32x4*)(Ab + (size_t)(row0 - 1) * FF + col);
            a2[0] = bflo(p2.x); a2[1] = bfhi(p2.x); a2[2] = bflo(p2.y); a2[3] = bfhi(p2.y); a2[4] = bflo(p2.z); a2[5] = bfhi(p2.z); a2[6] = bflo(p2.w); a2[7] = bfhi(p2.w);
            a1[0] = bflo(p1.x); a1[1] = bfhi(p1.x); a1[2] = bflo(p1.y); a1[3] = bfhi(p1.y); a1[4] = bflo(p1.z); a1[5] = bfhi(p1.z); a1[6] = bflo(p1.w); a1[7] = bfhi(p1.w);
        }
        for (int r0 = 0; r0 < 16; r0 += 8) {
            u32x4 pa[8], pu[8];
#pragma unroll
            for (int r = 0; r < 8; ++r) { const size_t off = (size_t)(row0 + r0 + r) * FF + col; pa[r] = *(const u32x4*)(Ab + off); pu[r] = *(const u32x4*)(Ub + off); }
#pragma unroll
            for (int r = 0; r < 8; ++r) {
                float a[8], uu[8], o[8];
                a[0] = bflo(pa[r].x); a[1] = bfhi(pa[r].x); a[2] = bflo(pa[r].y); a[3] = bfhi(pa[r].y); a[4] = bflo(pa[r].z); a[5] = bfhi(pa[r].z); a[6] = bflo(pa[r].w); a[7] = bfhi(pa[r].w);
                uu[0] = bflo(pu[r].x); uu[1] = bfhi(pu[r].x); uu[2] = bflo(pu[r].y); uu[3] = bfhi(pu[r].y); uu[4] = bflo(pu[r].z); uu[5] = bfhi(pu[r].z); uu[6] = bflo(pu[r].w); uu[7] = bfhi(pu[r].w);
#pragma unroll
                for (int e = 0; e < 8; ++e) { const float y = w0[e] * a2[e] + w1[e] * a1[e] + w2[e] * a[e] + bb[e]; o[e] = silu_f(y) * uu[e]; a2[e] = a1[e]; a1[e] = a[e]; }
                u32x4 w; w.x = pkbf(o[0], o[1]); w.y = pkbf(o[2], o[3]); w.z = pkbf(o[4], o[5]); w.w = pkbf(o[6], o[7]);
                *(u32x4*)(Ub + (size_t)(row0 + r0 + r) * FF + col) = w;
            }
        }
    }
}
__device__ __forceinline__ void gla_g3_phase(LAS unsigned char* lds, bf16* Qb, bf16* Kb, const bf16* VT, const float* GL, const float* w_gate, const float* b_gate, float* DEC, bf16* ST, int G) {
    LAS float* Bc = (LAS float*)lds;
    LAS float* SEG = (LAS float*)(lds + 32768);
    LAS bf16* KET = (LAS bf16*)(lds + 36864);
    LAS float* GLS = (LAS float*)(lds + 57344);
    const int tid = threadIdx.x, lane = tid & 63, wave = tid >> 6, hi = lane >> 5, l31 = lane & 31;
    for (int item = blockIdx.x; item < 1024; item += G) {
        const int h = item & 3, c = (item >> 2) & 127, b = item >> 9; const size_t t0 = (size_t)b * SEQ + 64 * c;
        const f32x2 glv = *(const f32x2*)(GL + t0 * 16 + 2 * tid);
        u32x4 qv[2], kv[2];
#pragma unroll
        for (int i = 0; i < 2; ++i) { const int idx = tid + 512 * i, j = idx >> 4, kc = (idx & 15) * 8; qv[i] = *(const u32x4*)(Qb + (t0 + j) * 512 + h * 128 + kc); kv[i] = *(const u32x4*)(Kb + (t0 + j) * 512 + h * 128 + kc); }
        bf16x8 vfr[4];
        { const bf16* Vp = VT + (size_t)(h * 256 + 32 * wave + l31) * MROWS + t0 + 8 * hi;
#pragma unroll
          for (int s4 = 0; s4 < 4; ++s4) vfr[s4] = *(const bf16x8*)(Vp + 16 * s4); }
        *(LAS f32x2*)(GLS + 2 * tid) = glv;
        __syncthreads();
        {
            const int k = tid & 127, jq = tid >> 7;
            float wg[16];
#pragma unroll
            for (int i = 0; i < 16; ++i) wg[i] = w_gate[i * 512 + h * 128 + k];
            const float bg = b_gate[h * 128 + k];
            float run = 0.f;
            for (int jj = 0; jj < 16; ++jj) { const int j = jq * 16 + jj; const LAS float* gp = GLS + j * 16; float z = bg;
#pragma unroll
                for (int i = 0; i < 16; ++i) z += gp[i] * wg[i];
                const float ls = fminf(z, 0.f) - 0.6931471805599453f * __builtin_amdgcn_logf(1.0f + __builtin_amdgcn_exp2f(-1.4426950408889634f * fabsf(z)));
                run += ls * (1.0f / 16.0f); Bc[j * 128 + k] = run; }
            SEG[jq * 128 + k] = run;
            __syncthreads();
            float off = 0.f;
            for (int qq = 0; qq < jq; ++qq) off += SEG[qq * 128 + k];
            for (int jj = 0; jj < 16; ++jj) Bc[(jq * 16 + jj) * 128 + k] += off;
            __syncthreads();
            if (tid < 128) DEC[(size_t)item * 128 + tid] = __expf(Bc[63 * 128 + tid]);
        }
#pragma unroll
        for (int i = 0; i < 2; ++i) { const int idx = tid + 512 * i, j = idx >> 4, kc = (idx & 15) * 8;
            bf16* qp = Qb + (t0 + j) * 512 + h * 128 + kc; bf16* kp = Kb + (t0 + j) * 512 + h * 128 + kc;
            float qf[8], kf[8], qd[8], kd[8];
            qf[0] = bflo(qv[i].x); qf[1] = bfhi(qv[i].x); qf[2] = bflo(qv[i].y); qf[3] = bfhi(qv[i].y); qf[4] = bflo(qv[i].z); qf[5] = bfhi(qv[i].z); qf[6] = bflo(qv[i].w); qf[7] = bfhi(qv[i].w);
            kf[0] = bflo(kv[i].x); kf[1] = bfhi(kv[i].x); kf[2] = bflo(kv[i].y); kf[3] = bfhi(kv[i].y); kf[4] = bflo(kv[i].z); kf[5] = bfhi(kv[i].z); kf[6] = bflo(kv[i].w); kf[7] = bfhi(kv[i].w);
#pragma unroll
            for (int e = 0; e < 8; ++e) { const float bv = Bc[j * 128 + kc + e], bl = Bc[63 * 128 + kc + e];
                qd[e] = qf[e] * 0.08838834764831845f * __expf(bv); kd[e] = kf[e] * __expf(-bv);
                const float ke = kf[e] * __expf(bl - bv); KET[(kc + e) * 72 + (j ^ (8 * ((kc >> 3) & 7)))] = (bf16)(pkbf(ke, ke) & 0xffffu); }
            u32x4 qo, ko; qo.x = pkbf(qd[0], qd[1]); qo.y = pkbf(qd[2], qd[3]); qo.z = pkbf(qd[4], qd[5]); qo.w = pkbf(qd[6], qd[7]);
            ko.x = pkbf(kd[0], kd[1]); ko.y = pkbf(kd[2], kd[3]); ko.z = pkbf(kd[4], kd[5]); ko.w = pkbf(kd[6], kd[7]);
            *(u32x4*)qp = qo; *(u32x4*)kp = ko; }
        __syncthreads();
        {
            f32x16 acc[4];
#pragma unroll
            for (int kt = 0; kt < 4; ++kt)
#pragma unroll
                for (int r = 0; r < 16; ++r) acc[kt][r] = 0.f;
#pragma unroll
            for (int s = 0; s < 4; ++s) { const bf16x8 vf = vfr[s];
#pragma unroll
                for (int kt = 0; kt < 4; ++kt) { const bf16x8 af = *(const LAS bf16x8*)(KET + (32 * kt + l31) * 72 + 8 * ((2 * s + hi) ^ (((32 * kt + l31) >> 3) & 7))); acc[kt] = MFMA32(af, vf, acc[kt]); } }
            bf16* Sp = ST + ((size_t)item * 256 + 32 * wave + l31) * 128;
#pragma unroll
            for (int kt = 0; kt < 4; ++kt)
#pragma unroll
                for (int rg = 0; rg < 4; ++rg) { u32x2 w; w.x = pkbf(acc[kt][4 * rg], acc[kt][4 * rg + 1]); w.y = pkbf(acc[kt][4 * rg + 2], acc[kt][4 * rg + 3]);
                    *(u32x2*)(Sp + 32 * kt + 8 * rg + 4 * hi) = w; }
        }
        __syncthreads();
    }
}
__device__ __forceinline__ void gla_scan_phase(bf16* ST, const float* DEC, int gtid, int nthr) {
    for (int e = gtid; e < 2 * 4 * 256 * 64; e += nthr) {
        const int kp = e & 63, v = (e >> 6) & 255, h = (e >> 14) & 3, b = e >> 16;
        float s0 = 0.f, s1 = 0.f;
        for (int c0 = 0; c0 < 128; c0 += 16) {
            unsigned ds[16]; f32x2 dc[16];
#pragma unroll
            for (int u = 0; u < 16; ++u) { const size_t item = (size_t)(b * 128 + c0 + u) * 4 + h; ds[u] = *(const unsigned*)(ST + (item * 256 + v) * 128 + 2 * kp); dc[u] = *(const f32x2*)(DEC + item * 128 + 2 * kp); }
#pragma unroll
            for (int u = 0; u < 16; ++u) { const size_t item = (size_t)(b * 128 + c0 + u) * 4 + h;
                *(unsigned*)(ST + (item * 256 + v) * 128 + 2 * kp) = pkbf(s0, s1); s0 = dc[u].x * s0 + bflo(ds[u]); s1 = dc[u].y * s1 + bfhi(ds[u]); }
        }
    }
}
__device__ __forceinline__ void gla_g5_phase(LAS unsigned char* lds, const bf16* Qb, const bf16* Kb, const bf16* VT, const bf16* Rb, const bf16* ST, const float* gain, bf16* O, int G) {
    LAS float* red = (LAS float*)lds;
    const int tid = threadIdx.x, lane = tid & 63, wave = tid >> 6, hi = lane >> 5, l31 = lane & 31;
    const int it = wave & 1, vp = wave >> 1;
    for (int item = blockIdx.x; item < 1024; item += G) {
        const int h = item & 3, c = (item >> 2) & 127, b = item >> 9; const size_t t0 = (size_t)b * SEQ + 64 * c;
        bf16x8 qf[8];
        const bf16* Qp = Qb + (t0 + 32 * it + l31) * 512 + h * 128 + 8 * hi;
#pragma unroll
        for (int s = 0; s < 8; ++s) qf[s] = *(const bf16x8*)(Qp + 16 * s);
        f32x16 AT[2];
#pragma unroll
        for (int jt = 0; jt < 2; ++jt) {
            f32x16 acc;
#pragma unroll
            for (int r = 0; r < 16; ++r) acc[r] = 0.f;
            if (jt <= it) {
                const bf16* Kp = Kb + (t0 + 32 * jt + l31) * 512 + h * 128 + 8 * hi;
#pragma unroll
                for (int s = 0; s < 8; ++s) { const bf16x8 kf = *(const bf16x8*)(Kp + 16 * s); acc = MFMA32(kf, qf[s], acc); }
                if (jt == it) {
#pragma unroll
                    for (int r = 0; r < 16; ++r) acc[r] = (crow(r, hi) <= l31) ? acc[r] : 0.f;
                }
            }
            AT[jt] = acc;
        }
        f32x16 Oa[2];
#pragma unroll
        for (int vt = 0; vt < 2; ++vt) {
            f32x16 acc;
#pragma unroll
            for (int r = 0; r < 16; ++r) acc[r] = 0.f;
            const int vcol = 32 * (2 * vp + vt) + l31;
#pragma unroll
            for (int jt = 0; jt < 2; ++jt) {
                if (jt <= it) {
#pragma unroll
                    for (int jj = 0; jj < 2; ++jj) { const bf16* Vp = VT + (size_t)(h * 256 + vcol) * MROWS + t0 + 32 * jt + 16 * jj + 4 * hi; acc = MFMA32(ld2x8(Vp), pack8(AT[jt], jj), acc); }
                }
            }
            const bf16* Sp = ST + ((size_t)item * 256 + vcol) * 128 + 8 * hi;
#pragma unroll
            for (int s = 0; s < 8; ++s) { const bf16x8 sf = *(const bf16x8*)(Sp + 16 * s); acc = MFMA32(sf, qf[s], acc); }
            Oa[vt] = acc;
        }
        float ss = 0.f;
#pragma unroll
        for (int vt = 0; vt < 2; ++vt)
#pragma unroll
            for (int r = 0; r < 16; ++r) ss += Oa[vt][r] * Oa[vt][r];
        ss = xor32_sum(ss);
        if (hi == 0) red[vp * 64 + 32 * it + l31] = ss;
        __syncthreads();
        const float tot = (red[32 * it + l31] + red[64 + 32 * it + l31]) + (red[128 + 32 * it + l31] + red[192 + 32 * it + l31]);
        const float rs = 1.0f / sqrtf(tot * (1.0f / 256.0f) + EPS);
        const size_t row = t0 + 32 * it + l31;
#pragma unroll
        for (int vt = 0; vt < 2; ++vt)
#pragma unroll
            for (int rg = 0; rg < 4; ++rg) { const int vb = 32 * (2 * vp + vt) + 8 * rg + 4 * hi;
                const f32x4 gn = *(const f32x4*)(gain + vb); const u32x2 rr = *(const u32x2*)(Rb + row * 1024 + h * 256 + vb);
                const float o0 = Oa[vt][4 * rg] * rs * gn.x * silu_f(bflo(rr.x)), o1 = Oa[vt][4 * rg + 1] * rs * gn.y * silu_f(bfhi(rr.x));
                const float o2 = Oa[vt][4 * rg + 2] * rs * gn.z * silu_f(bflo(rr.y)), o3 = Oa[vt][4 * rg + 3] * rs * gn.w * silu_f(bfhi(rr.y));
                u32x2 w; w.x = pkbf(o0, o1); w.y = pkbf(o2, o3); *(u32x2*)(O + row * 1024 + h * 256 + vb) = w; }
        __syncthreads();
    }
}

#define XB_TMO      128
#define XB_XCNT(j)  (256  + 64 * (j))
#define XB_XSUB(j)  (1280 + 64 * (j))
#define XB_XGEN(j)  (2304 + 64 * (j))
#define XB_TOP      3328
#define XB_TOPGEN   3392
#define XCD_BAR_WORDS 3456
#define XB_SPIN_CAP (1u << 18)

__device__ __forceinline__ unsigned xb_ld(unsigned* p)              { return __hip_atomic_load(p, __ATOMIC_RELAXED, __HIP_MEMORY_SCOPE_AGENT); }
__device__ __forceinline__ unsigned xb_add(unsigned* p, unsigned v) { return __hip_atomic_fetch_add(p, v, __ATOMIC_RELAXED, __HIP_MEMORY_SCOPE_AGENT); }
__device__ __forceinline__ unsigned xb_xcc_id() { return (unsigned)__builtin_amdgcn_s_getreg((3 << 11) | 20) & 0xFu; }
#define XB_SPIN(cond, bar) do { unsigned _sp = 0; while (cond) { __builtin_amdgcn_s_sleep(1); \
    if ((++_sp & 255u) == 0u) { if (xb_ld(&(bar)[XB_TMO])) break; if (_sp > XB_SPIN_CAP) { atomicAdd(&(bar)[XB_TMO], 1u); break; } } } } while (0)

struct XcdBarrier {
    unsigned* bar; unsigned x;
    volatile LAS unsigned* st;
};

__device__ __forceinline__ XcdBarrier xcd_barrier_post(unsigned* bar, volatile LAS unsigned* st) {
    XcdBarrier b; b.bar = bar; b.x = xb_xcc_id(); b.st = st;
    if (threadIdx.x == 0) (void)xb_add(&bar[XB_XCNT(b.x)], 1u);
    return b;
}
__device__ __forceinline__ void xcd_barrier_complete(unsigned* bar, unsigned x, unsigned& nloc, unsigned& nx) {
    const unsigned G = gridDim.x * gridDim.y * gridDim.z;
    unsigned sum, cnt, mine, sp = 0u;
    for (;;) {
        sum = 0u; cnt = 0u; mine = 0u;
#pragma unroll
        for (unsigned j = 0; j < 16; ++j) { const unsigned c = xb_ld(&bar[XB_XCNT(j)]); sum += c; cnt += (c > 0u) ? 1u : 0u; mine = (j == x) ? c : mine; }
        if (sum == G) break;
        __builtin_amdgcn_s_sleep(1);
        if ((++sp & 255u) == 0u) { if (xb_ld(&bar[XB_TMO])) break; if (sp > XB_SPIN_CAP) { atomicAdd(&bar[XB_TMO], 1u); break; } }
    }
    nloc = mine > 0u ? mine : 1u; nx = cnt > 0u ? cnt : 1u;
}

__device__ __forceinline__ void xcd_barrier(const XcdBarrier& b) {
    asm volatile("s_waitcnt vmcnt(0)" ::: "memory");
    __syncthreads();
    if (threadIdx.x == 0) {
        unsigned* bar = b.bar;
        __builtin_amdgcn_s_waitcnt(0);
        unsigned nloc = b.st[0], nx = b.st[1];
        if (nloc == 0u) { xcd_barrier_complete(bar, b.x, nloc, nx); b.st[0] = nloc; b.st[1] = nx; }
        const unsigned old = xb_add(&bar[XB_XSUB(b.x)], 1u);
        const unsigned gen = old / nloc;
        if (old + 1u == (gen + 1u) * nloc) {
            __builtin_amdgcn_fence(__ATOMIC_RELEASE, "agent");
            asm volatile("s_waitcnt vmcnt(0)" ::: "memory");
            const unsigned og = xb_add(&bar[XB_TOP], 1u);
            const unsigned tg = og / nx;
            if (og + 1u == (tg + 1u) * nx) xb_add(&bar[XB_TOPGEN], 1u);
            else XB_SPIN(xb_ld(&bar[XB_TOPGEN]) == tg, bar);
            __builtin_amdgcn_fence(__ATOMIC_ACQUIRE, "agent");
            xb_add(&bar[XB_XGEN(b.x)], 1u);
            asm volatile("s_waitcnt vmcnt(0)" ::: "memory");
        } else {
            XB_SPIN(xb_ld(&bar[XB_XGEN(b.x)]) == gen, bar);
            __builtin_amdgcn_fence(__ATOMIC_ACQUIRE, "agent");
            asm volatile("s_waitcnt vmcnt(0)" ::: "memory");
        }
    }
    __syncthreads();
}

constexpr size_t WS_BAR = 262144;
constexpr int MISC_OFF = 147200;
struct Params {
    const float *x, *c, *w_ada, *b_ada, *norm_mix, *norm_ffn, *attn_w_in, *attn_w_out, *gla_w_in, *gla_w_gate, *gla_b_gate, *gla_norm, *gla_w_out,
                *ffn_w_up, *ffn_conv_w, *ffn_conv_b, *ffn_w_down, *norm_final;
    float* out; unsigned char* ws;
};

typedef const __attribute__((address_space(4))) Params* kparams_t;
__device__ __forceinline__ kparams_t kp() { kparams_t q = (kparams_t)__builtin_amdgcn_kernarg_segment_ptr(); asm volatile("" : "+s"(q)); return q; }
#define PHASE_IDX int z_; asm volatile("s_mov_b32 %0, 0" : "=s"(z_)); const int tid = (int)threadIdx.x + z_, lane = tid & 63, wave = __builtin_amdgcn_readfirstlane(tid >> 6); \
    const int G = gridDim.x, bid = (int)blockIdx.x + z_, gw = bid * NWAVES + wave, ngw = G * NWAVES, gtid = bid * NTHR + tid, nthr = G * NTHR; \
    unsigned char* ws = kp()->ws; (void)lane; (void)gw; (void)ngw; (void)gtid; (void)nthr; (void)ws;
#define GSYNC_CG() do { asm volatile("s_waitcnt vmcnt(0) lgkmcnt(0)" ::: "memory"); cg::this_grid().sync(); asm volatile("" ::: "memory"); } while (0)
#define GSYNC() do { XcdBarrier b_; b_.bar = (unsigned*)(kp()->ws + WS_BAR); b_.x = xb_xcc_id(); b_.st = (volatile LAS unsigned*)(LDSP + MISC_OFF); xcd_barrier(b_); asm volatile("" ::: "memory"); } while (0)
#ifdef PROBE_GROUP
#define TSBUF ((unsigned long long*)(kp()->ws + 819200))
#undef GSYNC
#define GSYNC() do { XcdBarrier b_; b_.bar = (unsigned*)(kp()->ws + WS_BAR); b_.x = xb_xcc_id(); b_.st = (volatile LAS unsigned*)(LDSP + MISC_OFF); xcd_barrier(b_); asm volatile("" ::: "memory"); \
    if (threadIdx.x == 0 && blockIdx.x == 0) { unsigned long long* tb_ = TSBUF; const unsigned long long k_ = tb_[63]; tb_[k_] = __builtin_amdgcn_s_memrealtime(); tb_[63] = k_ + 1; } } while (0)
#endif
#define LDSP ((LAS unsigned char*)lds_raw)

template <class Epi>
__device__ __forceinline__ void run_gemm(LAS unsigned char* lds, const bf16* A, const bf16* Bt, int M, int N, int K, int dil, int L, int rot, const Epi& E) {
    pg8::Gemm g{A, Bt, M, N, K, dil, L}; pg8::StaticOrder S; const int G = gridDim.x; S.init(M, N, G, (int)((blockIdx.x + rot) % G));
    int z_; asm volatile("s_mov_b32 %0, 0" : "=s"(z_));
    pg8::gemm_phase<Epi, pg8::StaticOrder, true, true>((PG8_LAS unsigned char*)lds, g, S, E, (int)threadIdx.x + z_);
}

#define FFN_BLOCK(layer) do { \
    { PHASE_IDX; const float* ml = (const float*)(ws + WS_MOD) + (size_t)(layer) * 2 * 6144; \
      modulate_phase(kp()->out, (bf16*)(ws + WS_XN), kp()->norm_ffn + (layer) * DM, ml + 3 * 1024, ml + 4 * 1024, gw, ngw, lane); } \
    GSYNC(); \
    { unsigned char* ws = kp()->ws; pg8::EpiUp E{(bf16*)(ws + F_A), (bf16*)(ws + F_U)}; run_gemm(LDSP, (const bf16*)(ws + WS_XN), (const bf16*)(ws + W_UP), MROWS, 2 * FF, DM, 1, MROWS, 0, E); } \
    GSYNC(); \
    { PHASE_IDX; convgate_phase((const bf16*)(ws + F_A), (bf16*)(ws + F_U), kp()->ffn_conv_w + (size_t)(layer) * 3 * FF, kp()->ffn_conv_b + (size_t)(layer) * FF, gtid, nthr); } \
    GSYNC(); \
    { unsigned char* ws = kp()->ws; float* o = kp()->out; pg8::EpiRes E{o, o, (const float*)(ws + WS_MOD) + (size_t)(layer) * 2 * 6144 + 5 * 1024}; \
      run_gemm(LDSP, (const bf16*)(ws + F_U), (const bf16*)(ws + W_DOWN), MROWS, DM, FF, 1, MROWS, 0, E); } \
    GSYNC(); } while (0)

__global__ void __launch_bounds__(NTHR, 2) fwd_kernel(Params p_unused) {
    extern __shared__ __attribute__((aligned(16))) unsigned char lds_raw[];
#ifdef PROBE_GROUP
    if (threadIdx.x == 0 && blockIdx.x == 0) { unsigned long long* tb_ = TSBUF; tb_[62] = __builtin_amdgcn_s_memrealtime(); tb_[63] = 0; }
#endif
    if (threadIdx.x == 0) { volatile LAS unsigned* st_ = (volatile LAS unsigned*)(LDSP + MISC_OFF); st_[0] = 0u; st_[1] = 0u; }
    __syncthreads();
    (void)xcd_barrier_post((unsigned*)(kp()->ws + WS_BAR), (volatile LAS unsigned*)(LDSP + MISC_OFF));
    {
        PHASE_IDX;
        LAS unsigned char* lds = LDSP;
        float* mod = (float*)(ws + WS_MOD);
        LAS float* scr = (LAS float*)(lds + wave * 16384);
        LAS float* red = (LAS float*)(lds + 131072);
        const float* cvec = kp()->c; const float* b_ada = kp()->b_ada;
        for (int it = bid; it < 192; it += G) {
            const int layer = it / 96, ch = it % 96, n = ch * 64 + lane;
            const float* W = kp()->w_ada + (size_t)layer * 1024 * 6144;
            float a0 = 0.f, a1 = 0.f;
#pragma unroll 32
            for (int kk = 0; kk < 128; ++kk) { const int k = wave * 128 + kk; const float wv = W[(size_t)k * 6144 + n]; a0 += silu_f(cvec[k]) * wv; a1 += silu_f(cvec[1024 + k]) * wv; }
            red[(wave * 2 + 0) * 64 + lane] = a0; red[(wave * 2 + 1) * 64 + lane] = a1;
            __syncthreads();
            if (wave == 0) { float t0 = b_ada[layer * 6144 + n], t1 = t0;
                for (int w = 0; w < 8; ++w) { t0 += red[(w * 2) * 64 + lane]; t1 += red[(w * 2 + 1) * 64 + lane]; }
                mod[(size_t)(layer * 2 + 0) * 6144 + n] = t0; mod[(size_t)(layer * 2 + 1) * 6144 + n] = t1; }
            __syncthreads();
        }
        constexpr int I_IN = 16 * 288, I_O = 16 * 32, I_UP = 16 * 176, I_DN = 44 * 32;
        for (int it = gw; it < I_IN + I_O + I_UP + I_DN; it += ngw) {
            int r = it;
            if (r < I_IN) { transpose_item(kp()->attn_w_in, 1024, 9216, (bf16*)(ws + W_IN), 1, scr, r, lane); continue; } r -= I_IN;
            if (r < I_O) { transpose_item(kp()->attn_w_out, 1024, 1024, (bf16*)(ws + W_OUT), 0, scr, r, lane); continue; } r -= I_O;
            if (r < I_UP) { transpose_item(kp()->ffn_w_up, 1024, 2 * FF, (bf16*)(ws + W_UP), 0, scr, r, lane); continue; } r -= I_UP;
            transpose_item(kp()->ffn_w_down, FF, 1024, (bf16*)(ws + W_DOWN), 0, scr, r, lane);
        }
    }
    if (kp()->ws == nullptr) GSYNC_CG();
    GSYNC();
#if STAGE >= 1
    { PHASE_IDX; const float* mod = (const float*)(ws + WS_MOD); modulate_phase(kp()->x, (bf16*)(ws + WS_XN), kp()->norm_mix, mod + 0 * 1024, mod + 1 * 1024, gw, ngw, lane); }
    GSYNC();
    for (int b = 0; b < 2; ++b) {
        for (int g = 0; g < 3; ++g) {
            unsigned char* ws = kp()->ws;
            const int dil = (g == 0) ? 1 : (g == 1 ? 4 : 16);
            pg8::EpiAttn E{(bf16*)(ws + A_Q) + (size_t)g * 8192 * 1024, (bf16*)(ws + A_K) + (size_t)g * 8192 * 1024, (bf16*)(ws + A_VT) + (size_t)g * 8192 * 1024};
            run_gemm(LDSP, (const bf16*)(ws + WS_XN) + (size_t)b * SEQ * DM, (const bf16*)(ws + W_IN) + (size_t)g * 3072 * 1024, SEQ, 3072, DM, dil, SEQ / dil, g * 128, E);
        }
        GSYNC();
        { PHASE_IDX; attn_phase(LDSP, (bf16*)(ws + A_Q), (const bf16*)(ws + A_K), (const bf16*)(ws + A_VT), (float*)(ws + A_LSE), tid, bid); }
        GSYNC();
        { PHASE_IDX; combine_phase((const bf16*)(ws + A_Q), (const float*)(ws + A_LSE), (bf16*)(ws + WS_XN) + (size_t)b * SEQ * DM, gtid, nthr); }
        GSYNC();
    }
    { unsigned char* ws = kp()->ws; pg8::EpiRes E{kp()->x, kp()->out, (const float*)(ws + WS_MOD) + 2 * 1024}; run_gemm(LDSP, (const bf16*)(ws + WS_XN), (const bf16*)(ws + W_OUT), MROWS, DM, DM, 1, MROWS, 0, E); }
    GSYNC();
#endif
#if STAGE >= 2
    FFN_BLOCK(0);
#endif
#if STAGE >= 3
    {
        {
            PHASE_IDX;
            const float* ml = (const float*)(ws + WS_MOD) + (size_t)2 * 6144;
            modulate_phase(kp()->out, (bf16*)(ws + WS_XN), kp()->norm_mix + DM, ml + 0 * 1024, ml + 1 * 1024, gw, ngw, lane);
            LAS float* scr = (LAS float*)(LDSP + wave * 16384);
            constexpr int I_IN = 16 * 97, I_O = 16 * 32, I_UP = 16 * 176, I_DN = 44 * 32;
            for (int it = gw; it < I_IN + I_O + I_UP + I_DN; it += ngw) {
                int r = it;
                if (r < I_IN) { transpose_item(kp()->gla_w_in, 1024, 3088, (bf16*)(ws + W_IN), 2, scr, r, lane); continue; } r -= I_IN;
                if (r < I_O) { transpose_item(kp()->gla_w_out, 1024, 1024, (bf16*)(ws + W_OUT), 0, scr, r, lane); continue; } r -= I_O;
                if (r < I_UP) { transpose_item(kp()->ffn_w_up + (size_t)1024 * 2 * FF, 1024, 2 * FF, (bf16*)(ws + W_UP), 0, scr, r, lane); continue; } r -= I_UP;
                transpose_item(kp()->ffn_w_down + (size_t)FF * 1024, FF, 1024, (bf16*)(ws + W_DOWN), 0, scr, r, lane);
            }
            for (int i = gtid; i < 240 * 1024 / 8; i += nthr) ((u32x4*)(ws + W_IN + (size_t)3088 * 1024 * 2))[i] = (u32x4){0u, 0u, 0u, 0u};
        }
        GSYNC();
        { unsigned char* ws = kp()->ws; pg8::EpiGla E{(bf16*)(ws + G_Q), (bf16*)(ws + G_K), (bf16*)(ws + G_VT), (bf16*)(ws + G_R), (float*)(ws + G_GL)};
          run_gemm(LDSP, (const bf16*)(ws + WS_XN), (const bf16*)(ws + W_IN), MROWS, 3328, DM, 1, MROWS, 0, E); }
        GSYNC();
        { PHASE_IDX; gla_g3_phase(LDSP, (bf16*)(ws + G_Q), (bf16*)(ws + G_K), (const bf16*)(ws + G_VT), (const float*)(ws + G_GL), kp()->gla_w_gate, kp()->gla_b_gate, (float*)(ws + G_DEC), (bf16*)(ws + G_ST), G); }
        GSYNC();
        { PHASE_IDX; gla_scan_phase((bf16*)(ws + G_ST), (const float*)(ws + G_DEC), gtid, nthr); }
        GSYNC();
        { PHASE_IDX; gla_g5_phase(LDSP, (const bf16*)(ws + G_Q), (const bf16*)(ws + G_K), (const bf16*)(ws + G_VT), (const bf16*)(ws + G_R), (const bf16*)(ws + G_ST), kp()->gla_norm, (bf16*)(ws + WS_XN), G); }
        GSYNC();
        { unsigned char* ws = kp()->ws; float* o = kp()->out; pg8::EpiRes E{o, o, (const float*)(ws + WS_MOD) + (size_t)2 * 6144 + 2 * 1024}; run_gemm(LDSP, (const bf16*)(ws + WS_XN), (const bf16*)(ws + W_OUT), MROWS, DM, DM, 1, MROWS, 0, E); }
        GSYNC();
    }
#endif
#if STAGE >= 4
    FFN_BLOCK(1);
#endif
    { PHASE_IDX;
#if STAGE >= 1
      final_norm_phase(kp()->out, kp()->out, kp()->norm_final, gw, ngw, lane);
#else
      final_norm_phase(kp()->x, kp()->out, kp()->norm_final, gw, ngw, lane);
#endif
    }
#ifdef PROBE_GROUP
    if (threadIdx.x == 0 && blockIdx.x == 0) {
        unsigned long long* tb_ = TSBUF; const unsigned long long tend = __builtin_amdgcn_s_memrealtime();
        unsigned long long d[24]; d[0] = tb_[0] - tb_[62]; for (int k = 1; k < 23; ++k) d[k] = tb_[k] - tb_[k - 1]; d[23] = tend - tb_[22];
        unsigned long long sel = 0;
        if (PROBE_GROUP == 1) sel = d[2] + d[5] + d[8] + d[10] + d[12] + d[14] + d[18] + d[20] + d[22];
        if (PROBE_GROUP == 2) sel = d[3] + d[6];
        if (PROBE_GROUP == 3) sel = d[15] + d[16] + d[17];
        if (PROBE_GROUP == 4) sel = d[1] + d[9] + d[13] + d[19] + d[23];
        if (PROBE_GROUP == 5) sel = d[11] + d[21];
        if (PROBE_GROUP == 6) sel = d[0];
        if (PROBE_GROUP == 7) sel = d[4] + d[7];
        if (PROBE_GROUP == 8) sel = d[10] + d[20];
        if (PROBE_GROUP == 9) sel = d[2] + d[5];
        if (PROBE_GROUP == 10) sel = d[16];
        if (PROBE_GROUP == 11) sel = d[15];
        const unsigned long long t0 = __builtin_amdgcn_s_memrealtime();
        while (__builtin_amdgcn_s_memrealtime() - t0 < 2 * sel) __builtin_amdgcn_s_sleep(8);
    }
#endif
}

extern "C" void kernel_launch(void* const* d_in, const int* in_sizes, int n_in, void* d_out, int out_size, void* d_ws, size_t ws_size, hipStream_t stream) {
    static int grid = 0;
    if (grid == 0) {
        if (n_in != 18 || ws_size < WS_END) { fprintf(stderr, "kernel_launch: unexpected n_in %d / ws_size %zu\n", n_in, ws_size); grid = -1; return; }
        int dev = 0, cus = 0, per_cu = 0;
        hipGetDevice(&dev);
        hipDeviceGetAttribute(&cus, hipDeviceAttributeMultiprocessorCount, dev);
        hipFuncSetAttribute((const void*)fwd_kernel, hipFuncAttributeMaxDynamicSharedMemorySize, LDS_BYTES);
        hipOccupancyMaxActiveBlocksPerMultiprocessor(&per_cu, (const void*)fwd_kernel, NTHR, LDS_BYTES);
        if (per_cu < 1) { fprintf(stderr, "kernel_launch: occupancy query says %d blocks per CU\n", per_cu); grid = -1; return; }
        grid = cus;
    }
    if (grid < 0) return;
    if (hipMemsetAsync((char*)d_ws + WS_BAR, 0, 16384, stream) != hipSuccess) { fprintf(stderr, "kernel_launch: memset of barrier words failed\n"); return; }
    Params p{};
    const float** pp = (const float**)&p;
    for (int i = 0; i < 18; ++i) pp[i] = (const float*)d_in[i];
    p.out = (float*)d_out; p.ws = (unsigned char*)d_ws;
    void* args[] = {&p};
    hipError_t e = hipLaunchCooperativeKernel((const void*)fwd_kernel, dim3(grid), dim3(NTHR), args, LDS_BYTES, stream);
    if (e != hipSuccess) fprintf(stderr, "cooperative launch failed: %s (grid %d)\n", hipGetErrorString(e), grid);
}
```

```cpp
#include <hip/hip_runtime.h>
#include <hip/hip_cooperative_groups.h>
#include <cstdio>
#include <cstdint>
namespace cg = cooperative_groups;
#ifndef STAGE
#define STAGE 4
#endif
namespace pg8 {
#define PG8_LAS __attribute__((address_space(3)))
typedef unsigned short bf16_t;
typedef short bf16x8 __attribute__((ext_vector_type(8)));
typedef float f32x4 __attribute__((ext_vector_type(4)));
typedef unsigned u32x4 __attribute__((ext_vector_type(4)));
constexpr int BM = 256, BK = 64, HALF = 128, HTB = HALF * BK * 2  , STAGE_BYTES = 8 * HTB, NXCD = 8, WGM = 8;

__host__ __device__ __forceinline__ int lds_byte(int r, int c) { const int st = (r >> 4) * 2 + (c >> 5), rr = r & 15, cc = c & 31, ob = rr * 64 + cc * 2; return st * 1024 + (ob ^ (((ob >> 9) & 1) << 5)); }
__host__ __device__ __forceinline__ void stage_rc(int b, int& R, int& C) { const int st = b / 1024, sb = b % 1024, swz = sb ^ (((sb >> 9) & 1) << 5); R = (st >> 1) * 16 + swz / 64; C = (st & 1) * 32 + (swz % 64) / 2; }
__host__ __device__ __forceinline__ int perm32(int rho) { const int n = rho >> 4, i = rho & 15; return 8 * (i >> 2) + 4 * n + (i & 3); }

struct Unit { int pm, pn; };
struct Gemm { const bf16_t* A; const bf16_t* Bt; int M, N, K; int dil, L;
    __device__ __forceinline__ size_t a_off(int pm) const { const int n0 = pm * 256; return (size_t)((n0 / L) + dil * (n0 % L)) * (size_t)K * 2; } };

struct StaticOrder {
    int nM, nN, nwg, G, c;
    __host__ __device__ void init(int M, int N, int G_, int c_) { nM = M / BM; nN = N / BM; nwg = nM * nN; G = G_; c = c_; }
    __host__ __device__ bool next(int i, Unit& u) const {
        const long L = (long)i * G + c; if (L >= nwg) return false;
        int wgid = (int)L; { const int q = nwg / NXCD, r = nwg % NXCD, xcd = wgid % NXCD, off = wgid / NXCD; wgid = (xcd < r ? xcd * (q + 1) : r * (q + 1) + (xcd - r) * q) + off; }
        const int nig = WGM * nN, gid = wgid / nig, fm = gid * WGM, gsz = (nM - fm) < WGM ? (nM - fm) : WGM;
        u.pm = fm + ((wgid % nig) % gsz); u.pn = (wgid % nig) / gsz; return true;
    }
    __device__ __forceinline__ void a_ready(const Unit&) const {}
    __device__ __forceinline__ void done(const Unit&) const {}
};

typedef unsigned u32x4 __attribute__((ext_vector_type(4)));
typedef float f32x2_t __attribute__((ext_vector_type(2))); typedef __bf16 bf16x2_t __attribute__((ext_vector_type(2)));
__device__ __forceinline__ unsigned cvt_pk_bf16(float lo, float hi) { f32x2_t v = {lo, hi}; bf16x2_t b = __builtin_convertvector(v, bf16x2_t); return __builtin_bit_cast(unsigned, b); }
__device__ __forceinline__ void store_rm_bf16(const f32x4 (&acc)[2][2][4][2], bf16_t* base, int ld, int row0, int col0) {
#pragma unroll
    for (int ai = 0; ai < 2; ++ai)
#pragma unroll
        for (int m = 0; m < 4; ++m) { bf16_t* rowp = base + (size_t)(row0 + ai * HALF + m * 16) * ld + col0;
#pragma unroll
            for (int bj = 0; bj < 2; ++bj) { const f32x4 v0 = acc[ai][bj][m][0], v1 = acc[ai][bj][m][1];
                u32x4 w; w.x = cvt_pk_bf16(v0[0], v0[1]); w.y = cvt_pk_bf16(v0[2], v0[3]); w.z = cvt_pk_bf16(v1[0], v1[1]); w.w = cvt_pk_bf16(v1[2], v1[3]);
                *(u32x4*)(rowp + bj * HALF) = w; } }
}
__device__ __forceinline__ void store_tr_bf16(const f32x4 (&acc)[2][2][4][2], bf16_t* base, size_t pitch, int row0, int col0) {
#pragma unroll
    for (int ai = 0; ai < 2; ++ai)
#pragma unroll
        for (int m = 0; m < 4; ++m) { bf16_t* rp = base + (row0 + ai * HALF + m * 16);
#pragma unroll
            for (int bj = 0; bj < 2; ++bj)
#pragma unroll
                for (int n = 0; n < 2; ++n) { const f32x4 v = acc[ai][bj][m][n]; const unsigned p0 = cvt_pk_bf16(v[0], v[1]), p1 = cvt_pk_bf16(v[2], v[3]);
                    bf16_t* cp = rp + (size_t)(col0 + bj * HALF + 4 * n) * pitch;
                    cp[0] = (bf16_t)(p0 & 0xffffu); cp[pitch] = (bf16_t)(p0 >> 16); cp[2 * pitch] = (bf16_t)(p1 & 0xffffu); cp[3 * pitch] = (bf16_t)(p1 >> 16); } }
}
struct EpiAttn {
    static constexpr bool PERM = true, AFTER_DRAIN = false;
    bf16_t* Q; bf16_t* Kb; bf16_t* VT;
    __device__ __forceinline__ void operator()(const f32x4 (&acc)[2][2][4][2], const Unit& u, int wr, int wc, int fr, int fq) const {
        const int row0 = u.pm * BM + wr * 64 + fr, col0 = (u.pn & 3) * BM + wc * 32 + 8 * fq;
        if (u.pn < 8) store_rm_bf16(acc, u.pn < 4 ? Q : Kb, 1024, row0, col0);
        else store_tr_bf16(acc, VT, 8192, row0, col0);
    }
};
struct EpiGla {
    static constexpr bool PERM = true, AFTER_DRAIN = false;
    bf16_t* Q; bf16_t* Kb; bf16_t* VT; bf16_t* R; float* GL;
    __device__ __forceinline__ void operator()(const f32x4 (&acc)[2][2][4][2], const Unit& u, int wr, int wc, int fr, int fq) const {
        const int row0 = u.pm * BM + wr * 64 + fr, cw = wc * 32 + 8 * fq;
        if (u.pn < 2) store_rm_bf16(acc, Q, 512, row0, u.pn * BM + cw);
        else if (u.pn < 4) store_rm_bf16(acc, Kb, 512, row0, (u.pn - 2) * BM + cw);
        else if (u.pn < 8) store_tr_bf16(acc, VT, 16384, row0, (u.pn - 4) * BM + cw);
        else if (u.pn < 12) store_rm_bf16(acc, R, 1024, row0, (u.pn - 8) * BM + cw);
        else if (wc == 0 && fq < 2) {
#pragma unroll
            for (int ai = 0; ai < 2; ++ai)
#pragma unroll
                for (int m = 0; m < 4; ++m) { float* gp = GL + (size_t)(row0 + ai * HALF + m * 16) * 16 + 8 * fq;
                    *(f32x4*)gp = acc[ai][0][m][0]; *(f32x4*)(gp + 4) = acc[ai][0][m][1]; }
        }
    }
};
struct EpiUp {
    static constexpr bool PERM = true, AFTER_DRAIN = false;
    bf16_t* Ab; bf16_t* Ub;
    __device__ __forceinline__ void operator()(const f32x4 (&acc)[2][2][4][2], const Unit& u, int wr, int wc, int fr, int fq) const {
        const int row0 = u.pm * BM + wr * 64 + fr, cw = wc * 32 + 8 * fq;
        if (u.pn < 11) store_rm_bf16(acc, Ab, 2816, row0, u.pn * BM + cw); else store_rm_bf16(acc, Ub, 2816, row0, (u.pn - 11) * BM + cw);
    }
};
struct EpiRes {
    static constexpr bool PERM = false, AFTER_DRAIN = false;
    const float* base; float* out; const float* gate;
    __device__ __forceinline__ void operator()(const f32x4 (&acc)[2][2][4][2], const Unit& u, int wr, int wc, int fr, int fq) const {
        const int row0 = u.pm * BM + wr * 64 + fr, col0 = u.pn * BM + wc * 32 + 4 * fq;
        const float* gp = gate + (size_t)((u.pm * BM) >> 13) * 6144 + col0;
        f32x4 gv[2][2];
#pragma unroll
        for (int bj = 0; bj < 2; ++bj)
#pragma unroll
            for (int n = 0; n < 2; ++n) gv[bj][n] = *(const f32x4*)(gp + bj * HALF + n * 16);
#pragma unroll
        for (int ai = 0; ai < 2; ++ai)
#pragma unroll
            for (int m = 0; m < 4; ++m) { const size_t off = (size_t)(row0 + ai * HALF + m * 16) * 1024 + col0;
#pragma unroll
                for (int bj = 0; bj < 2; ++bj)
#pragma unroll
                    for (int n = 0; n < 2; ++n) { const f32x4 bs = *(const f32x4*)(base + off + bj * HALF + n * 16);
                        *(f32x4*)(out + off + bj * HALF + n * 16) = bs + gv[bj][n] * acc[ai][bj][m][n]; } }
    }
};
template <class Epi, class Sched, bool ALIGN_EPI = false, bool SP2 = false>
__device__ __forceinline__ void gemm_phase(PG8_LAS unsigned char* lds, const Gemm g, const Sched& S, const Epi& E, const int tid_in) {
    const int tid = tid_in, wid = __builtin_amdgcn_readfirstlane(tid >> 6), lane = tid & 63, wr = wid >> 2, wc = wid & 3, fr = lane & 15, fq = lane >> 4;
    const int K = g.K, nt = K / BK, lda = g.dil * K;
    unsigned voffA[2], voffB[2];
#pragma unroll
    for (int i = 0; i < 2; ++i) { int R, C; stage_rc(tid * 16 + i * 8192, R, C); const int Rb = Epi::PERM ? ((R & ~31) + perm32(R & 31)) : R;
        voffA[i] = (unsigned)(R * lda + C) * 2u; voffB[i] = (unsigned)(Rb * K + C) * 2u; }
    const size_t kstep = (size_t)(BK * 2);
     const size_t hstepA = (size_t)HALF * lda * 2, hstepB = (size_t)HALF * K * 2;
    const size_t tstepB = 2 * hstepB;
    const unsigned ldsw = (unsigned)wid * 1024u;
    const int aoff = lds_byte(wr * 64 + fr, fq * 8), boff = lds_byte(wc * 32 + fr, fq * 8);
#define PG8_SA(b, h) (((b) * 2 + (h)) * HTB)
#define PG8_SB(b, h) ((4 + (b) * 2 + (h)) * HTB)
#define PG8_STAGE(bufoff, gbase, voff) do { _Pragma("unroll") for (int _i = 0; _i < 2; ++_i) \
        __builtin_amdgcn_global_load_lds((const unsigned*)((const char*)(gbase) + (voff)[_i]), (PG8_LAS unsigned*)(lds + (bufoff) + ldsw + _i * 8192), 16, 0, 0); } while (0)
#define PG8_LDA(dst, b, h) do { _Pragma("unroll") for (int m = 0; m < 4; ++m) _Pragma("unroll") for (int k = 0; k < 2; ++k) dst[m][k] = *(const PG8_LAS bf16x8*)(lds + PG8_SA(b, h) + aoff + m * 2048 + k * 1024); } while (0)
#define PG8_LDB(dst, b, h) do { _Pragma("unroll") for (int n = 0; n < 2; ++n) _Pragma("unroll") for (int k = 0; k < 2; ++k) dst[n][k] = *(const PG8_LAS bf16x8*)(lds + PG8_SB(b, h) + boff + n * 2048 + k * 1024); } while (0)
#define PG8_MMA(ai, bj, At, Bt) do { __builtin_amdgcn_s_setprio(1); _Pragma("unroll") for (int m = 0; m < 4; ++m) _Pragma("unroll") for (int n = 0; n < 2; ++n) _Pragma("unroll") for (int k = 0; k < 2; ++k) \
        acc[ai][bj][m][n] = __builtin_amdgcn_mfma_f32_16x16x32_bf16(Bt[n][k], At[m][k], acc[ai][bj][m][n], 0, 0, 0); __builtin_amdgcn_s_setprio(0); } while (0)
#define PG8_WAIT_V(n) asm volatile("s_waitcnt vmcnt(" #n ")" ::: "memory")
#define PG8_WAIT_L(n) asm volatile("s_waitcnt lgkmcnt(" #n ")" ::: "memory")
#define PG8_BAR __builtin_amdgcn_s_barrier()
#define PG8_SCHED __builtin_amdgcn_sched_barrier(0)
    Unit cur, nxt; int ui = 0;
    if (!S.next(0, cur)) return;
    f32x4 acc[2][2][4][2];
#pragma unroll
    for (int a = 0; a < 2; ++a)
#pragma unroll
        for (int b = 0; b < 2; ++b)
#pragma unroll
            for (int m = 0; m < 4; ++m)
#pragma unroll
                for (int n = 0; n < 2; ++n) acc[a][b][m][n] = (f32x4){0.f, 0.f, 0.f, 0.f};
    bf16x8 At[4][2], B0[2][2], B1[2][2];
    const char* cA = (const char*)g.A + g.a_off(cur.pm); const char* cB = (const char*)g.Bt + (size_t)cur.pn * tstepB;
    S.a_ready(cur);
    if constexpr (SP2) {
        PG8_STAGE(PG8_SB(0, 0), cB, voffB); PG8_STAGE(PG8_SB(0, 1), cB + hstepB, voffB); PG8_STAGE(PG8_SA(0, 0), cA, voffA); PG8_STAGE(PG8_SA(0, 1), cA + hstepA, voffA);
        if (wr == 1) PG8_BAR;
        PG8_WAIT_V(2); PG8_BAR;
        PG8_STAGE(PG8_SB(1, 0), cB + kstep, voffB); PG8_STAGE(PG8_SA(1, 0), cA + kstep, voffA); PG8_STAGE(PG8_SB(1, 1), cB + hstepB + kstep, voffB);
        PG8_WAIT_V(6); PG8_BAR;
    } else {
        PG8_STAGE(PG8_SB(0, 0), cB, voffB); PG8_STAGE(PG8_SA(0, 0), cA, voffA); PG8_STAGE(PG8_SB(0, 1), cB + hstepB, voffB); PG8_STAGE(PG8_SA(0, 1), cA + hstepA, voffA);
        if (wr == 1) PG8_BAR;
        PG8_WAIT_V(4); PG8_BAR;
        PG8_STAGE(PG8_SB(1, 0), cB + kstep, voffB); PG8_STAGE(PG8_SA(1, 0), cA + kstep, voffA); PG8_STAGE(PG8_SB(1, 1), cB + hstepB + kstep, voffB);
        PG8_WAIT_V(6); PG8_BAR;
    }
    for (;;) {
        const bool has_next = S.next(ui + 1, nxt);
        const char* nA = has_next ? (const char*)g.A + g.a_off(nxt.pm) : cA; const char* nB = has_next ? (const char*)g.Bt + (size_t)nxt.pn * tstepB : cB;
        for (int t = 0; t < nt; t += 2) {
            const bool last = (t == nt - 2);
            const char* a1 = cA + (size_t)(t + 1) * kstep;
            const char* a2 = last ? nA : cA + (size_t)(t + 2) * kstep; const char* b2 = last ? nB : cB + (size_t)(t + 2) * kstep;
            const char* a3 = a2 + kstep; const char* b3 = b2 + kstep;
            if (last && has_next) S.a_ready(nxt);
            if constexpr (SP2) {
            PG8_LDB(B0, 0, 0); PG8_LDB(B1, 0, 1); PG8_SCHED; PG8_LDA(At, 0, 0); PG8_STAGE(PG8_SA(1, 1), a1 + hstepA, voffA);
            PG8_WAIT_V(8); PG8_WAIT_L(0); PG8_BAR; PG8_MMA(0, 0, At, B0); PG8_MMA(0, 1, At, B1); PG8_BAR; PG8_SCHED;
            PG8_LDA(At, 0, 1); PG8_STAGE(PG8_SB(0, 0), b2, voffB); PG8_STAGE(PG8_SB(0, 1), b2 + hstepB, voffB); PG8_STAGE(PG8_SA(0, 0), a2, voffA);
            PG8_WAIT_V(8); PG8_WAIT_L(0); PG8_BAR; PG8_MMA(1, 0, At, B0); PG8_MMA(1, 1, At, B1); PG8_BAR; PG8_SCHED;
            PG8_LDB(B0, 1, 0); PG8_LDB(B1, 1, 1); PG8_SCHED; PG8_LDA(At, 1, 0); PG8_STAGE(PG8_SA(0, 1), a2 + hstepA, voffA);
            PG8_WAIT_V(8); PG8_WAIT_L(0); PG8_BAR; PG8_MMA(0, 0, At, B0); PG8_MMA(0, 1, At, B1); PG8_BAR; PG8_SCHED;
            PG8_LDA(At, 1, 1); PG8_STAGE(PG8_SB(1, 0), b3, voffB); PG8_STAGE(PG8_SB(1, 1), b3 + hstepB, voffB); PG8_STAGE(PG8_SA(1, 0), a3, voffA);
            PG8_WAIT_V(8); PG8_WAIT_L(0); PG8_BAR; PG8_MMA(1, 0, At, B0); PG8_MMA(1, 1, At, B1); PG8_BAR; PG8_SCHED;
            } else {
            PG8_LDB(B0, 0, 0); PG8_SCHED; PG8_LDA(At, 0, 0); PG8_STAGE(PG8_SA(1, 1), a1 + hstepA, voffA);
            PG8_WAIT_L(8); PG8_BAR; PG8_WAIT_L(0); PG8_MMA(0, 0, At, B0); PG8_BAR; PG8_SCHED;
            PG8_LDB(B1, 0, 1); PG8_STAGE(PG8_SB(0, 0), b2, voffB);
            PG8_BAR; PG8_WAIT_L(0); PG8_MMA(0, 1, At, B1); PG8_BAR;
            PG8_LDA(At, 0, 1); PG8_STAGE(PG8_SA(0, 0), a2, voffA);
            PG8_BAR; PG8_WAIT_L(0); PG8_MMA(1, 0, At, B0); PG8_BAR; PG8_SCHED;
            PG8_STAGE(PG8_SB(0, 1), b2 + hstepB, voffB);
            PG8_WAIT_V(6); PG8_BAR; PG8_MMA(1, 1, At, B1); PG8_BAR;
            PG8_LDB(B0, 1, 0); PG8_SCHED; PG8_LDA(At, 1, 0); PG8_STAGE(PG8_SA(0, 1), a2 + hstepA, voffA);
            PG8_WAIT_L(8); PG8_BAR; PG8_WAIT_L(0); PG8_MMA(0, 0, At, B0); PG8_BAR; PG8_SCHED;
            PG8_LDB(B1, 1, 1); PG8_STAGE(PG8_SB(1, 0), b3, voffB);
            PG8_BAR; PG8_WAIT_L(0); PG8_MMA(0, 1, At, B1); PG8_BAR;
            PG8_LDA(At, 1, 1); PG8_STAGE(PG8_SA(1, 0), a3, voffA);
            PG8_BAR; PG8_WAIT_L(0); PG8_MMA(1, 0, At, B0); PG8_BAR; PG8_SCHED;
            PG8_STAGE(PG8_SB(1, 1), b3 + hstepB, voffB);
            PG8_WAIT_V(6); PG8_BAR; PG8_MMA(1, 1, At, B1); PG8_BAR;
            }
        }
        if constexpr (ALIGN_EPI) { if (wr == 0) PG8_BAR; }
        if constexpr (!Epi::AFTER_DRAIN) { E(acc, cur, wr, wc, fr, fq); S.done(cur); }
        if (!has_next) break;
#pragma unroll
        for (int a = 0; a < 2; ++a)
#pragma unroll
            for (int b = 0; b < 2; ++b)
#pragma unroll
                for (int m = 0; m < 4; ++m)
#pragma unroll
                    for (int n = 0; n < 2; ++n) acc[a][b][m][n] = (f32x4){0.f, 0.f, 0.f, 0.f};
        cur = nxt; cA = nA; cB = nB; ++ui;
        if constexpr (ALIGN_EPI) { if (wr == 1) PG8_BAR; }
    }
    PG8_WAIT_V(0);
    if constexpr (!ALIGN_EPI) { if (wr == 0) PG8_BAR; }
    PG8_BAR;
    if constexpr (Epi::AFTER_DRAIN) { E.fused(acc, cur, wr, wc, fr, fq, lds, wid, lane); S.done(cur); }
#undef PG8_SA
#undef PG8_SB
#undef PG8_STAGE
#undef PG8_LDA
#undef PG8_LDB
#undef PG8_MMA
#undef PG8_WAIT_V
#undef PG8_WAIT_L
#undef PG8_BAR
#undef PG8_SCHED
}
}
#define LAS __attribute__((address_space(3)))
typedef unsigned short bf16;
typedef short bf16x8 __attribute__((ext_vector_type(8)));
typedef float f32x4 __attribute__((ext_vector_type(4)));
typedef float f32x2 __attribute__((ext_vector_type(2)));
typedef float f32x16 __attribute__((ext_vector_type(16)));
typedef unsigned u32x4 __attribute__((ext_vector_type(4)));
typedef unsigned u32x2 __attribute__((ext_vector_type(2)));
#define MFMA32(a, b, c) __builtin_amdgcn_mfma_f32_32x32x16_bf16((a), (b), (c), 0, 0, 0)

constexpr int NWAVES = 8, NTHR = 512;
constexpr int SEQ = 8192, DM = 1024, MROWS = 16384, FF = 2816;
constexpr float EPS = 1e-6f;
constexpr size_t MiB = 1u << 20;
constexpr size_t WS_MOD = 0;
constexpr size_t WS_W = 1 * MiB;
constexpr size_t W_IN = WS_W, W_OUT = WS_W + 18 * MiB, W_UP = WS_W + 20 * MiB, W_DOWN = WS_W + 31 * MiB;
constexpr size_t WS_XN = 38 * MiB;
constexpr size_t WS_BIG = 70 * MiB;
constexpr size_t A_Q = WS_BIG, A_K = WS_BIG + 48 * MiB, A_VT = WS_BIG + 96 * MiB, A_LSE = WS_BIG + 144 * MiB;
constexpr size_t F_A = WS_BIG, F_U = WS_BIG + 88 * MiB;
constexpr size_t G_Q = WS_BIG, G_K = WS_BIG + 16 * MiB, G_R = WS_BIG + 32 * MiB, G_VT = WS_BIG + 64 * MiB, G_GL = WS_BIG + 96 * MiB, G_DEC = WS_BIG + 97 * MiB, G_ST = WS_BIG + 98 * MiB;
constexpr size_t WS_END = 256 * MiB;
static_assert(G_ST + 64 * MiB <= WS_END && F_U + 88 * MiB <= WS_END && A_LSE + 2 * MiB <= WS_END, "ws map");
constexpr int LDS_BYTES = 147456;

__device__ __forceinline__ float wave_sum(float v, int lane) {
#pragma unroll
    for (int o = 1; o < 64; o <<= 1) v += __int_as_float(__builtin_amdgcn_ds_bpermute((lane ^ o) << 2, __float_as_int(v)));
    return v;
}
__device__ __forceinline__ float xor32_max(float v) { auto rr = __builtin_amdgcn_permlane32_swap(__float_as_uint(v), __float_as_uint(v), false, false); return fmaxf(__uint_as_float(rr[0]), __uint_as_float(rr[1])); }
__device__ __forceinline__ float xor32_sum(float v) { auto rr = __builtin_amdgcn_permlane32_swap(__float_as_uint(v), __float_as_uint(v), false, false); return __uint_as_float(rr[0]) + __uint_as_float(rr[1]); }
__device__ __forceinline__ unsigned pkbf(float lo, float hi) { return pg8::cvt_pk_bf16(lo, hi); }
__device__ __forceinline__ float bflo(unsigned w) { return __uint_as_float(w << 16); }
__device__ __forceinline__ float bfhi(unsigned w) { return __uint_as_float(w & 0xffff0000u); }
__device__ __forceinline__ float silu_f(float x) { return x * __builtin_amdgcn_rcpf(1.0f + __builtin_amdgcn_exp2f(-1.4426950408889634f * x)); }
__device__ __forceinline__ int crow(int r, int hi) { return (r & 3) + 8 * (r >> 2) + 4 * hi; }
__device__ __forceinline__ bf16x8 pack8(const f32x16& x, int s) {
    u32x4 p; p.x = pkbf(x[8 * s], x[8 * s + 1]); p.y = pkbf(x[8 * s + 2], x[8 * s + 3]); p.z = pkbf(x[8 * s + 4], x[8 * s + 5]); p.w = pkbf(x[8 * s + 6], x[8 * s + 7]);
    return __builtin_bit_cast(bf16x8, p);
}
__device__ __forceinline__ bf16x8 ld2x8(const bf16* p) {
    const u32x2 a = *(const u32x2*)p, b = *(const u32x2*)(p + 8); u32x4 r; r.x = a.x; r.y = a.y; r.z = b.x; r.w = b.y; return __builtin_bit_cast(bf16x8, r);
}

__device__ __forceinline__ int remap_col(int mode, int n) {
    if (mode == 1) { const int blk = n >> 10, rest = n & 1023, which = blk / 3, g = blk - which * 3; return g * 3072 + which * 1024 + rest; }
    if (mode == 2) { return n < 2048 ? n : (n < 2064 ? 3072 + (n - 2048) : n - 16); }
    return n;
}
__device__ __forceinline__ void transpose_item(const float* W, int K, int N, bf16* WT, int mode, LAS float* scr, int item, int lane) {
    const int nblk = (N + 31) / 32, kb = item / nblk, nb = item % nblk, k0 = 64 * kb, n0 = 32 * nb;
    const int ncol = n0 + (lane & 31); const bool ok = ncol < N;
    float tv[32];
#pragma unroll
    for (int i = 0; i < 32; ++i) { const int kk = 2 * i + (lane >> 5); tv[i] = ok ? W[(size_t)(k0 + kk) * N + ncol] : 0.f; }
#pragma unroll
    for (int i = 0; i < 32; ++i) { const int kk = 2 * i + (lane >> 5); scr[kk * 33 + (lane & 31)] = tv[i]; }
    asm volatile("s_waitcnt lgkmcnt(0)" ::: "memory");
    const int c = lane & 7;
#pragma unroll
    for (int j = 0; j < 4; ++j) { const int n = (lane >> 3) + 8 * j; const LAS float* s = scr + (8 * c) * 33 + n;
        u32x4 o; o.x = pkbf(s[0 * 33], s[1 * 33]); o.y = pkbf(s[2 * 33], s[3 * 33]); o.z = pkbf(s[4 * 33], s[5 * 33]); o.w = pkbf(s[6 * 33], s[7 * 33]);
        if (n0 + n < N) *(u32x4*)(WT + (size_t)remap_col(mode, n0 + n) * K + k0 + 8 * c) = o; }
    asm volatile("s_waitcnt lgkmcnt(0)" ::: "memory");
}
__device__ __forceinline__ void modulate_phase(const float* xin, bf16* xn, const float* gain, const float* shift, const float* scale  , int gw, int ngw, int lane) {
    for (int b = 0; b < 2; ++b) {
        f32x4 A[4], B[4];
#pragma unroll
        for (int j = 0; j < 4; ++j) { const int c = 256 * j + 4 * lane; const f32x4 g = *(const f32x4*)(gain + c), sc = *(const f32x4*)(scale + b * 6144 + c); A[j] = g * (1.0f + sc); B[j] = *(const f32x4*)(shift + b * 6144 + c); }
        for (int m0 = gw; m0 < SEQ; m0 += 4 * ngw) {
            f32x4 v[4][4]; float s[4];
#pragma unroll
            for (int r = 0; r < 4; ++r) { const int m = m0 + r * ngw; s[r] = 0.f;
                if (m < SEQ) { const f32x4* xr = (const f32x4*)(xin + ((size_t)b * SEQ + m) * DM) + lane;
#pragma unroll
                    for (int j = 0; j < 4; ++j) v[r][j] = xr[64 * j]; } }
#pragma unroll
            for (int r = 0; r < 4; ++r) { if (m0 + r * ngw < SEQ) {
#pragma unroll
                for (int j = 0; j < 4; ++j) s[r] += (v[r][j].x * v[r][j].x + v[r][j].y * v[r][j].y) + (v[r][j].z * v[r][j].z + v[r][j].w * v[r][j].w); } }
#pragma unroll
            for (int r = 0; r < 4; ++r) s[r] = wave_sum(s[r], lane);
#pragma unroll
            for (int r = 0; r < 4; ++r) { const int m = m0 + r * ngw;
                if (m < SEQ) { const float rs = 1.0f / sqrtf(s[r] * (1.0f / DM) + EPS); u32x2* o8 = (u32x2*)(xn + ((size_t)b * SEQ + m) * DM) + lane;
#pragma unroll
                    for (int j = 0; j < 4; ++j) { const f32x4 y = v[r][j] * rs * A[j] + B[j]; u32x2 w; w.x = pkbf(y.x, y.y); w.y = pkbf(y.z, y.w); o8[64 * j] = w; } } }
        }
    }
}
__device__ __forceinline__ void final_norm_phase(const float* xin, float* out, const float* gain, int gw, int ngw, int lane) {
    f32x4 A[4];
#pragma unroll
    for (int j = 0; j < 4; ++j) A[j] = *(const f32x4*)(gain + 256 * j + 4 * lane);
    for (int m0 = gw; m0 < MROWS; m0 += 4 * ngw) {
        f32x4 v[4][4]; float s[4];
#pragma unroll
        for (int r = 0; r < 4; ++r) { const int m = m0 + r * ngw; s[r] = 0.f;
            if (m < MROWS) { const f32x4* xr = (const f32x4*)(xin + (size_t)m * DM) + lane;
#pragma unroll
                for (int j = 0; j < 4; ++j) v[r][j] = xr[64 * j]; } }
#pragma unroll
        for (int r = 0; r < 4; ++r) { if (m0 + r * ngw < MROWS) {
#pragma unroll
            for (int j = 0; j < 4; ++j) s[r] += (v[r][j].x * v[r][j].x + v[r][j].y * v[r][j].y) + (v[r][j].z * v[r][j].z + v[r][j].w * v[r][j].w); } }
#pragma unroll
        for (int r = 0; r < 4; ++r) s[r] = wave_sum(s[r], lane);
#pragma unroll
        for (int r = 0; r < 4; ++r) { const int m = m0 + r * ngw;
            if (m < MROWS) { const float rs = 1.0f / sqrtf(s[r] * (1.0f / DM) + EPS); f32x4* o = (f32x4*)(out + (size_t)m * DM) + lane;
#pragma unroll
                for (int j = 0; j < 4; ++j) o[64 * j] = v[r][j] * rs * A[j]; } }
    }
}

__device__ __forceinline__ void attn_phase(LAS unsigned char* lds, bf16* Qg, const bf16* Kg, const bf16* VT, float* LSE, int tid, int bid) {
    const int lane = tid & 63, wave = __builtin_amdgcn_readfirstlane(tid >> 6), q = lane & 31, hi = lane >> 5;
    LAS unsigned char* Ks = lds;
    LAS unsigned char* Vs = lds + 55296;
    const int G = gridDim.x;
    u32x4 kreg[6], vreg[6];
#define ATT_LOAD(bu_) do { const int qb_ = (bu_) & 31, h_ = ((bu_) >> 5) & 15, g_ = (bu_) >> 9; const int L_ = (g_ == 0) ? 8192 : (g_ == 1 ? 2048 : 512); \
        const int n0b_ = 256 * qb_; const bool first_ = (n0b_ & (L_ - 1)) == 0; \
        const bf16* Kb_ = Kg + ((size_t)g_ * 8192 + n0b_ - 128) * 1024 + h_ * 64; const bf16* Vb_ = VT + ((size_t)g_ * 1024 + h_ * 64) * 8192 + (n0b_ - 128); \
        _Pragma("unroll") for (int i_ = 0; i_ < 6; ++i_) { const int idx_ = tid + 512 * i_; const int row_ = idx_ >> 3, ch_ = idx_ & 7, e_ = idx_ / 48, cv_ = idx_ - e_ * 48; \
            if (!first_ || row_ >= 128) kreg[i_] = *(const u32x4*)(Kb_ + (size_t)row_ * 1024 + ch_ * 8); \
            if (!first_ || cv_ >= 16) vreg[i_] = *(const u32x4*)(Vb_ + (size_t)e_ * 8192 + cv_ * 8); } } while (0)
    if (bid < 1536) ATT_LOAD(bid);
    for (int bu = bid; bu < 1536; bu += G) {
        asm volatile("" : "+v"(tid));
        const int qb = bu & 31, h = (bu >> 5) & 15, g = bu >> 9;
        const int L = (g == 0) ? 8192 : (g == 1 ? 2048 : 512);
        const int n0 = 256 * qb + 32 * wave, m0 = n0 & (L - 1);
        const int kt_lo = (m0 >= 128) ? 0 : ((128 - m0) >> 5);
        bf16* Qp = Qg + ((size_t)g * 8192 + n0 + q) * 1024 + h * 64;
        bf16x8 qf[4];
#pragma unroll
        for (int s = 0; s < 4; ++s) qf[s] = *(const bf16x8*)(Qp + 16 * s + 8 * hi);
        __syncthreads();
#pragma unroll
        for (int i = 0; i < 6; ++i) { const int idx = tid + 512 * i; const int row = idx >> 3, ch = idx & 7, e = idx / 48, cv = idx - e * 48;
            *(LAS u32x4*)(Ks + row * 144 + ch * 16) = kreg[i]; *(LAS u32x4*)(Vs + e * 784 + cv * 16) = vreg[i]; }
        __syncthreads();
        if (bu + G < 1536) ATT_LOAD(bu + G);
        f32x16 S[5];
#pragma unroll
        for (int kt = 0; kt < 5; ++kt) {
            f32x16 acc;
#pragma unroll
            for (int r = 0; r < 16; ++r) acc[r] = 0.f;
            if (kt >= kt_lo) {
                const LAS unsigned char* Kp = Ks + (32 * wave + 32 * kt + q) * 144 + 16 * hi;
#pragma unroll
                for (int s = 0; s < 4; ++s) { const bf16x8 kf = *(const LAS bf16x8*)(Kp + 32 * s); acc = MFMA32(kf, qf[s], acc); }
            }
#pragma unroll
            for (int r = 0; r < 16; ++r) {
                const int kk = crow(r, hi);
                bool valid = kt >= kt_lo;
                if (kt == 0) valid = valid && (kk >= q);
                if (kt == 4) valid = valid && (kk <= q);
                acc[r] = valid ? acc[r] : -1e30f;
            }
            S[kt] = acc;
        }
        float mx = -1e30f;
#pragma unroll
        for (int kt = 0; kt < 5; ++kt)
#pragma unroll
            for (int r = 0; r < 16; ++r) mx = fmaxf(mx, S[kt][r]);
        mx = xor32_max(mx);
        const float c2 = 0.125f * 1.4426950408889634f;
        float l = 0.f;
#pragma unroll
        for (int kt = 0; kt < 5; ++kt)
#pragma unroll
            for (int r = 0; r < 16; ++r) { const float p = __builtin_amdgcn_exp2f((S[kt][r] - mx) * c2); S[kt][r] = p; l += p; }
        l = xor32_sum(l);
        f32x16 O[2];
#pragma unroll
        for (int r = 0; r < 16; ++r) { O[0][r] = 0.f; O[1][r] = 0.f; }
#pragma unroll
        for (int kt = 0; kt < 5; ++kt) {
            if (kt >= kt_lo) {
#pragma unroll
                for (int jj = 0; jj < 2; ++jj) {
                    const bf16x8 pf = pack8(S[kt], jj);
#pragma unroll
                    for (int et = 0; et < 2; ++et) {
                        const LAS unsigned char* Vp = Vs + (32 * et + q) * 784 + (32 * wave + 32 * kt + 16 * jj + 4 * hi) * 2;
                        const u32x2 a = *(const LAS u32x2*)Vp, b = *(const LAS u32x2*)(Vp + 16); u32x4 vv; vv.x = a.x; vv.y = a.y; vv.z = b.x; vv.w = b.y;
                        O[et] = MFMA32(__builtin_bit_cast(bf16x8, vv), pf, O[et]);
                    }
                }
            }
        }
        const float inv = 1.0f / l;
#pragma unroll
        for (int et = 0; et < 2; ++et)
#pragma unroll
            for (int rg = 0; rg < 4; ++rg) { u32x2 w; w.x = pkbf(O[et][4 * rg] * inv, O[et][4 * rg + 1] * inv); w.y = pkbf(O[et][4 * rg + 2] * inv, O[et][4 * rg + 3] * inv);
                *(u32x2*)(Qp + 32 * et + 8 * rg + 4 * hi) = w; }
        if (hi == 0) LSE[((size_t)g * 8192 + n0 + q) * 16 + h] = mx * 0.125f + __logf(l);
    }
#undef ATT_LOAD
}
__device__ __forceinline__ void combine_phase(const bf16* Qg, const float* LSE, bf16* O  , int gtid, int nthr) {
    for (int i = gtid; i < 8192 * 128; i += nthr) {
        const int t = i >> 7, ch = i & 127, head = ch >> 3;
        int np[3]; np[0] = t; np[1] = (t & 3) * 2048 + (t >> 2); np[2] = (t & 15) * 512 + (t >> 4);
        float ls[3];
#pragma unroll
        for (int g = 0; g < 3; ++g) ls[g] = LSE[((size_t)g * 8192 + np[g]) * 16 + head];
        const float mx = fmaxf(ls[0], fmaxf(ls[1], ls[2]));
        float w[3]; float sw = 0.f;
#pragma unroll
        for (int g = 0; g < 3; ++g) { w[g] = __expf(ls[g] - mx); sw += w[g]; }
        const float isw = 1.0f / sw;
        float acc[8];
#pragma unroll
        for (int e = 0; e < 8; ++e) acc[e] = 0.f;
#pragma unroll
        for (int g = 0; g < 3; ++g) { const u32x4 v = *(const u32x4*)(Qg + ((size_t)g * 8192 + np[g]) * 1024 + 8 * ch); const float wg = w[g] * isw;
            acc[0] += wg * bflo(v.x); acc[1] += wg * bfhi(v.x); acc[2] += wg * bflo(v.y); acc[3] += wg * bfhi(v.y);
            acc[4] += wg * bflo(v.z); acc[5] += wg * bfhi(v.z); acc[6] += wg * bflo(v.w); acc[7] += wg * bfhi(v.w); }
        u32x4 o; o.x = pkbf(acc[0], acc[1]); o.y = pkbf(acc[2], acc[3]); o.z = pkbf(acc[4], acc[5]); o.w = pkbf(acc[6], acc[7]);
        *(u32x4*)(O + (size_t)t * 1024 + 8 * ch) = o;
    }
}

__device__ __forceinline__ void convgate_phase(const bf16* Ab, bf16* Ub, const float* cw, const float* cb, int gtid, int nthr) {
    for (int it = gtid; it < 1024 * 352; it += nthr) {
        const int rb = it / 352, ch = it - rb * 352, col = ch * 8, row0 = rb * 16;
        float w0[8], w1[8], w2[8], bb[8], a2[8], a1[8];
#pragma unroll
        for (int e = 0; e < 8; ++e) { w0[e] = cw[col + e]; w1[e] = cw[FF + col + e]; w2[e] = cw[2 * FF + col + e]; bb[e] = cb[col + e]; a2[e] = 0.f; a1[e] = 0.f; }
        if ((row0 & (SEQ - 1)) != 0) {
            const u32x4 p2 = *(const u32x4*)(Ab + (size_t)(row0 - 2) * FF + col), p1 = *(const u32x4*)(Ab + (size_t)(row0 - 1) * FF + col);
            a2[0] = bflo(p2.x); a2[1] = bfhi(p2.x); a2[2] = bflo(p2.y); a2[3] = bfhi(p2.y); a2[4] = bflo(p2.z); a2[5] = bfhi(p2.z); a2[6] = bflo(p2.w); a2[7] = bfhi(p2.w);
            a1[0] = bflo(p1.x); a1[1] = bfhi(p1.x); a1[2] = bflo(p1.y); a1[3] = bfhi(p1.y); a1[4] = bflo(p1.z); a1[5] = bfhi(p1.z); a1[6] = bflo(p1.w); a1[7] = bfhi(p1.w);
        }
        for (int r0 = 0; r0 < 16; r0 += 8) {
            u32x4 pa[8], pu[8];
#pragma unroll
            for (int r = 0; r < 8; ++r) { const size_t off = (size_t)(row0 + r0 + r) * FF + col; pa[r] = *(const u32x4*)(Ab + off); pu[r] = *(const u32x4*)(Ub + off); }
#pragma unroll
            for (int r = 0; r < 8; ++r) {
                float a[8], uu[8], o[8];
                a[0] = bflo(pa[r].x); a[1] = bfhi(pa[r].x); a[2] = bflo(pa[r].y); a[3] = bfhi(pa[r].y); a[4] = bflo(pa[r].z); a[5] = bfhi(pa[r].z); a[6] = bflo(pa[r].w); a[7] = bfhi(pa[r].w);
                uu[0] = bflo(pu[r].x); uu[1] = bfhi(pu[r].x); uu[2] = bflo(pu[r].y); uu[3] = bfhi(pu[r].y); uu[4] = bflo(pu[r].z); uu[5] = bfhi(pu[r].z); uu[6] = bflo(pu[r].w); uu[7] = bfhi(pu[r].w);
#pragma unroll
                for (int e = 0; e < 8; ++e) { const float y = w0[e] * a2[e] + w1[e] * a1[e] + w2[e] * a[e] + bb[e]; o[e] = silu_f(y) * uu[e]; a2[e] = a1[e]; a1[e] = a[e]; }
                u32x4 w; w.x = pkbf(o[0], o[1]); w.y = pkbf(o[2], o[3]); w.z = pkbf(o[4], o[5]); w.w = pkbf(o[6], o[7]);
                *(u32x4*)(Ub + (size_t)(row0 + r0 + r) * FF + col) = w;
            }
        }
    }
}
__device__ __forceinline__ void gla_g3_phase(LAS unsigned char* lds, bf16* Qb, bf16* Kb, const bf16* VT, const float* GL, const float* w_gate, const float* b_gate, float* DEC, bf16* ST, int G) {
    LAS float* Bc = (LAS float*)lds;
    LAS float* SEG = (LAS float*)(lds + 32768);
    LAS bf16* KET = (LAS bf16*)(lds + 36864);
    LAS float* GLS = (LAS float*)(lds + 57344);
    const int tid = threadIdx.x, lane = tid & 63, wave = tid >> 6, hi = lane >> 5, l31 = lane & 31;
    for (int item = blockIdx.x; item < 1024; item += G) {
        const int h = item & 3, c = (item >> 2) & 127, b = item >> 9; const size_t t0 = (size_t)b * SEQ + 64 * c;
        const f32x2 glv = *(const f32x2*)(GL + t0 * 16 + 2 * tid);
        u32x4 qv[2], kv[2];
#pragma unroll
        for (int i = 0; i < 2; ++i) { const int idx = tid + 512 * i, j = idx >> 4, kc = (idx & 15) * 8; qv[i] = *(const u32x4*)(Qb + (t0 + j) * 512 + h * 128 + kc); kv[i] = *(const u32x4*)(Kb + (t0 + j) * 512 + h * 128 + kc); }
        bf16x8 vfr[4];
        { const bf16* Vp = VT + (size_t)(h * 256 + 32 * wave + l31) * MROWS + t0 + 8 * hi;
#pragma unroll
          for (int s4 = 0; s4 < 4; ++s4) vfr[s4] = *(const bf16x8*)(Vp + 16 * s4); }
        *(LAS f32x2*)(GLS + 2 * tid) = glv;
        __syncthreads();
        {
            const int k = tid & 127, jq = tid >> 7;
            float wg[16];
#pragma unroll
            for (int i = 0; i < 16; ++i) wg[i] = w_gate[i * 512 + h * 128 + k];
            const float bg = b_gate[h * 128 + k];
            float run = 0.f;
            for (int jj = 0; jj < 16; ++jj) { const int j = jq * 16 + jj; const LAS float* gp = GLS + j * 16; float z = bg;
#pragma unroll
                for (int i = 0; i < 16; ++i) z += gp[i] * wg[i];
                const float ls = fminf(z, 0.f) - 0.6931471805599453f * __builtin_amdgcn_logf(1.0f + __builtin_amdgcn_exp2f(-1.4426950408889634f * fabsf(z)));
                run += ls * (1.0f / 16.0f); Bc[j * 128 + k] = run; }
            SEG[jq * 128 + k] = run;
            __syncthreads();
            float off = 0.f;
            for (int qq = 0; qq < jq; ++qq) off += SEG[qq * 128 + k];
            for (int jj = 0; jj < 16; ++jj) Bc[(jq * 16 + jj) * 128 + k] += off;
            __syncthreads();
            if (tid < 128) DEC[(size_t)item * 128 + tid] = __expf(Bc[63 * 128 + tid]);
        }
#pragma unroll
        for (int i = 0; i < 2; ++i) { const int idx = tid + 512 * i, j = idx >> 4, kc = (idx & 15) * 8;
            bf16* qp = Qb + (t0 + j) * 512 + h * 128 + kc; bf16* kp = Kb + (t0 + j) * 512 + h * 128 + kc;
            float qf[8], kf[8], qd[8], kd[8];
            qf[0] = bflo(qv[i].x); qf[1] = bfhi(qv[i].x); qf[2] = bflo(qv[i].y); qf[3] = bfhi(qv[i].y); qf[4] = bflo(qv[i].z); qf[5] = bfhi(qv[i].z); qf[6] = bflo(qv[i].w); qf[7] = bfhi(qv[i].w);
            kf[0] = bflo(kv[i].x); kf[1] = bfhi(kv[i].x); kf[2] = bflo(kv[i].y); kf[3] = bfhi(kv[i].y); kf[4] = bflo(kv[i].z); kf[5] = bfhi(kv[i].z); kf[6] = bflo(kv[i].w); kf[7] = bfhi(kv[i].w);
#pragma unroll
            for (int e = 0; e < 8; ++e) { const float bv = Bc[j * 128 + kc + e], bl = Bc[63 * 128 + kc + e];
                qd[e] = qf[e] * 0.08838834764831845f * __expf(bv); kd[e] = kf[e] * __expf(-bv);
                const float ke = kf[e] * __expf(bl - bv); KET[(kc + e) * 72 + (j ^ (8 * ((kc >> 3) & 7)))] = (bf16)(pkbf(ke, ke) & 0xffffu); }
            u32x4 qo, ko; qo.x = pkbf(qd[0], qd[1]); qo.y = pkbf(qd[2], qd[3]); qo.z = pkbf(qd[4], qd[5]); qo.w = pkbf(qd[6], qd[7]);
            ko.x = pkbf(kd[0], kd[1]); ko.y = pkbf(kd[2], kd[3]); ko.z = pkbf(kd[4], kd[5]); ko.w = pkbf(kd[6], kd[7]);
            *(u32x4*)qp = qo; *(u32x4*)kp = ko; }
        __syncthreads();
        {
            f32x16 acc[4];
#pragma unroll
            for (int kt = 0; kt < 4; ++kt)
#pragma unroll
                for (int r = 0; r < 16; ++r) acc[kt][r] = 0.f;
#pragma unroll
            for (int s = 0; s < 4; ++s) { const bf16x8 vf = vfr[s];
#pragma unroll
                for (int kt = 0; kt < 4; ++kt) { const bf16x8 af = *(const LAS bf16x8*)(KET + (32 * kt + l31) * 72 + 8 * ((2 * s + hi) ^ (((32 * kt + l31) >> 3) & 7))); acc[kt] = MFMA32(af, vf, acc[kt]); } }
            bf16* Sp = ST + ((size_t)item * 256 + 32 * wave + l31) * 128;
#pragma unroll
            for (int kt = 0; kt < 4; ++kt)
#pragma unroll
                for (int rg = 0; rg < 4; ++rg) { u32x2 w; w.x = pkbf(acc[kt][4 * rg], acc[kt][4 * rg + 1]); w.y = pkbf(acc[kt][4 * rg + 2], acc[kt][4 * rg + 3]);
                    *(u32x2*)(Sp + 32 * kt + 8 * rg + 4 * hi) = w; }
        }
        __syncthreads();
    }
}
__device__ __forceinline__ void gla_scan_phase(bf16* ST, const float* DEC, int gtid, int nthr) {
    for (int e = gtid; e < 2 * 4 * 256 * 64; e += nthr) {
        const int kp = e & 63, v = (e >> 6) & 255, h = (e >> 14) & 3, b = e >> 16;
        float s0 = 0.f, s1 = 0.f;
        for (int c0 = 0; c0 < 128; c0 += 16) {
            unsigned ds[16]; f32x2 dc[16];
#pragma unroll
            for (int u = 0; u < 16; ++u) { const size_t item = (size_t)(b * 128 + c0 + u) * 4 + h; ds[u] = *(const unsigned*)(ST + (item * 256 + v) * 128 + 2 * kp); dc[u] = *(const f32x2*)(DEC + item * 128 + 2 * kp); }
#pragma unroll
            for (int u = 0; u < 16; ++u) { const size_t item = (size_t)(b * 128 + c0 + u) * 4 + h;
                *(unsigned*)(ST + (item * 256 + v) * 128 + 2 * kp) = pkbf(s0, s1); s0 = dc[u].x * s0 + bflo(ds[u]); s1 = dc[u].y * s1 + bfhi(ds[u]); }
        }
    }
}
__device__ __forceinline__ void gla_g5_phase(LAS unsigned char* lds, const bf16* Qb, const bf16* Kb, const bf16* VT, const bf16* Rb, const bf16* ST, const float* gain, bf16* O, int G) {
    LAS float* red = (LAS float*)lds;
    const int tid = threadIdx.x, lane = tid & 63, wave = tid >> 6, hi = lane >> 5, l31 = lane & 31;
    const int it = wave & 1, vp = wave >> 1;
    for (int item = blockIdx.x; item < 1024; item += G) {
        const int h = item & 3, c = (item >> 2) & 127, b = item >> 9; const size_t t0 = (size_t)b * SEQ + 64 * c;
        u32x2 rpre[2][4];
#pragma unroll
        for (int vt = 0; vt < 2; ++vt)
#pragma unroll
            for (int rg = 0; rg < 4; ++rg) rpre[vt][rg] = *(const u32x2*)(Rb + (t0 + 32 * it + l31) * 1024 + h * 256 + 32 * (2 * vp + vt) + 8 * rg + 4 * hi);
        bf16x8 qf[8];
        const bf16* Qp = Qb + (t0 + 32 * it + l31) * 512 + h * 128 + 8 * hi;
#pragma unroll
        for (int s = 0; s < 8; ++s) qf[s] = *(const bf16x8*)(Qp + 16 * s);
        f32x16 AT[2];
#pragma unroll
        for (int jt = 0; jt < 2; ++jt) {
            f32x16 acc;
#pragma unroll
            for (int r = 0; r < 16; ++r) acc[r] = 0.f;
            if (jt <= it) {
                const bf16* Kp = Kb + (t0 + 32 * jt + l31) * 512 + h * 128 + 8 * hi;
#pragma unroll
                for (int s = 0; s < 8; ++s) { const bf16x8 kf = *(const bf16x8*)(Kp + 16 * s); acc = MFMA32(kf, qf[s], acc); }
                if (jt == it) {
#pragma unroll
                    for (int r = 0; r < 16; ++r) acc[r] = (crow(r, hi) <= l31) ? acc[r] : 0.f;
                }
            }
            AT[jt] = acc;
        }
        f32x16 Oa[2];
#pragma unroll
        for (int vt = 0; vt < 2; ++vt) {
            f32x16 acc;
#pragma unroll
            for (int r = 0; r < 16; ++r) acc[r] = 0.f;
            const int vcol = 32 * (2 * vp + vt) + l31;
#pragma unroll
            for (int jt = 0; jt < 2; ++jt) {
                if (jt <= it) {
#pragma unroll
                    for (int jj = 0; jj < 2; ++jj) { const bf16* Vp = VT + (size_t)(h * 256 + vcol) * MROWS + t0 + 32 * jt + 16 * jj + 4 * hi; acc = MFMA32(ld2x8(Vp), pack8(AT[jt], jj), acc); }
                }
            }
            const bf16* Sp = ST + ((size_t)item * 256 + vcol) * 128 + 8 * hi;
#pragma unroll
            for (int s = 0; s < 8; ++s) { const bf16x8 sf = *(const bf16x8*)(Sp + 16 * s); acc = MFMA32(sf, qf[s], acc); }
            Oa[vt] = acc;
        }
        float ss = 0.f;
#pragma unroll
        for (int vt = 0; vt < 2; ++vt)
#pragma unroll
            for (int r = 0; r < 16; ++r) ss += Oa[vt][r] * Oa[vt][r];
        ss = xor32_sum(ss);
        if (hi == 0) red[vp * 64 + 32 * it + l31] = ss;
        __syncthreads();
        const float tot = (red[32 * it + l31] + red[64 + 32 * it + l31]) + (red[128 + 32 * it + l31] + red[192 + 32 * it + l31]);
        const float rs = 1.0f / sqrtf(tot * (1.0f / 256.0f) + EPS);
        const size_t row = t0 + 32 * it + l31;
#pragma unroll
        for (int vt = 0; vt < 2; ++vt)
#pragma unroll
            for (int rg = 0; rg < 4; ++rg) { const int vb = 32 * (2 * vp + vt) + 8 * rg + 4 * hi;
                const f32x4 gn = *(const f32x4*)(gain + vb); const u32x2 rr = rpre[vt][rg];
                const float o0 = Oa[vt][4 * rg] * rs * gn.x * silu_f(bflo(rr.x)), o1 = Oa[vt][4 * rg + 1] * rs * gn.y * silu_f(bfhi(rr.x));
                const float o2 = Oa[vt][4 * rg + 2] * rs * gn.z * silu_f(bflo(rr.y)), o3 = Oa[vt][4 * rg + 3] * rs * gn.w * silu_f(bfhi(rr.y));
                u32x2 w; w.x = pkbf(o0, o1); w.y = pkbf(o2, o3); *(u32x2*)(O + row * 1024 + h * 256 + vb) = w; }
        __syncthreads();
    }
}

#define XB_TMO      128
#define XB_XCNT(j)  (256  + 64 * (j))
#define XB_XSUB(j)  (1280 + 64 * (j))
#define XB_XGEN(j)  (2304 + 64 * (j))
#define XB_TOP      3328
#define XB_TOPGEN   3392
#define XCD_BAR_WORDS 3456
#define XB_SPIN_CAP (1u << 18)

__device__ __forceinline__ unsigned xb_ld(unsigned* p)              { return __hip_atomic_load(p, __ATOMIC_RELAXED, __HIP_MEMORY_SCOPE_AGENT); }
__device__ __forceinline__ unsigned xb_add(unsigned* p, unsigned v) { return __hip_atomic_fetch_add(p, v, __ATOMIC_RELAXED, __HIP_MEMORY_SCOPE_AGENT); }
__device__ __forceinline__ unsigned xb_xcc_id() { return (unsigned)__builtin_amdgcn_s_getreg((3 << 11) | 20) & 0xFu; }
#define XB_SPIN(cond, bar) do { unsigned _sp = 0; while (cond) { __builtin_amdgcn_s_sleep(1); \
    if ((++_sp & 255u) == 0u) { if (xb_ld(&(bar)[XB_TMO])) break; if (_sp > XB_SPIN_CAP) { atomicAdd(&(bar)[XB_TMO], 1u); break; } } } } while (0)

struct XcdBarrier {
    unsigned* bar; unsigned x;
    volatile LAS unsigned* st;
};

__device__ __forceinline__ XcdBarrier xcd_barrier_post(unsigned* bar, volatile LAS unsigned* st) {
    XcdBarrier b; b.bar = bar; b.x = xb_xcc_id(); b.st = st;
    if (threadIdx.x == 0) (void)xb_add(&bar[XB_XCNT(b.x)], 1u);
    return b;
}
__device__ __forceinline__ void xcd_barrier_complete(unsigned* bar, unsigned x, unsigned& nloc, unsigned& nx) {
    const unsigned G = gridDim.x * gridDim.y * gridDim.z;
    unsigned sum, cnt, mine, sp = 0u;
    for (;;) {
        sum = 0u; cnt = 0u; mine = 0u;
#pragma unroll
        for (unsigned j = 0; j < 16; ++j) { const unsigned c = xb_ld(&bar[XB_XCNT(j)]); sum += c; cnt += (c > 0u) ? 1u : 0u; mine = (j == x) ? c : mine; }
        if (sum == G) break;
        __builtin_amdgcn_s_sleep(1);
        if ((++sp & 255u) == 0u) { if (xb_ld(&bar[XB_TMO])) break; if (sp > XB_SPIN_CAP) { atomicAdd(&bar[XB_TMO], 1u); break; } }
    }
    nloc = mine > 0u ? mine : 1u; nx = cnt > 0u ? cnt : 1u;
}

__device__ __forceinline__ void xcd_barrier(const XcdBarrier& b) {
    asm volatile("s_waitcnt vmcnt(0)" ::: "memory");
    __syncthreads();
    if (threadIdx.x == 0) {
        unsigned* bar = b.bar;
        __builtin_amdgcn_s_waitcnt(0);
        unsigned nloc = b.st[0], nx = b.st[1];
        if (nloc == 0u) { xcd_barrier_complete(bar, b.x, nloc, nx); b.st[0] = nloc; b.st[1] = nx; }
        const unsigned old = xb_add(&bar[XB_XSUB(b.x)], 1u);
        const unsigned gen = old / nloc;
        if (old + 1u == (gen + 1u) * nloc) {
            __builtin_amdgcn_fence(__ATOMIC_RELEASE, "agent");
            asm volatile("s_waitcnt vmcnt(0)" ::: "memory");
            const unsigned og = xb_add(&bar[XB_TOP], 1u);
            const unsigned tg = og / nx;
            if (og + 1u == (tg + 1u) * nx) xb_add(&bar[XB_TOPGEN], 1u);
            else XB_SPIN(xb_ld(&bar[XB_TOPGEN]) == tg, bar);
            __builtin_amdgcn_fence(__ATOMIC_ACQUIRE, "agent");
            xb_add(&bar[XB_XGEN(b.x)], 1u);
            asm volatile("s_waitcnt vmcnt(0)" ::: "memory");
        } else {
            XB_SPIN(xb_ld(&bar[XB_XGEN(b.x)]) == gen, bar);
            __builtin_amdgcn_fence(__ATOMIC_ACQUIRE, "agent");
            asm volatile("s_waitcnt vmcnt(0)" ::: "memory");
        }
    }
    __syncthreads();
}

constexpr size_t WS_BAR = 262144;
constexpr int MISC_OFF = 147200;
struct Params {
    const float *x, *c, *w_ada, *b_ada, *norm_mix, *norm_ffn, *attn_w_in, *attn_w_out, *gla_w_in, *gla_w_gate, *gla_b_gate, *gla_norm, *gla_w_out,
                *ffn_w_up, *ffn_conv_w, *ffn_conv_b, *ffn_w_down, *norm_final;
    float* out; unsigned char* ws;
};

typedef const __attribute__((address_space(4))) Params* kparams_t;
__device__ __forceinline__ kparams_t kp() { kparams_t q = (kparams_t)__builtin_amdgcn_kernarg_segment_ptr(); asm volatile("" : "+s"(q)); return q; }
#define PHASE_IDX int z_; asm volatile("s_mov_b32 %0, 0" : "=s"(z_)); const int tid = (int)threadIdx.x + z_, lane = tid & 63, wave = __builtin_amdgcn_readfirstlane(tid >> 6); \
    const int G = gridDim.x, bid = (int)blockIdx.x + z_, gw = bid * NWAVES + wave, ngw = G * NWAVES, gtid = bid * NTHR + tid, nthr = G * NTHR; \
    unsigned char* ws = kp()->ws; (void)lane; (void)gw; (void)ngw; (void)gtid; (void)nthr; (void)ws;
#define GSYNC_CG() do { asm volatile("s_waitcnt vmcnt(0) lgkmcnt(0)" ::: "memory"); cg::this_grid().sync(); asm volatile("" ::: "memory"); } while (0)
#define GSYNC() do { XcdBarrier b_; b_.bar = (unsigned*)(kp()->ws + WS_BAR); b_.x = xb_xcc_id(); b_.st = (volatile LAS unsigned*)(LDSP + MISC_OFF); xcd_barrier(b_); asm volatile("" ::: "memory"); } while (0)
#ifdef PROBE_GROUP
#define TSBUF ((unsigned long long*)(kp()->ws + 819200))
#undef GSYNC
#define GSYNC() do { XcdBarrier b_; b_.bar = (unsigned*)(kp()->ws + WS_BAR); b_.x = xb_xcc_id(); b_.st = (volatile LAS unsigned*)(LDSP + MISC_OFF); xcd_barrier(b_); asm volatile("" ::: "memory"); \
    if (threadIdx.x == 0 && blockIdx.x == 0) { unsigned long long* tb_ = TSBUF; const unsigned long long k_ = tb_[63]; tb_[k_] = __builtin_amdgcn_s_memrealtime(); tb_[63] = k_ + 1; } } while (0)
#endif
#define LDSP ((LAS unsigned char*)lds_raw)

template <class Epi>
__device__ __forceinline__ void run_gemm(LAS unsigned char* lds, const bf16* A, const bf16* Bt, int M, int N, int K, int dil, int L, int rot, const Epi& E) {
    pg8::Gemm g{A, Bt, M, N, K, dil, L}; pg8::StaticOrder S; const int G = gridDim.x; S.init(M, N, G, (int)((blockIdx.x + rot) % G));
    int z_; asm volatile("s_mov_b32 %0, 0" : "=s"(z_));
    pg8::gemm_phase<Epi, pg8::StaticOrder, true, true>((PG8_LAS unsigned char*)lds, g, S, E, (int)threadIdx.x + z_);
}

#define FFN_BLOCK(layer) do { \
    { PHASE_IDX; const float* ml = (const float*)(ws + WS_MOD) + (size_t)(layer) * 2 * 6144; \
      modulate_phase(kp()->out, (bf16*)(ws + WS_XN), kp()->norm_ffn + (layer) * DM, ml + 3 * 1024, ml + 4 * 1024, gw, ngw, lane); } \
    GSYNC(); \
    { unsigned char* ws = kp()->ws; pg8::EpiUp E{(bf16*)(ws + F_A), (bf16*)(ws + F_U)}; run_gemm(LDSP, (const bf16*)(ws + WS_XN), (const bf16*)(ws + W_UP), MROWS, 2 * FF, DM, 1, MROWS, 0, E); } \
    GSYNC(); \
    { PHASE_IDX; convgate_phase((const bf16*)(ws + F_A), (bf16*)(ws + F_U), kp()->ffn_conv_w + (size_t)(layer) * 3 * FF, kp()->ffn_conv_b + (size_t)(layer) * FF, gtid, nthr); } \
    GSYNC(); \
    { unsigned char* ws = kp()->ws; float* o = kp()->out; pg8::EpiRes E{o, o, (const float*)(ws + WS_MOD) + (size_t)(layer) * 2 * 6144 + 5 * 1024}; \
      run_gemm(LDSP, (const bf16*)(ws + F_U), (const bf16*)(ws + W_DOWN), MROWS, DM, FF, 1, MROWS, 0, E); } \
    GSYNC(); } while (0)

__global__ void __launch_bounds__(NTHR, 2) fwd_kernel(Params p_unused) {
    extern __shared__ __attribute__((aligned(16))) unsigned char lds_raw[];
#ifdef PROBE_GROUP
    if (threadIdx.x == 0 && blockIdx.x == 0) { unsigned long long* tb_ = TSBUF; tb_[62] = __builtin_amdgcn_s_memrealtime(); tb_[63] = 0; }
#endif
    if (threadIdx.x == 0) { volatile LAS unsigned* st_ = (volatile LAS unsigned*)(LDSP + MISC_OFF); st_[0] = 0u; st_[1] = 0u; }
    __syncthreads();
    (void)xcd_barrier_post((unsigned*)(kp()->ws + WS_BAR), (volatile LAS unsigned*)(LDSP + MISC_OFF));
    {
        PHASE_IDX;
        LAS unsigned char* lds = LDSP;
        float* mod = (float*)(ws + WS_MOD);
        LAS float* scr = (LAS float*)(lds + wave * 16384);
        LAS float* red = (LAS float*)(lds + 131072);
        const float* cvec = kp()->c; const float* b_ada = kp()->b_ada;
        for (int it = bid; it < 192; it += G) {
            const int layer = it / 96, ch = it % 96, n = ch * 64 + lane;
            const float* W = kp()->w_ada + (size_t)layer * 1024 * 6144;
            float a0 = 0.f, a1 = 0.f;
#pragma unroll 32
            for (int kk = 0; kk < 128; ++kk) { const int k = wave * 128 + kk; const float wv = W[(size_t)k * 6144 + n]; a0 += silu_f(cvec[k]) * wv; a1 += silu_f(cvec[1024 + k]) * wv; }
            red[(wave * 2 + 0) * 64 + lane] = a0; red[(wave * 2 + 1) * 64 + lane] = a1;
            __syncthreads();
            if (wave == 0) { float t0 = b_ada[layer * 6144 + n], t1 = t0;
                for (int w = 0; w < 8; ++w) { t0 += red[(w * 2) * 64 + lane]; t1 += red[(w * 2 + 1) * 64 + lane]; }
                mod[(size_t)(layer * 2 + 0) * 6144 + n] = t0; mod[(size_t)(layer * 2 + 1) * 6144 + n] = t1; }
            __syncthreads();
        }
        constexpr int I_IN = 16 * 288, I_O = 16 * 32, I_UP = 16 * 176, I_DN = 44 * 32;
        for (int it = gw; it < I_IN + I_O + I_UP + I_DN; it += ngw) {
            int r = it;
            if (r < I_IN) { transpose_item(kp()->attn_w_in, 1024, 9216, (bf16*)(ws + W_IN), 1, scr, r, lane); continue; } r -= I_IN;
            if (r < I_O) { transpose_item(kp()->attn_w_out, 1024, 1024, (bf16*)(ws + W_OUT), 0, scr, r, lane); continue; } r -= I_O;
            if (r < I_UP) { transpose_item(kp()->ffn_w_up, 1024, 2 * FF, (bf16*)(ws + W_UP), 0, scr, r, lane); continue; } r -= I_UP;
            transpose_item(kp()->ffn_w_down, FF, 1024, (bf16*)(ws + W_DOWN), 0, scr, r, lane);
        }
    }
    if (kp()->ws == nullptr) GSYNC_CG();
    GSYNC();
#if STAGE >= 1
    { PHASE_IDX; const float* mod = (const float*)(ws + WS_MOD); modulate_phase(kp()->x, (bf16*)(ws + WS_XN), kp()->norm_mix, mod + 0 * 1024, mod + 1 * 1024, gw, ngw, lane); }
    GSYNC();
    for (int b = 0; b < 2; ++b) {
        for (int g = 0; g < 3; ++g) {
            unsigned char* ws = kp()->ws;
            const int dil = (g == 0) ? 1 : (g == 1 ? 4 : 16);
            pg8::EpiAttn E{(bf16*)(ws + A_Q) + (size_t)g * 8192 * 1024, (bf16*)(ws + A_K) + (size_t)g * 8192 * 1024, (bf16*)(ws + A_VT) + (size_t)g * 8192 * 1024};
            run_gemm(LDSP, (const bf16*)(ws + WS_XN) + (size_t)b * SEQ * DM, (const bf16*)(ws + W_IN) + (size_t)g * 3072 * 1024, SEQ, 3072, DM, dil, SEQ / dil, g * 128, E);
        }
        GSYNC();
        { PHASE_IDX; attn_phase(LDSP, (bf16*)(ws + A_Q), (const bf16*)(ws + A_K), (const bf16*)(ws + A_VT), (float*)(ws + A_LSE), tid, bid); }
        GSYNC();
        { PHASE_IDX; combine_phase((const bf16*)(ws + A_Q), (const float*)(ws + A_LSE), (bf16*)(ws + WS_XN) + (size_t)b * SEQ * DM, gtid, nthr); }
        GSYNC();
    }
    { unsigned char* ws = kp()->ws; pg8::EpiRes E{kp()->x, kp()->out, (const float*)(ws + WS_MOD) + 2 * 1024}; run_gemm(LDSP, (const bf16*)(ws + WS_XN), (const bf16*)(ws + W_OUT), MROWS, DM, DM, 1, MROWS, 0, E); }
    GSYNC();
#endif
#if STAGE >= 2
    FFN_BLOCK(0);
#endif
#if STAGE >= 3
    {
        {
            PHASE_IDX;
            const float* ml = (const float*)(ws + WS_MOD) + (size_t)2 * 6144;
            modulate_phase(kp()->out, (bf16*)(ws + WS_XN), kp()->norm_mix + DM, ml + 0 * 1024, ml + 1 * 1024, gw, ngw, lane);
            LAS float* scr = (LAS float*)(LDSP + wave * 16384);
            constexpr int I_IN = 16 * 97, I_O = 16 * 32, I_UP = 16 * 176, I_DN = 44 * 32;
            for (int it = gw; it < I_IN + I_O + I_UP + I_DN; it += ngw) {
                int r = it;
                if (r < I_IN) { transpose_item(kp()->gla_w_in, 1024, 3088, (bf16*)(ws + W_IN), 2, scr, r, lane); continue; } r -= I_IN;
                if (r < I_O) { transpose_item(kp()->gla_w_out, 1024, 1024, (bf16*)(ws + W_OUT), 0, scr, r, lane); continue; } r -= I_O;
                if (r < I_UP) { transpose_item(kp()->ffn_w_up + (size_t)1024 * 2 * FF, 1024, 2 * FF, (bf16*)(ws + W_UP), 0, scr, r, lane); continue; } r -= I_UP;
                transpose_item(kp()->ffn_w_down + (size_t)FF * 1024, FF, 1024, (bf16*)(ws + W_DOWN), 0, scr, r, lane);
            }
            for (int i = gtid; i < 240 * 1024 / 8; i += nthr) ((u32x4*)(ws + W_IN + (size_t)3088 * 1024 * 2))[i] = (u32x4){0u, 0u, 0u, 0u};
        }
        GSYNC();
        { unsigned char* ws = kp()->ws; pg8::EpiGla E{(bf16*)(ws + G_Q), (bf16*)(ws + G_K), (bf16*)(ws + G_VT), (bf16*)(ws + G_R), (float*)(ws + G_GL)};
          run_gemm(LDSP, (const bf16*)(ws + WS_XN), (const bf16*)(ws + W_IN), MROWS, 3328, DM, 1, MROWS, 0, E); }
        GSYNC();
        { PHASE_IDX; gla_g3_phase(LDSP, (bf16*)(ws + G_Q), (bf16*)(ws + G_K), (const bf16*)(ws + G_VT), (const float*)(ws + G_GL), kp()->gla_w_gate, kp()->gla_b_gate, (float*)(ws + G_DEC), (bf16*)(ws + G_ST), G); }
        GSYNC();
        { PHASE_IDX; gla_scan_phase((bf16*)(ws + G_ST), (const float*)(ws + G_DEC), gtid, nthr); }
        GSYNC();
        { PHASE_IDX; gla_g5_phase(LDSP, (const bf16*)(ws + G_Q), (const bf16*)(ws + G_K), (const bf16*)(ws + G_VT), (const bf16*)(ws + G_R), (const bf16*)(ws + G_ST), kp()->gla_norm, (bf16*)(ws + WS_XN), G); }
        GSYNC();
        { unsigned char* ws = kp()->ws; float* o = kp()->out; pg8::EpiRes E{o, o, (const float*)(ws + WS_MOD) + (size_t)2 * 6144 + 2 * 1024}; run_gemm(LDSP, (const bf16*)(ws + WS_XN), (const bf16*)(ws + W_OUT), MROWS, DM, DM, 1, MROWS, 0, E); }
        GSYNC();
    }
#endif
#if STAGE >= 4
    FFN_BLOCK(1);
#endif
    { PHASE_IDX;
#if STAGE >= 1
      final_norm_phase(kp()->out, kp()->out, kp()->norm_final, gw, ngw, lane);
#else
      final_norm_phase(kp()->x, kp()->out, kp()->norm_final, gw, ngw, lane);
#endif
    }
#ifdef PROBE_GROUP
    if (threadIdx.x == 0 && blockIdx.x == 0) {
        unsigned long long* tb_ = TSBUF; const unsigned long long tend = __builtin_amdgcn_s_memrealtime();
        unsigned long long d[24]; d[0] = tb_[0] - tb_[62]; for (int k = 1; k < 23; ++k) d[k] = tb_[k] - tb_[k - 1]; d[23] = tend - tb_[22];
        unsigned long long sel = 0;
        if (PROBE_GROUP == 1) sel = d[2] + d[5] + d[8] + d[10] + d[12] + d[14] + d[18] + d[20] + d[22];
        if (PROBE_GROUP == 2) sel = d[3] + d[6];
        if (PROBE_GROUP == 3) sel = d[15] + d[16] + d[17];
        if (PROBE_GROUP == 4) sel = d[1] + d[9] + d[13] + d[19] + d[23];
        if (PROBE_GROUP == 5) sel = d[11] + d[21];
        if (PROBE_GROUP == 6) sel = d[0];
        if (PROBE_GROUP == 7) sel = d[4] + d[7];
        if (PROBE_GROUP == 8) sel = d[10] + d[20];
        if (PROBE_GROUP == 9) sel = d[2] + d[5];
        if (PROBE_GROUP == 10) sel = d[16];
        if (PROBE_GROUP == 11) sel = d[15];
        const unsigned long long t0 = __builtin_amdgcn_s_memrealtime();
        while (__builtin_amdgcn_s_memrealtime() - t0 < 2 * sel) __builtin_amdgcn_s_sleep(8);
    }
#endif
}

extern "C" void kernel_launch(void* const* d_in, const int* in_sizes, int n_in, void* d_out, int out_size, void* d_ws, size_t ws_size, hipStream_t stream) {
    static int grid = 0;
    if (grid == 0) {
        if (n_in != 18 || ws_size < WS_END) { fprintf(stderr, "kernel_launch: unexpected n_in %d / ws_size %zu\n", n_in, ws_size); grid = -1; return; }
        int dev = 0, cus = 0, per_cu = 0;
        hipGetDevice(&dev);
        hipDeviceGetAttribute(&cus, hipDeviceAttributeMultiprocessorCount, dev);
        hipFuncSetAttribute((const void*)fwd_kernel, hipFuncAttributeMaxDynamicSharedMemorySize, LDS_BYTES);
        hipOccupancyMaxActiveBlocksPerMultiprocessor(&per_cu, (const void*)fwd_kernel, NTHR, LDS_BYTES);
        if (per_cu < 1) { fprintf(stderr, "kernel_launch: occupancy query says %d blocks per CU\n", per_cu); grid = -1; return; }
        grid = cus;
    }
    if (grid < 0) return;
    if (hipMemsetAsync((char*)d_ws + WS_BAR, 0, 16384, stream) != hipSuccess) { fprintf(stderr, "kernel_launch: memset of barrier words failed\n"); return; }
    Params p{};
    const float** pp = (const float**)&p;
    for (int i = 0; i < 18; ++i) pp[i] = (const float*)d_in[i];
    p.out = (float*)d_out; p.ws = (unsigned char*)d_ws;
    void* args[] = {&p};
    hipError_t e = hipLaunchCooperativeKernel((const void*)fwd_kernel, dim3(grid), dim3(NTHR), args, LDS_BYTES, stream);
    if (e != hipSuccess) fprintf(stderr, "cooperative launch failed: %s (grid %d)\n", hipGetErrorString(e), grid);
}
```

```cpp
#include <hip/hip_runtime.h>
#include <hip/hip_cooperative_groups.h>
#include <cstdio>
#include <cstdint>
namespace cg = cooperative_groups;
#ifndef STAGE
#define STAGE 4
#endif
namespace pg8 {
#define PG8_LAS __attribute__((address_space(3)))
typedef unsigned short bf16_t;
typedef short bf16x8 __attribute__((ext_vector_type(8)));
typedef float f32x4 __attribute__((ext_vector_type(4)));
typedef unsigned u32x4 __attribute__((ext_vector_type(4)));
constexpr int BM = 256, BK = 64, HALF = 128, HTB = HALF * BK * 2  , STAGE_BYTES = 8 * HTB, NXCD = 8, WGM = 8;

__host__ __device__ __forceinline__ int lds_byte(int r, int c) { const int st = (r >> 4) * 2 + (c >> 5), rr = r & 15, cc = c & 31, ob = rr * 64 + cc * 2; return st * 1024 + (ob ^ (((ob >> 9) & 1) << 5)); }
__host__ __device__ __forceinline__ void stage_rc(int b, int& R, int& C) { const int st = b / 1024, sb = b % 1024, swz = sb ^ (((sb >> 9) & 1) << 5); R = (st >> 1) * 16 + swz / 64; C = (st & 1) * 32 + (swz % 64) / 2; }
__host__ __device__ __forceinline__ int perm32(int rho) { const int n = rho >> 4, i = rho & 15; return 8 * (i >> 2) + 4 * n + (i & 3); }

struct Unit { int pm, pn; };
struct Gemm { const bf16_t* A; const bf16_t* Bt; int M, N, K; int dil, L;
    __device__ __forceinline__ size_t a_off(int pm) const { const int n0 = pm * 256; return (size_t)((n0 / L) + dil * (n0 % L)) * (size_t)K * 2; } };

struct StaticOrder {
    int nM, nN, nwg, G, c;
    __host__ __device__ void init(int M, int N, int G_, int c_) { nM = M / BM; nN = N / BM; nwg = nM * nN; G = G_; c = c_; }
    __host__ __device__ bool next(int i, Unit& u) const {
        const long L = (long)i * G + c; if (L >= nwg) return false;
        int wgid = (int)L; { const int q = nwg / NXCD, r = nwg % NXCD, xcd = wgid % NXCD, off = wgid / NXCD; wgid = (xcd < r ? xcd * (q + 1) : r * (q + 1) + (xcd - r) * q) + off; }
        const int nig = WGM * nN, gid = wgid / nig, fm = gid * WGM, gsz = (nM - fm) < WGM ? (nM - fm) : WGM;
        u.pm = fm + ((wgid % nig) % gsz); u.pn = (wgid % nig) / gsz; return true;
    }
    __device__ __forceinline__ void a_ready(const Unit&) const {}
    __device__ __forceinline__ void done(const Unit&) const {}
};

typedef unsigned u32x4 __attribute__((ext_vector_type(4)));
typedef float f32x2_t __attribute__((ext_vector_type(2))); typedef __bf16 bf16x2_t __attribute__((ext_vector_type(2)));
__device__ __forceinline__ unsigned cvt_pk_bf16(float lo, float hi) { f32x2_t v = {lo, hi}; bf16x2_t b = __builtin_convertvector(v, bf16x2_t); return __builtin_bit_cast(unsigned, b); }
__device__ __forceinline__ void store_rm_bf16(const f32x4 (&acc)[2][2][4][2], bf16_t* base, int ld, int row0, int col0) {
#pragma unroll
    for (int ai = 0; ai < 2; ++ai)
#pragma unroll
        for (int m = 0; m < 4; ++m) { bf16_t* rowp = base + (size_t)(row0 + ai * HALF + m * 16) * ld + col0;
#pragma unroll
            for (int bj = 0; bj < 2; ++bj) { const f32x4 v0 = acc[ai][bj][m][0], v1 = acc[ai][bj][m][1];
                u32x4 w; w.x = cvt_pk_bf16(v0[0], v0[1]); w.y = cvt_pk_bf16(v0[2], v0[3]); w.z = cvt_pk_bf16(v1[0], v1[1]); w.w = cvt_pk_bf16(v1[2], v1[3]);
                *(u32x4*)(rowp + bj * HALF) = w; } }
}
__device__ __forceinline__ void store_tr_bf16(const f32x4 (&acc)[2][2][4][2], bf16_t* base, size_t pitch, int row0, int col0) {
#pragma unroll
    for (int ai = 0; ai < 2; ++ai)
#pragma unroll
        for (int m = 0; m < 4; ++m) { bf16_t* rp = base + (row0 + ai * HALF + m * 16);
#pragma unroll
            for (int bj = 0; bj < 2; ++bj)
#pragma unroll
                for (int n = 0; n < 2; ++n) { const f32x4 v = acc[ai][bj][m][n]; const unsigned p0 = cvt_pk_bf16(v[0], v[1]), p1 = cvt_pk_bf16(v[2], v[3]);
                    bf16_t* cp = rp + (size_t)(col0 + bj * HALF + 4 * n) * pitch;
                    cp[0] = (bf16_t)(p0 & 0xffffu); cp[pitch] = (bf16_t)(p0 >> 16); cp[2 * pitch] = (bf16_t)(p1 & 0xffffu); cp[3 * pitch] = (bf16_t)(p1 >> 16); } }
}
struct EpiAttn {
    static constexpr bool PERM = true, AFTER_DRAIN = false;
    bf16_t* Q; bf16_t* Kb; bf16_t* VT;
    __device__ __forceinline__ void operator()(const f32x4 (&acc)[2][2][4][2], const Unit& u, int wr, int wc, int fr, int fq) const {
        const int row0 = u.pm * BM + wr * 64 + fr, col0 = (u.pn & 3) * BM + wc * 32 + 8 * fq;
        if (u.pn < 8) store_rm_bf16(acc, u.pn < 4 ? Q : Kb, 1024, row0, col0);
        else store_tr_bf16(acc, VT, 8192, row0, col0);
    }
};
struct EpiGla {
    static constexpr bool PERM = true, AFTER_DRAIN = false;
    bf16_t* Q; bf16_t* Kb; bf16_t* VT; bf16_t* R; float* GL;
    __device__ __forceinline__ void operator()(const f32x4 (&acc)[2][2][4][2], const Unit& u, int wr, int wc, int fr, int fq) const {
        const int row0 = u.pm * BM + wr * 64 + fr, cw = wc * 32 + 8 * fq;
        if (u.pn < 2) store_rm_bf16(acc, Q, 512, row0, u.pn * BM + cw);
        else if (u.pn < 4) store_rm_bf16(acc, Kb, 512, row0, (u.pn - 2) * BM + cw);
        else if (u.pn < 8) store_tr_bf16(acc, VT, 16384, row0, (u.pn - 4) * BM + cw);
        else if (u.pn < 12) store_rm_bf16(acc, R, 1024, row0, (u.pn - 8) * BM + cw);
        else if (wc == 0 && fq < 2) {
#pragma unroll
            for (int ai = 0; ai < 2; ++ai)
#pragma unroll
                for (int m = 0; m < 4; ++m) { float* gp = GL + (size_t)(row0 + ai * HALF + m * 16) * 16 + 8 * fq;
                    *(f32x4*)gp = acc[ai][0][m][0]; *(f32x4*)(gp + 4) = acc[ai][0][m][1]; }
        }
    }
};
struct EpiUp {
    static constexpr bool PERM = true, AFTER_DRAIN = false;
    bf16_t* Ab; bf16_t* Ub;
    __device__ __forceinline__ void operator()(const f32x4 (&acc)[2][2][4][2], const Unit& u, int wr, int wc, int fr, int fq) const {
        const int row0 = u.pm * BM + wr * 64 + fr, cw = wc * 32 + 8 * fq;
        if (u.pn < 11) store_rm_bf16(acc, Ab, 2816, row0, u.pn * BM + cw); else store_rm_bf16(acc, Ub, 2816, row0, (u.pn - 11) * BM + cw);
    }
};
struct EpiUpConv {
    static constexpr bool PERM = true, AFTER_DRAIN = false;
    bf16_t* G; const float* cw; const float* cb; float* TA; float* HA; float* HU; PG8_LAS float* X;
    __device__ __forceinline__ void operator()(const f32x4 (&acc)[2][2][4][2], const Unit& u, int wr, int wc, int fr, int fq) const {
        const int cl = wc * 32 + 8 * fq, f = u.pn * 128 + cl;
        if (fr >= 14) {
#pragma unroll
            for (int ai = 0; ai < 2; ++ai)
#pragma unroll
                for (int n = 0; n < 2; ++n) *(PG8_LAS f32x4*)(X + ((2 * ai + wr) * 2 + (fr - 14)) * 128 + cl + 4 * n) = acc[ai][0][3][n];
            if (wr == 1) {
#pragma unroll
                for (int n = 0; n < 2; ++n) *(f32x4*)(TA + ((size_t)u.pm * 2 + (fr - 14)) * 2816 + f + 4 * n) = acc[1][0][3][n];
            }
        }
        if (wr == 0 && fr < 2) {
#pragma unroll
            for (int n = 0; n < 2; ++n) { *(f32x4*)(HA + ((size_t)u.pm * 2 + fr) * 2816 + f + 4 * n) = acc[0][0][0][n]; *(f32x4*)(HU + ((size_t)u.pm * 2 + fr) * 2816 + f + 4 * n) = acc[0][1][0][n]; }
        }
        asm volatile("s_waitcnt lgkmcnt(0)" ::: "memory"); __builtin_amdgcn_s_barrier(); asm volatile("" ::: "memory");
        f32x4 c0[2], c1[2], c2[2], cbv[2];
#pragma unroll
        for (int n = 0; n < 2; ++n) { c0[n] = *(const f32x4*)(cw + f + 4 * n); c1[n] = *(const f32x4*)(cw + 2816 + f + 4 * n); c2[n] = *(const f32x4*)(cw + 5632 + f + 4 * n); cbv[n] = *(const f32x4*)(cb + f + 4 * n); }
        const bool seq_start = (u.pm & 31) == 0;
        const int l1 = (((fr + 15) & 15) + 16 * fq) << 2, l2 = (((fr + 14) & 15) + 16 * fq) << 2;
#pragma unroll
        for (int ai = 0; ai < 2; ++ai) {
            const int strip = 2 * ai + wr;
            f32x4 P1[2], P2[2];
#pragma unroll
            for (int n = 0; n < 2; ++n) {
                if (strip > 0) { P1[n] = *(const PG8_LAS f32x4*)(X + ((strip - 1) * 2 + 1) * 128 + cl + 4 * n); P2[n] = *(const PG8_LAS f32x4*)(X + ((strip - 1) * 2 + 0) * 128 + cl + 4 * n); }
                else { P1[n] = (f32x4){0.f, 0.f, 0.f, 0.f}; P2[n] = (f32x4){0.f, 0.f, 0.f, 0.f}; }
            }
            f32x4 wp1[2], wp2[2];
#pragma unroll
            for (int n = 0; n < 2; ++n) { wp1[n] = (f32x4){0.f, 0.f, 0.f, 0.f}; wp2[n] = (f32x4){0.f, 0.f, 0.f, 0.f}; }
#pragma unroll
            for (int m = 0; m < 4; ++m) {
                unsigned pk[4];
#pragma unroll
                for (int n = 0; n < 2; ++n) {
                    const f32x4 a = acc[ai][0][m][n], uu = acc[ai][1][m][n];
                    f32x4 w1, w2, g;
#pragma unroll
                    for (int j = 0; j < 4; ++j) { w1[j] = __int_as_float(__builtin_amdgcn_ds_bpermute(l1, __float_as_int(a[j]))); w2[j] = __int_as_float(__builtin_amdgcn_ds_bpermute(l2, __float_as_int(a[j]))); }
#pragma unroll
                    for (int j = 0; j < 4; ++j) {
                        const float s1 = (fr >= 1) ? w1[j] : (m >= 1 ? wp1[n][j] : P1[n][j]);
                        const float s2 = (fr >= 2) ? w2[j] : (m >= 1 ? wp2[n][j] : (fr == 1 ? P1[n][j] : P2[n][j]));
                        const float y = c0[n][j] * s2 + c1[n][j] * s1 + c2[n][j] * a[j] + cbv[n][j];
                        g[j] = y * __builtin_amdgcn_rcpf(1.0f + __builtin_amdgcn_exp2f(-1.4426950408889634f * y)) * uu[j];
                    }
                    wp1[n] = w1; wp2[n] = w2;
                    pk[2 * n] = cvt_pk_bf16(g[0], g[1]); pk[2 * n + 1] = cvt_pk_bf16(g[2], g[3]);
                }
                const bool skip = (strip == 0) && (m == 0) && (fr < 2) && !seq_start;
                if (!skip) { u32x4 w; w.x = pk[0]; w.y = pk[1]; w.z = pk[2]; w.w = pk[3]; *(u32x4*)(G + (size_t)(u.pm * BM + ai * HALF + wr * 64 + m * 16 + fr) * 2816 + f) = w; }
            }
        }
    }
};
struct EpiRes {
    static constexpr bool PERM = false, AFTER_DRAIN = false;
    const float* base; float* out; const float* gate;
    __device__ __forceinline__ void operator()(const f32x4 (&acc)[2][2][4][2], const Unit& u, int wr, int wc, int fr, int fq) const {
        const int row0 = u.pm * BM + wr * 64 + fr, col0 = u.pn * BM + wc * 32 + 4 * fq;
        const float* gp = gate + (size_t)((u.pm * BM) >> 13) * 6144 + col0;
        f32x4 gv[2][2];
#pragma unroll
        for (int bj = 0; bj < 2; ++bj)
#pragma unroll
            for (int n = 0; n < 2; ++n) gv[bj][n] = *(const f32x4*)(gp + bj * HALF + n * 16);
#pragma unroll
        for (int ai = 0; ai < 2; ++ai)
#pragma unroll
            for (int m = 0; m < 4; ++m) { const size_t off = (size_t)(row0 + ai * HALF + m * 16) * 1024 + col0;
#pragma unroll
                for (int bj = 0; bj < 2; ++bj)
#pragma unroll
                    for (int n = 0; n < 2; ++n) { const f32x4 bs = *(const f32x4*)(base + off + bj * HALF + n * 16);
                        *(f32x4*)(out + off + bj * HALF + n * 16) = bs + gv[bj][n] * acc[ai][bj][m][n]; } }
    }
};
template <class Epi, class Sched, bool ALIGN_EPI = false, bool SP2 = false>
__device__ __forceinline__ void gemm_phase(PG8_LAS unsigned char* lds, const Gemm g, const Sched& S, const Epi& E, const int tid_in) {
    const int tid = tid_in, wid = __builtin_amdgcn_readfirstlane(tid >> 6), lane = tid & 63, wr = wid >> 2, wc = wid & 3, fr = lane & 15, fq = lane >> 4;
    const int K = g.K, nt = K / BK, lda = g.dil * K;
    unsigned voffA[2], voffB[2];
#pragma unroll
    for (int i = 0; i < 2; ++i) { int R, C; stage_rc(tid * 16 + i * 8192, R, C); const int Rb = Epi::PERM ? ((R & ~31) + perm32(R & 31)) : R;
        voffA[i] = (unsigned)(R * lda + C) * 2u; voffB[i] = (unsigned)(Rb * K + C) * 2u; }
    const size_t kstep = (size_t)(BK * 2);
     const size_t hstepA = (size_t)HALF * lda * 2, hstepB = (size_t)HALF * K * 2;
    const size_t tstepB = 2 * hstepB;
    const unsigned ldsw = (unsigned)wid * 1024u;
    const int aoff = lds_byte(wr * 64 + fr, fq * 8), boff = lds_byte(wc * 32 + fr, fq * 8);
#define PG8_SA(b, h) (((b) * 2 + (h)) * HTB)
#define PG8_SB(b, h) ((4 + (b) * 2 + (h)) * HTB)
#define PG8_STAGE(bufoff, gbase, voff) do { _Pragma("unroll") for (int _i = 0; _i < 2; ++_i) \
        __builtin_amdgcn_global_load_lds((const unsigned*)((const char*)(gbase) + (voff)[_i]), (PG8_LAS unsigned*)(lds + (bufoff) + ldsw + _i * 8192), 16, 0, 0); } while (0)
#define PG8_LDA(dst, b, h) do { _Pragma("unroll") for (int m = 0; m < 4; ++m) _Pragma("unroll") for (int k = 0; k < 2; ++k) dst[m][k] = *(const PG8_LAS bf16x8*)(lds + PG8_SA(b, h) + aoff + m * 2048 + k * 1024); } while (0)
#define PG8_LDB(dst, b, h) do { _Pragma("unroll") for (int n = 0; n < 2; ++n) _Pragma("unroll") for (int k = 0; k < 2; ++k) dst[n][k] = *(const PG8_LAS bf16x8*)(lds + PG8_SB(b, h) + boff + n * 2048 + k * 1024); } while (0)
#define PG8_MMA(ai, bj, At, Bt) do { __builtin_amdgcn_s_setprio(1); _Pragma("unroll") for (int m = 0; m < 4; ++m) _Pragma("unroll") for (int n = 0; n < 2; ++n) _Pragma("unroll") for (int k = 0; k < 2; ++k) \
        acc[ai][bj][m][n] = __builtin_amdgcn_mfma_f32_16x16x32_bf16(Bt[n][k], At[m][k], acc[ai][bj][m][n], 0, 0, 0); __builtin_amdgcn_s_setprio(0); } while (0)
#define PG8_WAIT_V(n) asm volatile("s_waitcnt vmcnt(" #n ")" ::: "memory")
#define PG8_WAIT_L(n) asm volatile("s_waitcnt lgkmcnt(" #n ")" ::: "memory")
#define PG8_BAR __builtin_amdgcn_s_barrier()
#define PG8_SCHED __builtin_amdgcn_sched_barrier(0)
    Unit cur, nxt; int ui = 0;
    if (!S.next(0, cur)) return;
    f32x4 acc[2][2][4][2];
#pragma unroll
    for (int a = 0; a < 2; ++a)
#pragma unroll
        for (int b = 0; b < 2; ++b)
#pragma unroll
            for (int m = 0; m < 4; ++m)
#pragma unroll
                for (int n = 0; n < 2; ++n) acc[a][b][m][n] = (f32x4){0.f, 0.f, 0.f, 0.f};
    bf16x8 At[4][2], B0[2][2], B1[2][2];
    const char* cA = (const char*)g.A + g.a_off(cur.pm); const char* cB = (const char*)g.Bt + (size_t)cur.pn * tstepB;
    S.a_ready(cur);
    if constexpr (SP2) {
        PG8_STAGE(PG8_SB(0, 0), cB, voffB); PG8_STAGE(PG8_SB(0, 1), cB + hstepB, voffB); PG8_STAGE(PG8_SA(0, 0), cA, voffA); PG8_STAGE(PG8_SA(0, 1), cA + hstepA, voffA);
        if (wr == 1) PG8_BAR;
        PG8_WAIT_V(2); PG8_BAR;
        PG8_STAGE(PG8_SB(1, 0), cB + kstep, voffB); PG8_STAGE(PG8_SA(1, 0), cA + kstep, voffA); PG8_STAGE(PG8_SB(1, 1), cB + hstepB + kstep, voffB);
        PG8_WAIT_V(6); PG8_BAR;
    } else {
        PG8_STAGE(PG8_SB(0, 0), cB, voffB); PG8_STAGE(PG8_SA(0, 0), cA, voffA); PG8_STAGE(PG8_SB(0, 1), cB + hstepB, voffB); PG8_STAGE(PG8_SA(0, 1), cA + hstepA, voffA);
        if (wr == 1) PG8_BAR;
        PG8_WAIT_V(4); PG8_BAR;
        PG8_STAGE(PG8_SB(1, 0), cB + kstep, voffB); PG8_STAGE(PG8_SA(1, 0), cA + kstep, voffA); PG8_STAGE(PG8_SB(1, 1), cB + hstepB + kstep, voffB);
        PG8_WAIT_V(6); PG8_BAR;
    }
    for (;;) {
        const bool has_next = S.next(ui + 1, nxt);
        const char* nA = has_next ? (const char*)g.A + g.a_off(nxt.pm) : cA; const char* nB = has_next ? (const char*)g.Bt + (size_t)nxt.pn * tstepB : cB;
        for (int t = 0; t < nt; t += 2) {
            const bool last = (t == nt - 2);
            const char* a1 = cA + (size_t)(t + 1) * kstep;
            const char* a2 = last ? nA : cA + (size_t)(t + 2) * kstep; const char* b2 = last ? nB : cB + (size_t)(t + 2) * kstep;
            const char* a3 = a2 + kstep; const char* b3 = b2 + kstep;
            if (last && has_next) S.a_ready(nxt);
            if constexpr (SP2) {
            PG8_LDB(B0, 0, 0); PG8_LDB(B1, 0, 1); PG8_SCHED; PG8_LDA(At, 0, 0); PG8_STAGE(PG8_SA(1, 1), a1 + hstepA, voffA);
            PG8_WAIT_V(8); PG8_WAIT_L(0); PG8_BAR; PG8_MMA(0, 0, At, B0); PG8_MMA(0, 1, At, B1); PG8_BAR; PG8_SCHED;
            PG8_LDA(At, 0, 1); PG8_STAGE(PG8_SB(0, 0), b2, voffB); PG8_STAGE(PG8_SB(0, 1), b2 + hstepB, voffB); PG8_STAGE(PG8_SA(0, 0), a2, voffA);
            PG8_WAIT_V(8); PG8_WAIT_L(0); PG8_BAR; PG8_MMA(1, 0, At, B0); PG8_MMA(1, 1, At, B1); PG8_BAR; PG8_SCHED;
            PG8_LDB(B0, 1, 0); PG8_LDB(B1, 1, 1); PG8_SCHED; PG8_LDA(At, 1, 0); PG8_STAGE(PG8_SA(0, 1), a2 + hstepA, voffA);
            PG8_WAIT_V(8); PG8_WAIT_L(0); PG8_BAR; PG8_MMA(0, 0, At, B0); PG8_MMA(0, 1, At, B1); PG8_BAR; PG8_SCHED;
            PG8_LDA(At, 1, 1); PG8_STAGE(PG8_SB(1, 0), b3, voffB); PG8_STAGE(PG8_SB(1, 1), b3 + hstepB, voffB); PG8_STAGE(PG8_SA(1, 0), a3, voffA);
            PG8_WAIT_V(8); PG8_WAIT_L(0); PG8_BAR; PG8_MMA(1, 0, At, B0); PG8_MMA(1, 1, At, B1); PG8_BAR; PG8_SCHED;
            } else {
            PG8_LDB(B0, 0, 0); PG8_SCHED; PG8_LDA(At, 0, 0); PG8_STAGE(PG8_SA(1, 1), a1 + hstepA, voffA);
            PG8_WAIT_L(8); PG8_BAR; PG8_WAIT_L(0); PG8_MMA(0, 0, At, B0); PG8_BAR; PG8_SCHED;
            PG8_LDB(B1, 0, 1); PG8_STAGE(PG8_SB(0, 0), b2, voffB);
            PG8_BAR; PG8_WAIT_L(0); PG8_MMA(0, 1, At, B1); PG8_BAR;
            PG8_LDA(At, 0, 1); PG8_STAGE(PG8_SA(0, 0), a2, voffA);
            PG8_BAR; PG8_WAIT_L(0); PG8_MMA(1, 0, At, B0); PG8_BAR; PG8_SCHED;
            PG8_STAGE(PG8_SB(0, 1), b2 + hstepB, voffB);
            PG8_WAIT_V(6); PG8_BAR; PG8_MMA(1, 1, At, B1); PG8_BAR;
            PG8_LDB(B0, 1, 0); PG8_SCHED; PG8_LDA(At, 1, 0); PG8_STAGE(PG8_SA(0, 1), a2 + hstepA, voffA);
            PG8_WAIT_L(8); PG8_BAR; PG8_WAIT_L(0); PG8_MMA(0, 0, At, B0); PG8_BAR; PG8_SCHED;
            PG8_LDB(B1, 1, 1); PG8_STAGE(PG8_SB(1, 0), b3, voffB);
            PG8_BAR; PG8_WAIT_L(0); PG8_MMA(0, 1, At, B1); PG8_BAR;
            PG8_LDA(At, 1, 1); PG8_STAGE(PG8_SA(1, 0), a3, voffA);
            PG8_BAR; PG8_WAIT_L(0); PG8_MMA(1, 0, At, B0); PG8_BAR; PG8_SCHED;
            PG8_STAGE(PG8_SB(1, 1), b3 + hstepB, voffB);
            PG8_WAIT_V(6); PG8_BAR; PG8_MMA(1, 1, At, B1); PG8_BAR;
            }
        }
        if constexpr (ALIGN_EPI) { if (wr == 0) PG8_BAR; }
        if constexpr (!Epi::AFTER_DRAIN) { E(acc, cur, wr, wc, fr, fq); S.done(cur); }
        if (!has_next) break;
#pragma unroll
        for (int a = 0; a < 2; ++a)
#pragma unroll
            for (int b = 0; b < 2; ++b)
#pragma unroll
                for (int m = 0; m < 4; ++m)
#pragma unroll
                    for (int n = 0; n < 2; ++n) acc[a][b][m][n] = (f32x4){0.f, 0.f, 0.f, 0.f};
        cur = nxt; cA = nA; cB = nB; ++ui;
        if constexpr (ALIGN_EPI) { if (wr == 1) PG8_BAR; }
    }
    PG8_WAIT_V(0);
    if constexpr (!ALIGN_EPI) { if (wr == 0) PG8_BAR; }
    PG8_BAR;
    if constexpr (Epi::AFTER_DRAIN) { E.fused(acc, cur, wr, wc, fr, fq, lds, wid, lane); S.done(cur); }
#undef PG8_SA
#undef PG8_SB
#undef PG8_STAGE
#undef PG8_LDA
#undef PG8_LDB
#undef PG8_MMA
#undef PG8_WAIT_V
#undef PG8_WAIT_L
#undef PG8_BAR
#undef PG8_SCHED
}
}
#define LAS __attribute__((address_space(3)))
typedef unsigned short bf16;
typedef short bf16x8 __attribute__((ext_vector_type(8)));
typedef float f32x4 __attribute__((ext_vector_type(4)));
typedef float f32x2 __attribute__((ext_vector_type(2)));
typedef float f32x16 __attribute__((ext_vector_type(16)));
typedef unsigned u32x4 __attribute__((ext_vector_type(4)));
typedef unsigned u32x2 __attribute__((ext_vector_type(2)));
#define MFMA32(a, b, c) __builtin_amdgcn_mfma_f32_32x32x16_bf16((a), (b), (c), 0, 0, 0)

constexpr int NWAVES = 8, NTHR = 512;
constexpr int SEQ = 8192, DM = 1024, MROWS = 16384, FF = 2816;
constexpr float EPS = 1e-6f;
constexpr size_t MiB = 1u << 20;
constexpr size_t WS_MOD = 0;
constexpr size_t WS_W = 1 * MiB;
constexpr size_t W_IN = WS_W, W_OUT = WS_W + 18 * MiB, W_UP = WS_W + 20 * MiB, W_DOWN = WS_W + 31 * MiB;
constexpr size_t WS_XN = 38 * MiB;
constexpr size_t WS_BIG = 70 * MiB;
constexpr size_t A_Q = WS_BIG, A_K = WS_BIG + 48 * MiB, A_VT = WS_BIG + 96 * MiB, A_LSE = WS_BIG + 144 * MiB;
constexpr size_t F_A = WS_BIG, F_U = WS_BIG + 88 * MiB;
constexpr size_t F_TA = WS_BIG, F_HA = WS_BIG + 2 * MiB, F_HU = WS_BIG + 4 * MiB;
constexpr size_t G_Q = WS_BIG, G_K = WS_BIG + 16 * MiB, G_R = WS_BIG + 32 * MiB, G_VT = WS_BIG + 64 * MiB, G_GL = WS_BIG + 96 * MiB, G_DEC = WS_BIG + 97 * MiB, G_ST = WS_BIG + 98 * MiB;
constexpr size_t WS_END = 256 * MiB;
static_assert(G_ST + 64 * MiB <= WS_END && F_U + 88 * MiB <= WS_END && A_LSE + 2 * MiB <= WS_END, "ws map");
constexpr int LDS_BYTES = 147456;

__device__ __forceinline__ float wave_sum(float v, int lane) {
#pragma unroll
    for (int o = 1; o < 64; o <<= 1) v += __int_as_float(__builtin_amdgcn_ds_bpermute((lane ^ o) << 2, __float_as_int(v)));
    return v;
}
__device__ __forceinline__ float xor32_max(float v) { auto rr = __builtin_amdgcn_permlane32_swap(__float_as_uint(v), __float_as_uint(v), false, false); return fmaxf(__uint_as_float(rr[0]), __uint_as_float(rr[1])); }
__device__ __forceinline__ float xor32_sum(float v) { auto rr = __builtin_amdgcn_permlane32_swap(__float_as_uint(v), __float_as_uint(v), false, false); return __uint_as_float(rr[0]) + __uint_as_float(rr[1]); }
__device__ __forceinline__ unsigned pkbf(float lo, float hi) { return pg8::cvt_pk_bf16(lo, hi); }
__device__ __forceinline__ float bflo(unsigned w) { return __uint_as_float(w << 16); }
__device__ __forceinline__ float bfhi(unsigned w) { return __uint_as_float(w & 0xffff0000u); }
__device__ __forceinline__ float silu_f(float x) { return x * __builtin_amdgcn_rcpf(1.0f + __builtin_amdgcn_exp2f(-1.4426950408889634f * x)); }
__device__ __forceinline__ int crow(int r, int hi) { return (r & 3) + 8 * (r >> 2) + 4 * hi; }
__device__ __forceinline__ bf16x8 pack8(const f32x16& x, int s) {
    u32x4 p; p.x = pkbf(x[8 * s], x[8 * s + 1]); p.y = pkbf(x[8 * s + 2], x[8 * s + 3]); p.z = pkbf(x[8 * s + 4], x[8 * s + 5]); p.w = pkbf(x[8 * s + 6], x[8 * s + 7]);
    return __builtin_bit_cast(bf16x8, p);
}
__device__ __forceinline__ bf16x8 ld2x8(const bf16* p) {
    const u32x2 a = *(const u32x2*)p, b = *(const u32x2*)(p + 8); u32x4 r; r.x = a.x; r.y = a.y; r.z = b.x; r.w = b.y; return __builtin_bit_cast(bf16x8, r);
}

__device__ __forceinline__ int remap_col(int mode, int n) {
    if (mode == 1) { const int blk = n >> 10, rest = n & 1023, which = blk / 3, g = blk - which * 3; return g * 3072 + which * 1024 + rest; }
    if (mode == 2) { return n < 2048 ? n : (n < 2064 ? 3072 + (n - 2048) : n - 16); }
    if (mode == 3) { const int u_ = n >= FF ? 1 : 0, f_ = n - u_ * FF; return 256 * (f_ >> 7) + 128 * u_ + (f_ & 127); }
    return n;
}
__device__ __forceinline__ void transpose_item(const float* W, int K, int N, bf16* WT, int mode, LAS float* scr, int item, int lane) {
    const int nblk = (N + 31) / 32, kb = item / nblk, nb = item % nblk, k0 = 64 * kb, n0 = 32 * nb;
    const int ncol = n0 + (lane & 31); const bool ok = ncol < N;
    float tv[32];
#pragma unroll
    for (int i = 0; i < 32; ++i) { const int kk = 2 * i + (lane >> 5); tv[i] = ok ? W[(size_t)(k0 + kk) * N + ncol] : 0.f; }
#pragma unroll
    for (int i = 0; i < 32; ++i) { const int kk = 2 * i + (lane >> 5); scr[kk * 33 + (lane & 31)] = tv[i]; }
    asm volatile("s_waitcnt lgkmcnt(0)" ::: "memory");
    const int c = lane & 7;
#pragma unroll
    for (int j = 0; j < 4; ++j) { const int n = (lane >> 3) + 8 * j; const LAS float* s = scr + (8 * c) * 33 + n;
        u32x4 o; o.x = pkbf(s[0 * 33], s[1 * 33]); o.y = pkbf(s[2 * 33], s[3 * 33]); o.z = pkbf(s[4 * 33], s[5 * 33]); o.w = pkbf(s[6 * 33], s[7 * 33]);
        if (n0 + n < N) *(u32x4*)(WT + (size_t)remap_col(mode, n0 + n) * K + k0 + 8 * c) = o; }
    asm volatile("s_waitcnt lgkmcnt(0)" ::: "memory");
}
__device__ __forceinline__ void modulate_phase(const float* xin, bf16* xn, const float* gain, const float* shift, const float* scale  , int gw, int ngw, int lane) {
    for (int b = 0; b < 2; ++b) {
        f32x4 A[4], B[4];
#pragma unroll
        for (int j = 0; j < 4; ++j) { const int c = 256 * j + 4 * lane; const f32x4 g = *(const f32x4*)(gain + c), sc = *(const f32x4*)(scale + b * 6144 + c); A[j] = g * (1.0f + sc); B[j] = *(const f32x4*)(shift + b * 6144 + c); }
        for (int m0 = gw; m0 < SEQ; m0 += 4 * ngw) {
            f32x4 v[4][4]; float s[4];
#pragma unroll
            for (int r = 0; r < 4; ++r) { const int m = m0 + r * ngw; s[r] = 0.f;
                if (m < SEQ) { const f32x4* xr = (const f32x4*)(xin + ((size_t)b * SEQ + m) * DM) + lane;
#pragma unroll
                    for (int j = 0; j < 4; ++j) v[r][j] = xr[64 * j]; } }
#pragma unroll
            for (int r = 0; r < 4; ++r) { if (m0 + r * ngw < SEQ) {
#pragma unroll
                for (int j = 0; j < 4; ++j) s[r] += (v[r][j].x * v[r][j].x + v[r][j].y * v[r][j].y) + (v[r][j].z * v[r][j].z + v[r][j].w * v[r][j].w); } }
#pragma unroll
            for (int r = 0; r < 4; ++r) s[r] = wave_sum(s[r], lane);
#pragma unroll
            for (int r = 0; r < 4; ++r) { const int m = m0 + r * ngw;
                if (m < SEQ) { const float rs = 1.0f / sqrtf(s[r] * (1.0f / DM) + EPS); u32x2* o8 = (u32x2*)(xn + ((size_t)b * SEQ + m) * DM) + lane;
#pragma unroll
                    for (int j = 0; j < 4; ++j) { const f32x4 y = v[r][j] * rs * A[j] + B[j]; u32x2 w; w.x = pkbf(y.x, y.y); w.y = pkbf(y.z, y.w); o8[64 * j] = w; } } }
        }
    }
}
__device__ __forceinline__ void final_norm_phase(const float* xin, float* out, const float* gain, int gw, int ngw, int lane) {
    f32x4 A[4];
#pragma unroll
    for (int j = 0; j < 4; ++j) A[j] = *(const f32x4*)(gain + 256 * j + 4 * lane);
    for (int m0 = gw; m0 < MROWS; m0 += 4 * ngw) {
        f32x4 v[4][4]; float s[4];
#pragma unroll
        for (int r = 0; r < 4; ++r) { const int m = m0 + r * ngw; s[r] = 0.f;
            if (m < MROWS) { const f32x4* xr = (const f32x4*)(xin + (size_t)m * DM) + lane;
#pragma unroll
                for (int j = 0; j < 4; ++j) v[r][j] = xr[64 * j]; } }
#pragma unroll
        for (int r = 0; r < 4; ++r) { if (m0 + r * ngw < MROWS) {
#pragma unroll
            for (int j = 0; j < 4; ++j) s[r] += (v[r][j].x * v[r][j].x + v[r][j].y * v[r][j].y) + (v[r][j].z * v[r][j].z + v[r][j].w * v[r][j].w); } }
#pragma unroll
        for (int r = 0; r < 4; ++r) s[r] = wave_sum(s[r], lane);
#pragma unroll
        for (int r = 0; r < 4; ++r) { const int m = m0 + r * ngw;
            if (m < MROWS) { const float rs = 1.0f / sqrtf(s[r] * (1.0f / DM) + EPS); f32x4* o = (f32x4*)(out + (size_t)m * DM) + lane;
#pragma unroll
                for (int j = 0; j < 4; ++j) o[64 * j] = v[r][j] * rs * A[j]; } }
    }
}

__device__ __forceinline__ void attn_phase(LAS unsigned char* lds, bf16* Qg, const bf16* Kg, const bf16* VT, float* LSE, int tid, int bid) {
    const int lane = tid & 63, wave = __builtin_amdgcn_readfirstlane(tid >> 6), q = lane & 31, hi = lane >> 5;
    LAS unsigned char* Ks = lds;
    LAS unsigned char* Vs = lds + 55296;
    const int G = gridDim.x;
    u32x4 kreg[6], vreg[6];
#define ATT_LOAD(bu_) do { const int qb_ = (bu_) & 31, h_ = ((bu_) >> 5) & 15, g_ = (bu_) >> 9; const int L_ = (g_ == 0) ? 8192 : (g_ == 1 ? 2048 : 512); \
        const int n0b_ = 256 * qb_; const bool first_ = (n0b_ & (L_ - 1)) == 0; \
        const bf16* Kb_ = Kg + ((size_t)g_ * 8192 + n0b_ - 128) * 1024 + h_ * 64; const bf16* Vb_ = VT + ((size_t)g_ * 1024 + h_ * 64) * 8192 + (n0b_ - 128); \
        _Pragma("unroll") for (int i_ = 0; i_ < 6; ++i_) { const int idx_ = tid + 512 * i_; const int row_ = idx_ >> 3, ch_ = idx_ & 7, e_ = idx_ / 48, cv_ = idx_ - e_ * 48; \
            if (!first_ || row_ >= 128) kreg[i_] = *(const u32x4*)(Kb_ + (size_t)row_ * 1024 + ch_ * 8); \
            if (!first_ || cv_ >= 16) vreg[i_] = *(const u32x4*)(Vb_ + (size_t)e_ * 8192 + cv_ * 8); } } while (0)
    if (bid < 1536) ATT_LOAD(bid);
    for (int bu = bid; bu < 1536; bu += G) {
        asm volatile("" : "+v"(tid));
        const int qb = bu & 31, h = (bu >> 5) & 15, g = bu >> 9;
        const int L = (g == 0) ? 8192 : (g == 1 ? 2048 : 512);
        const int n0 = 256 * qb + 32 * wave, m0 = n0 & (L - 1);
        const int kt_lo = (m0 >= 128) ? 0 : ((128 - m0) >> 5);
        bf16* Qp = Qg + ((size_t)g * 8192 + n0 + q) * 1024 + h * 64;
        bf16x8 qf[4];
#pragma unroll
        for (int s = 0; s < 4; ++s) qf[s] = *(const bf16x8*)(Qp + 16 * s + 8 * hi);
        __syncthreads();
#pragma unroll
        for (int i = 0; i < 6; ++i) { const int idx = tid + 512 * i; const int row = idx >> 3, ch = idx & 7, e = idx / 48, cv = idx - e * 48;
            *(LAS u32x4*)(Ks + row * 144 + ch * 16) = kreg[i]; *(LAS u32x4*)(Vs + e * 784 + cv * 16) = vreg[i]; }
        __syncthreads();
        if (bu + G < 1536) ATT_LOAD(bu + G);
        f32x16 S[5];
#pragma unroll
        for (int kt = 0; kt < 5; ++kt) {
            f32x16 acc;
#pragma unroll
            for (int r = 0; r < 16; ++r) acc[r] = 0.f;
            if (kt >= kt_lo) {
                const LAS unsigned char* Kp = Ks + (32 * wave + 32 * kt + q) * 144 + 16 * hi;
#pragma unroll
                for (int s = 0; s < 4; ++s) { const bf16x8 kf = *(const LAS bf16x8*)(Kp + 32 * s); acc = MFMA32(kf, qf[s], acc); }
            }
#pragma unroll
            for (int r = 0; r < 16; ++r) {
                const int kk = crow(r, hi);
                bool valid = kt >= kt_lo;
                if (kt == 0) valid = valid && (kk >= q);
                if (kt == 4) valid = valid && (kk <= q);
                acc[r] = valid ? acc[r] : -1e30f;
            }
            S[kt] = acc;
        }
        float mx = -1e30f;
#pragma unroll
        for (int kt = 0; kt < 5; ++kt)
#pragma unroll
            for (int r = 0; r < 16; ++r) mx = fmaxf(mx, S[kt][r]);
        mx = xor32_max(mx);
        const float c2 = 0.125f * 1.4426950408889634f;
        float l = 0.f;
#pragma unroll
        for (int kt = 0; kt < 5; ++kt)
#pragma unroll
            for (int r = 0; r < 16; ++r) { const float p = __builtin_amdgcn_exp2f((S[kt][r] - mx) * c2); S[kt][r] = p; l += p; }
        l = xor32_sum(l);
        f32x16 O[2];
#pragma unroll
        for (int r = 0; r < 16; ++r) { O[0][r] = 0.f; O[1][r] = 0.f; }
#pragma unroll
        for (int kt = 0; kt < 5; ++kt) {
            if (kt >= kt_lo) {
#pragma unroll
                for (int jj = 0; jj < 2; ++jj) {
                    const bf16x8 pf = pack8(S[kt], jj);
#pragma unroll
                    for (int et = 0; et < 2; ++et) {
                        const LAS unsigned char* Vp = Vs + (32 * et + q) * 784 + (32 * wave + 32 * kt + 16 * jj + 4 * hi) * 2;
                        const u32x2 a = *(const LAS u32x2*)Vp, b = *(const LAS u32x2*)(Vp + 16); u32x4 vv; vv.x = a.x; vv.y = a.y; vv.z = b.x; vv.w = b.y;
                        O[et] = MFMA32(__builtin_bit_cast(bf16x8, vv), pf, O[et]);
                    }
                }
            }
        }
        const float inv = 1.0f / l;
#pragma unroll
        for (int et = 0; et < 2; ++et)
#pragma unroll
            for (int rg = 0; rg < 4; ++rg) { u32x2 w; w.x = pkbf(O[et][4 * rg] * inv, O[et][4 * rg + 1] * inv); w.y = pkbf(O[et][4 * rg + 2] * inv, O[et][4 * rg + 3] * inv);
                *(u32x2*)(Qp + 32 * et + 8 * rg + 4 * hi) = w; }
        if (hi == 0) LSE[((size_t)g * 8192 + n0 + q) * 16 + h] = mx * 0.125f + __logf(l);
    }
#undef ATT_LOAD
}
__device__ __forceinline__ void combine_phase(const bf16* Qg, const float* LSE, bf16* O  , int gtid, int nthr) {
    for (int i = gtid; i < 8192 * 128; i += nthr) {
        const int t = i >> 7, ch = i & 127, head = ch >> 3;
        int np[3]; np[0] = t; np[1] = (t & 3) * 2048 + (t >> 2); np[2] = (t & 15) * 512 + (t >> 4);
        float ls[3];
#pragma unroll
        for (int g = 0; g < 3; ++g) ls[g] = LSE[((size_t)g * 8192 + np[g]) * 16 + head];
        const float mx = fmaxf(ls[0], fmaxf(ls[1], ls[2]));
        float w[3]; float sw = 0.f;
#pragma unroll
        for (int g = 0; g < 3; ++g) { w[g] = __expf(ls[g] - mx); sw += w[g]; }
        const float isw = 1.0f / sw;
        float acc[8];
#pragma unroll
        for (int e = 0; e < 8; ++e) acc[e] = 0.f;
#pragma unroll
        for (int g = 0; g < 3; ++g) { const u32x4 v = *(const u32x4*)(Qg + ((size_t)g * 8192 + np[g]) * 1024 + 8 * ch); const float wg = w[g] * isw;
            acc[0] += wg * bflo(v.x); acc[1] += wg * bfhi(v.x); acc[2] += wg * bflo(v.y); acc[3] += wg * bfhi(v.y);
            acc[4] += wg * bflo(v.z); acc[5] += wg * bfhi(v.z); acc[6] += wg * bflo(v.w); acc[7] += wg * bfhi(v.w); }
        u32x4 o; o.x = pkbf(acc[0], acc[1]); o.y = pkbf(acc[2], acc[3]); o.z = pkbf(acc[4], acc[5]); o.w = pkbf(acc[6], acc[7]);
        *(u32x4*)(O + (size_t)t * 1024 + 8 * ch) = o;
    }
}

__device__ __forceinline__ void convgate_phase(const bf16* Ab, bf16* Ub, const float* cw, const float* cb, int gtid, int nthr) {
    for (int it = gtid; it < 1024 * 352; it += nthr) {
        const int rb = it / 352, ch = it - rb * 352, col = ch * 8, row0 = rb * 16;
        float w0[8], w1[8], w2[8], bb[8], a2[8], a1[8];
#pragma unroll
        for (int e = 0; e < 8; ++e) { w0[e] = cw[col + e]; w1[e] = cw[FF + col + e]; w2[e] = cw[2 * FF + col + e]; bb[e] = cb[col + e]; a2[e] = 0.f; a1[e] = 0.f; }
        if ((row0 & (SEQ - 1)) != 0) {
            const u32x4 p2 = *(const u32x4*)(Ab + (size_t)(row0 - 2) * FF + col), p1 = *(const u32x4*)(Ab + (size_t)(row0 - 1) * FF + col);
            a2[0] = bflo(p2.x); a2[1] = bfhi(p2.x); a2[2] = bflo(p2.y); a2[3] = bfhi(p2.y); a2[4] = bflo(p2.z); a2[5] = bfhi(p2.z); a2[6] = bflo(p2.w); a2[7] = bfhi(p2.w);
            a1[0] = bflo(p1.x); a1[1] = bfhi(p1.x); a1[2] = bflo(p1.y); a1[3] = bfhi(p1.y); a1[4] = bflo(p1.z); a1[5] = bfhi(p1.z); a1[6] = bflo(p1.w); a1[7] = bfhi(p1.w);
        }
        for (int r0 = 0; r0 < 16; r0 += 8) {
            u32x4 pa[8], pu[8];
#pragma unroll
            for (int r = 0; r < 8; ++r) { const size_t off = (size_t)(row0 + r0 + r) * FF + col; pa[r] = *(const u32x4*)(Ab + off); pu[r] = *(const u32x4*)(Ub + off); }
#pragma unroll
            for (int r = 0; r < 8; ++r) {
                float a[8], uu[8], o[8];
                a[0] = bflo(pa[r].x); a[1] = bfhi(pa[r].x); a[2] = bflo(pa[r].y); a[3] = bfhi(pa[r].y); a[4] = bflo(pa[r].z); a[5] = bfhi(pa[r].z); a[6] = bflo(pa[r].w); a[7] = bfhi(pa[r].w);
                uu[0] = bflo(pu[r].x); uu[1] = bfhi(pu[r].x); uu[2] = bflo(pu[r].y); uu[3] = bfhi(pu[r].y); uu[4] = bflo(pu[r].z); uu[5] = bfhi(pu[r].z); uu[6] = bflo(pu[r].w); uu[7] = bfhi(pu[r].w);
#pragma unroll
                for (int e = 0; e < 8; ++e) { const float y = w0[e] * a2[e] + w1[e] * a1[e] + w2[e] * a[e] + bb[e]; o[e] = silu_f(y) * uu[e]; a2[e] = a1[e]; a1[e] = a[e]; }
                u32x4 w; w.x = pkbf(o[0], o[1]); w.y = pkbf(o[2], o[3]); w.z = pkbf(o[4], o[5]); w.w = pkbf(o[6], o[7]);
                *(u32x4*)(Ub + (size_t)(row0 + r0 + r) * FF + col) = w;
            }
        }
    }
}
__device__ __forceinline__ void convfix_phase(bf16* Gb, const float* TA, const float* HA, const float* HU, const float* cw, const float* cb, int gtid, int nthr) {
    for (int i = gtid; i < 64 * 2 * FF; i += nthr) {
        const int f = i % FF, pr = i / FF, r = pr & 1, pm = pr >> 1;
        if ((pm & 31) == 0) continue;
        const float a0 = HA[(size_t)(pm * 2 + r) * FF + f], uu = HU[(size_t)(pm * 2 + r) * FF + f];
        const float t0 = TA[(size_t)((pm - 1) * 2 + 0) * FF + f], t1 = TA[(size_t)((pm - 1) * 2 + 1) * FF + f];
        const float a1 = (r == 0) ? t1 : HA[(size_t)(pm * 2) * FF + f], a2 = (r == 0) ? t0 : t1;
        const float y = cw[f] * a2 + cw[FF + f] * a1 + cw[2 * FF + f] * a0 + cb[f];
        Gb[(size_t)(pm * 256 + r) * FF + f] = (bf16)(pkbf(silu_f(y) * uu, 0.f) & 0xffffu);
    }
}
__device__ __forceinline__ void gla_g3_phase(LAS unsigned char* lds, bf16* Qb, bf16* Kb, const bf16* VT, const float* GL, const float* w_gate, const float* b_gate, float* DEC, bf16* ST, int G) {
    LAS float* Bc = (LAS float*)lds;
    LAS float* SEG = (LAS float*)(lds + 32768);
    LAS bf16* KET = (LAS bf16*)(lds + 36864);
    LAS float* GLS = (LAS float*)(lds + 57344);
    const int tid = threadIdx.x, lane = tid & 63, wave = tid >> 6, hi = lane >> 5, l31 = lane & 31;
    for (int item = blockIdx.x; item < 1024; item += G) {
        const int h = item & 3, c = (item >> 2) & 127, b = item >> 9; const size_t t0 = (size_t)b * SEQ + 64 * c;
        const f32x2 glv = *(const f32x2*)(GL + t0 * 16 + 2 * tid);
        u32x4 qv[2], kv[2];
#pragma unroll
        for (int i = 0; i < 2; ++i) { const int idx = tid + 512 * i, j = idx >> 4, kc = (idx & 15) * 8; qv[i] = *(const u32x4*)(Qb + (t0 + j) * 512 + h * 128 + kc); kv[i] = *(const u32x4*)(Kb + (t0 + j) * 512 + h * 128 + kc); }
        bf16x8 vfr[4];
        { const bf16* Vp = VT + (size_t)(h * 256 + 32 * wave + l31) * MROWS + t0 + 8 * hi;
#pragma unroll
          for (int s4 = 0; s4 < 4; ++s4) vfr[s4] = *(const bf16x8*)(Vp + 16 * s4); }
        *(LAS f32x2*)(GLS + 2 * tid) = glv;
        __syncthreads();
        {
            const int k = tid & 127, jq = tid >> 7;
            float wg[16];
#pragma unroll
            for (int i = 0; i < 16; ++i) wg[i] = w_gate[i * 512 + h * 128 + k];
            const float bg = b_gate[h * 128 + k];
            float run = 0.f;
            for (int jj = 0; jj < 16; ++jj) { const int j = jq * 16 + jj; const LAS float* gp = GLS + j * 16; float z = bg;
#pragma unroll
                for (int i = 0; i < 16; ++i) z += gp[i] * wg[i];
                const float ls = fminf(z, 0.f) - 0.6931471805599453f * __builtin_amdgcn_logf(1.0f + __builtin_amdgcn_exp2f(-1.4426950408889634f * fabsf(z)));
                run += ls * (1.0f / 16.0f); Bc[j * 128 + k] = run; }
            SEG[jq * 128 + k] = run;
            __syncthreads();
            float off = 0.f;
            for (int qq = 0; qq < jq; ++qq) off += SEG[qq * 128 + k];
            for (int jj = 0; jj < 16; ++jj) Bc[(jq * 16 + jj) * 128 + k] += off;
            __syncthreads();
            if (tid < 128) DEC[(size_t)item * 128 + tid] = __expf(Bc[63 * 128 + tid]);
        }
#pragma unroll
        for (int i = 0; i < 2; ++i) { const int idx = tid + 512 * i, j = idx >> 4, kc = (idx & 15) * 8;
            bf16* qp = Qb + (t0 + j) * 512 + h * 128 + kc; bf16* kp = Kb + (t0 + j) * 512 + h * 128 + kc;
            float qf[8], kf[8], qd[8], kd[8];
            qf[0] = bflo(qv[i].x); qf[1] = bfhi(qv[i].x); qf[2] = bflo(qv[i].y); qf[3] = bfhi(qv[i].y); qf[4] = bflo(qv[i].z); qf[5] = bfhi(qv[i].z); qf[6] = bflo(qv[i].w); qf[7] = bfhi(qv[i].w);
            kf[0] = bflo(kv[i].x); kf[1] = bfhi(kv[i].x); kf[2] = bflo(kv[i].y); kf[3] = bfhi(kv[i].y); kf[4] = bflo(kv[i].z); kf[5] = bfhi(kv[i].z); kf[6] = bflo(kv[i].w); kf[7] = bfhi(kv[i].w);
#pragma unroll
            for (int e = 0; e < 8; ++e) { const float bv = Bc[j * 128 + kc + e], bl = Bc[63 * 128 + kc + e];
                qd[e] = qf[e] * 0.08838834764831845f * __expf(bv); kd[e] = kf[e] * __expf(-bv);
                const float ke = kf[e] * __expf(bl - bv); KET[(kc + e) * 72 + (j ^ (8 * ((kc >> 3) & 7)))] = (bf16)(pkbf(ke, ke) & 0xffffu); }
            u32x4 qo, ko; qo.x = pkbf(qd[0], qd[1]); qo.y = pkbf(qd[2], qd[3]); qo.z = pkbf(qd[4], qd[5]); qo.w = pkbf(qd[6], qd[7]);
            ko.x = pkbf(kd[0], kd[1]); ko.y = pkbf(kd[2], kd[3]); ko.z = pkbf(kd[4], kd[5]); ko.w = pkbf(kd[6], kd[7]);
            *(u32x4*)qp = qo; *(u32x4*)kp = ko; }
        __syncthreads();
        {
            f32x16 acc[4];
#pragma unroll
            for (int kt = 0; kt < 4; ++kt)
#pragma unroll
                for (int r = 0; r < 16; ++r) acc[kt][r] = 0.f;
#pragma unroll
            for (int s = 0; s < 4; ++s) { const bf16x8 vf = vfr[s];
#pragma unroll
                for (int kt = 0; kt < 4; ++kt) { const bf16x8 af = *(const LAS bf16x8*)(KET + (32 * kt + l31) * 72 + 8 * ((2 * s + hi) ^ (((32 * kt + l31) >> 3) & 7))); acc[kt] = MFMA32(af, vf, acc[kt]); } }
            bf16* Sp = ST + ((size_t)item * 256 + 32 * wave + l31) * 128;
#pragma unroll
            for (int kt = 0; kt < 4; ++kt)
#pragma unroll
                for (int rg = 0; rg < 4; ++rg) { u32x2 w; w.x = pkbf(acc[kt][4 * rg], acc[kt][4 * rg + 1]); w.y = pkbf(acc[kt][4 * rg + 2], acc[kt][4 * rg + 3]);
                    *(u32x2*)(Sp + 32 * kt + 8 * rg + 4 * hi) = w; }
        }
        __syncthreads();
    }
}
__device__ __forceinline__ void gla_scan_phase(bf16* ST, const float* DEC, int gtid, int nthr) {
    for (int e = gtid; e < 2 * 4 * 256 * 64; e += nthr) {
        const int kp = e & 63, v = (e >> 6) & 255, h = (e >> 14) & 3, b = e >> 16;
        float s0 = 0.f, s1 = 0.f;
        for (int c0 = 0; c0 < 128; c0 += 16) {
            unsigned ds[16]; f32x2 dc[16];
#pragma unroll
            for (int u = 0; u < 16; ++u) { const size_t item = (size_t)(b * 128 + c0 + u) * 4 + h; ds[u] = *(const unsigned*)(ST + (item * 256 + v) * 128 + 2 * kp); dc[u] = *(const f32x2*)(DEC + item * 128 + 2 * kp); }
#pragma unroll
            for (int u = 0; u < 16; ++u) { const size_t item = (size_t)(b * 128 + c0 + u) * 4 + h;
                *(unsigned*)(ST + (item * 256 + v) * 128 + 2 * kp) = pkbf(s0, s1); s0 = dc[u].x * s0 + bflo(ds[u]); s1 = dc[u].y * s1 + bfhi(ds[u]); }
        }
    }
}
__device__ __forceinline__ void gla_g5_phase(LAS unsigned char* lds, const bf16* Qb, const bf16* Kb, const bf16* VT, const bf16* Rb, const bf16* ST, const float* gain, bf16* O, int G) {
    LAS float* red = (LAS float*)lds;
    const int tid = threadIdx.x, lane = tid & 63, wave = tid >> 6, hi = lane >> 5, l31 = lane & 31;
    const int it = wave & 1, vp = wave >> 1;
    for (int item = blockIdx.x; item < 1024; item += G) {
        const int h = item & 3, c = (item >> 2) & 127, b = item >> 9; const size_t t0 = (size_t)b * SEQ + 64 * c;
        u32x2 rpre[2][4];
#pragma unroll
        for (int vt = 0; vt < 2; ++vt)
#pragma unroll
            for (int rg = 0; rg < 4; ++rg) rpre[vt][rg] = *(const u32x2*)(Rb + (t0 + 32 * it + l31) * 1024 + h * 256 + 32 * (2 * vp + vt) + 8 * rg + 4 * hi);
        bf16x8 qf[8];
        const bf16* Qp = Qb + (t0 + 32 * it + l31) * 512 + h * 128 + 8 * hi;
#pragma unroll
        for (int s = 0; s < 8; ++s) qf[s] = *(const bf16x8*)(Qp + 16 * s);
        f32x16 AT[2];
#pragma unroll
        for (int jt = 0; jt < 2; ++jt) {
            f32x16 acc;
#pragma unroll
            for (int r = 0; r < 16; ++r) acc[r] = 0.f;
            if (jt <= it) {
                const bf16* Kp = Kb + (t0 + 32 * jt + l31) * 512 + h * 128 + 8 * hi;
#pragma unroll
                for (int s = 0; s < 8; ++s) { const bf16x8 kf = *(const bf16x8*)(Kp + 16 * s); acc = MFMA32(kf, qf[s], acc); }
                if (jt == it) {
#pragma unroll
                    for (int r = 0; r < 16; ++r) acc[r] = (crow(r, hi) <= l31) ? acc[r] : 0.f;
                }
            }
            AT[jt] = acc;
        }
        f32x16 Oa[2];
#pragma unroll
        for (int vt = 0; vt < 2; ++vt) {
            f32x16 acc;
#pragma unroll
            for (int r = 0; r < 16; ++r) acc[r] = 0.f;
            const int vcol = 32 * (2 * vp + vt) + l31;
#pragma unroll
            for (int jt = 0; jt < 2; ++jt) {
                if (jt <= it) {
#pragma unroll
                    for (int jj = 0; jj < 2; ++jj) { const bf16* Vp = VT + (size_t)(h * 256 + vcol) * MROWS + t0 + 32 * jt + 16 * jj + 4 * hi; acc = MFMA32(ld2x8(Vp), pack8(AT[jt], jj), acc); }
                }
            }
            const bf16* Sp = ST + ((size_t)item * 256 + vcol) * 128 + 8 * hi;
#pragma unroll
            for (int s = 0; s < 8; ++s) { const bf16x8 sf = *(const bf16x8*)(Sp + 16 * s); acc = MFMA32(sf, qf[s], acc); }
            Oa[vt] = acc;
        }
        float ss = 0.f;
#pragma unroll
        for (int vt = 0; vt < 2; ++vt)
#pragma unroll
            for (int r = 0; r < 16; ++r) ss += Oa[vt][r] * Oa[vt][r];
        ss = xor32_sum(ss);
        if (hi == 0) red[vp * 64 + 32 * it + l31] = ss;
        __syncthreads();
        const float tot = (red[32 * it + l31] + red[64 + 32 * it + l31]) + (red[128 + 32 * it + l31] + red[192 + 32 * it + l31]);
        const float rs = 1.0f / sqrtf(tot * (1.0f / 256.0f) + EPS);
        const size_t row = t0 + 32 * it + l31;
#pragma unroll
        for (int vt = 0; vt < 2; ++vt)
#pragma unroll
            for (int rg = 0; rg < 4; ++rg) { const int vb = 32 * (2 * vp + vt) + 8 * rg + 4 * hi;
                const f32x4 gn = *(const f32x4*)(gain + vb); const u32x2 rr = rpre[vt][rg];
                const float o0 = Oa[vt][4 * rg] * rs * gn.x * silu_f(bflo(rr.x)), o1 = Oa[vt][4 * rg + 1] * rs * gn.y * silu_f(bfhi(rr.x));
                const float o2 = Oa[vt][4 * rg + 2] * rs * gn.z * silu_f(bflo(rr.y)), o3 = Oa[vt][4 * rg + 3] * rs * gn.w * silu_f(bfhi(rr.y));
                u32x2 w; w.x = pkbf(o0, o1); w.y = pkbf(o2, o3); *(u32x2*)(O + row * 1024 + h * 256 + vb) = w; }
        __syncthreads();
    }
}

#define XB_TMO      128
#define XB_XCNT(j)  (256  + 64 * (j))
#define XB_XSUB(j)  (1280 + 64 * (j))
#define XB_XGEN(j)  (2304 + 64 * (j))
#define XB_TOP      3328
#define XB_TOPGEN   3392
#define XCD_BAR_WORDS 3456
#define XB_SPIN_CAP (1u << 18)

__device__ __forceinline__ unsigned xb_ld(unsigned* p)              { return __hip_atomic_load(p, __ATOMIC_RELAXED, __HIP_MEMORY_SCOPE_AGENT); }
__device__ __forceinline__ unsigned xb_add(unsigned* p, unsigned v) { return __hip_atomic_fetch_add(p, v, __ATOMIC_RELAXED, __HIP_MEMORY_SCOPE_AGENT); }
__device__ __forceinline__ unsigned xb_xcc_id() { return (unsigned)__builtin_amdgcn_s_getreg((3 << 11) | 20) & 0xFu; }
#define XB_SPIN(cond, bar) do { unsigned _sp = 0; while (cond) { __builtin_amdgcn_s_sleep(1); \
    if ((++_sp & 255u) == 0u) { if (xb_ld(&(bar)[XB_TMO])) break; if (_sp > XB_SPIN_CAP) { atomicAdd(&(bar)[XB_TMO], 1u); break; } } } } while (0)

struct XcdBarrier {
    unsigned* bar; unsigned x;
    volatile LAS unsigned* st;
};

__device__ __forceinline__ XcdBarrier xcd_barrier_post(unsigned* bar, volatile LAS unsigned* st) {
    XcdBarrier b; b.bar = bar; b.x = xb_xcc_id(); b.st = st;
    if (threadIdx.x == 0) (void)xb_add(&bar[XB_XCNT(b.x)], 1u);
    return b;
}
__device__ __forceinline__ void xcd_barrier_complete(unsigned* bar, unsigned x, unsigned& nloc, unsigned& nx) {
    const unsigned G = gridDim.x * gridDim.y * gridDim.z;
    unsigned sum, cnt, mine, sp = 0u;
    for (;;) {
        sum = 0u; cnt = 0u; mine = 0u;
#pragma unroll
        for (unsigned j = 0; j < 16; ++j) { const unsigned c = xb_ld(&bar[XB_XCNT(j)]); sum += c; cnt += (c > 0u) ? 1u : 0u; mine = (j == x) ? c : mine; }
        if (sum == G) break;
        __builtin_amdgcn_s_sleep(1);
        if ((++sp & 255u) == 0u) { if (xb_ld(&bar[XB_TMO])) break; if (sp > XB_SPIN_CAP) { atomicAdd(&bar[XB_TMO], 1u); break; } }
    }
    nloc = mine > 0u ? mine : 1u; nx = cnt > 0u ? cnt : 1u;
}

__device__ __forceinline__ void xcd_barrier(const XcdBarrier& b) {
    asm volatile("s_waitcnt vmcnt(0)" ::: "memory");
    __syncthreads();
    if (threadIdx.x == 0) {
        unsigned* bar = b.bar;
        __builtin_amdgcn_s_waitcnt(0);
        unsigned nloc = b.st[0], nx = b.st[1];
        if (nloc == 0u) { xcd_barrier_complete(bar, b.x, nloc, nx); b.st[0] = nloc; b.st[1] = nx; }
        const unsigned old = xb_add(&bar[XB_XSUB(b.x)], 1u);
        const unsigned gen = old / nloc;
        if (old + 1u == (gen + 1u) * nloc) {
            __builtin_amdgcn_fence(__ATOMIC_RELEASE, "agent");
            asm volatile("s_waitcnt vmcnt(0)" ::: "memory");
            const unsigned og = xb_add(&bar[XB_TOP], 1u);
            const unsigned tg = og / nx;
            if (og + 1u == (tg + 1u) * nx) xb_add(&bar[XB_TOPGEN], 1u);
            else XB_SPIN(xb_ld(&bar[XB_TOPGEN]) == tg, bar);
            __builtin_amdgcn_fence(__ATOMIC_ACQUIRE, "agent");
            xb_add(&bar[XB_XGEN(b.x)], 1u);
            asm volatile("s_waitcnt vmcnt(0)" ::: "memory");
        } else {
            XB_SPIN(xb_ld(&bar[XB_XGEN(b.x)]) == gen, bar);
            __builtin_amdgcn_fence(__ATOMIC_ACQUIRE, "agent");
            asm volatile("s_waitcnt vmcnt(0)" ::: "memory");
        }
    }
    __syncthreads();
}

constexpr size_t WS_BAR = 262144;
constexpr int MISC_OFF = 147200;
struct Params {
    const float *x, *c, *w_ada, *b_ada, *norm_mix, *norm_ffn, *attn_w_in, *attn_w_out, *gla_w_in, *gla_w_gate, *gla_b_gate, *gla_norm, *gla_w_out,
                *ffn_w_up, *ffn_conv_w, *ffn_conv_b, *ffn_w_down, *norm_final;
    float* out; unsigned char* ws;
};

typedef const __attribute__((address_space(4))) Params* kparams_t;
__device__ __forceinline__ kparams_t kp() { kparams_t q = (kparams_t)__builtin_amdgcn_kernarg_segment_ptr(); asm volatile("" : "+s"(q)); return q; }
#define PHASE_IDX int z_; asm volatile("s_mov_b32 %0, 0" : "=s"(z_)); const int tid = (int)threadIdx.x + z_, lane = tid & 63, wave = __builtin_amdgcn_readfirstlane(tid >> 6); \
    const int G = gridDim.x, bid = (int)blockIdx.x + z_, gw = bid * NWAVES + wave, ngw = G * NWAVES, gtid = bid * NTHR + tid, nthr = G * NTHR; \
    unsigned char* ws = kp()->ws; (void)lane; (void)gw; (void)ngw; (void)gtid; (void)nthr; (void)ws;
#define GSYNC_CG() do { asm volatile("s_waitcnt vmcnt(0) lgkmcnt(0)" ::: "memory"); cg::this_grid().sync(); asm volatile("" ::: "memory"); } while (0)
#define GSYNC() do { XcdBarrier b_; b_.bar = (unsigned*)(kp()->ws + WS_BAR); b_.x = xb_xcc_id(); b_.st = (volatile LAS unsigned*)(LDSP + MISC_OFF); xcd_barrier(b_); asm volatile("" ::: "memory"); } while (0)
#ifdef PROBE_GROUP
#define TSBUF ((unsigned long long*)(kp()->ws + 819200))
#undef GSYNC
#define GSYNC() do { XcdBarrier b_; b_.bar = (unsigned*)(kp()->ws + WS_BAR); b_.x = xb_xcc_id(); b_.st = (volatile LAS unsigned*)(LDSP + MISC_OFF); xcd_barrier(b_); asm volatile("" ::: "memory"); \
    if (threadIdx.x == 0 && blockIdx.x == 0) { unsigned long long* tb_ = TSBUF; const unsigned long long k_ = tb_[63]; tb_[k_] = __builtin_amdgcn_s_memrealtime(); tb_[63] = k_ + 1; } } while (0)
#endif
#define LDSP ((LAS unsigned char*)lds_raw)

template <class Epi>
__device__ __forceinline__ void run_gemm(LAS unsigned char* lds, const bf16* A, const bf16* Bt, int M, int N, int K, int dil, int L, int rot, const Epi& E) {
    pg8::Gemm g{A, Bt, M, N, K, dil, L}; pg8::StaticOrder S; const int G = gridDim.x; S.init(M, N, G, (int)((blockIdx.x + rot) % G));
    int z_; asm volatile("s_mov_b32 %0, 0" : "=s"(z_));
    pg8::gemm_phase<Epi, pg8::StaticOrder, true, true>((PG8_LAS unsigned char*)lds, g, S, E, (int)threadIdx.x + z_);
}

#define FFN_BLOCK(layer) do { \
    { PHASE_IDX; const float* ml = (const float*)(ws + WS_MOD) + (size_t)(layer) * 2 * 6144; \
      modulate_phase(kp()->out, (bf16*)(ws + WS_XN), kp()->norm_ffn + (layer) * DM, ml + 3 * 1024, ml + 4 * 1024, gw, ngw, lane); } \
    GSYNC(); \
    { unsigned char* ws = kp()->ws; pg8::EpiUpConv E{(bf16*)(ws + F_U), kp()->ffn_conv_w + (size_t)(layer) * 3 * FF, kp()->ffn_conv_b + (size_t)(layer) * FF, (float*)(ws + F_TA), (float*)(ws + F_HA), (float*)(ws + F_HU), (PG8_LAS float*)(LDSP + 131072)}; \
      run_gemm(LDSP, (const bf16*)(ws + WS_XN), (const bf16*)(ws + W_UP), MROWS, 2 * FF, DM, 1, MROWS, 0, E); } \
    GSYNC(); \
    { PHASE_IDX; convfix_phase((bf16*)(ws + F_U), (const float*)(ws + F_TA), (const float*)(ws + F_HA), (const float*)(ws + F_HU), kp()->ffn_conv_w + (size_t)(layer) * 3 * FF, kp()->ffn_conv_b + (size_t)(layer) * FF, gtid, nthr); } \
    GSYNC(); \
    { unsigned char* ws = kp()->ws; float* o = kp()->out; pg8::EpiRes E{o, o, (const float*)(ws + WS_MOD) + (size_t)(layer) * 2 * 6144 + 5 * 1024}; \
      run_gemm(LDSP, (const bf16*)(ws + F_U), (const bf16*)(ws + W_DOWN), MROWS, DM, FF, 1, MROWS, 0, E); } \
    GSYNC(); } while (0)

__global__ void __launch_bounds__(NTHR, 2) fwd_kernel(Params p_unused) {
    extern __shared__ __attribute__((aligned(16))) unsigned char lds_raw[];
#ifdef PROBE_GROUP
    if (threadIdx.x == 0 && blockIdx.x == 0) { unsigned long long* tb_ = TSBUF; tb_[62] = __builtin_amdgcn_s_memrealtime(); tb_[63] = 0; }
#endif
    if (threadIdx.x == 0) { volatile LAS unsigned* st_ = (volatile LAS unsigned*)(LDSP + MISC_OFF); st_[0] = 0u; st_[1] = 0u; }
    __syncthreads();
    (void)xcd_barrier_post((unsigned*)(kp()->ws + WS_BAR), (volatile LAS unsigned*)(LDSP + MISC_OFF));
    {
        PHASE_IDX;
        LAS unsigned char* lds = LDSP;
        float* mod = (float*)(ws + WS_MOD);
        LAS float* scr = (LAS float*)(lds + wave * 16384);
        LAS float* red = (LAS float*)(lds + 131072);
        const float* cvec = kp()->c; const float* b_ada = kp()->b_ada;
        for (int it = bid; it < 192; it += G) {
            const int layer = it / 96, ch = it % 96, n = ch * 64 + lane;
            const float* W = kp()->w_ada + (size_t)layer * 1024 * 6144;
            float a0 = 0.f, a1 = 0.f;
#pragma unroll 32
            for (int kk = 0; kk < 128; ++kk) { const int k = wave * 128 + kk; const float wv = W[(size_t)k * 6144 + n]; a0 += silu_f(cvec[k]) * wv; a1 += silu_f(cvec[1024 + k]) * wv; }
            red[(wave * 2 + 0) * 64 + lane] = a0; red[(wave * 2 + 1) * 64 + lane] = a1;
            __syncthreads();
            if (wave == 0) { float t0 = b_ada[layer * 6144 + n], t1 = t0;
                for (int w = 0; w < 8; ++w) { t0 += red[(w * 2) * 64 + lane]; t1 += red[(w * 2 + 1) * 64 + lane]; }
                mod[(size_t)(layer * 2 + 0) * 6144 + n] = t0; mod[(size_t)(layer * 2 + 1) * 6144 + n] = t1; }
            __syncthreads();
        }
        constexpr int I_IN = 16 * 288, I_O = 16 * 32, I_UP = 16 * 176, I_DN = 44 * 32;
        for (int it = gw; it < I_IN + I_O + I_UP + I_DN; it += ngw) {
            int r = it;
            if (r < I_IN) { transpose_item(kp()->attn_w_in, 1024, 9216, (bf16*)(ws + W_IN), 1, scr, r, lane); continue; } r -= I_IN;
            if (r < I_O) { transpose_item(kp()->attn_w_out, 1024, 1024, (bf16*)(ws + W_OUT), 0, scr, r, lane); continue; } r -= I_O;
            if (r < I_UP) { transpose_item(kp()->ffn_w_up, 1024, 2 * FF, (bf16*)(ws + W_UP), 3, scr, r, lane); continue; } r -= I_UP;
            transpose_item(kp()->ffn_w_down, FF, 1024, (bf16*)(ws + W_DOWN), 0, scr, r, lane);
        }
    }
    if (kp()->ws == nullptr) GSYNC_CG();
    GSYNC();
#if STAGE >= 1
    { PHASE_IDX; const float* mod = (const float*)(ws + WS_MOD); modulate_phase(kp()->x, (bf16*)(ws + WS_XN), kp()->norm_mix, mod + 0 * 1024, mod + 1 * 1024, gw, ngw, lane); }
    GSYNC();
    for (int b = 0; b < 2; ++b) {
        for (int g = 0; g < 3; ++g) {
            unsigned char* ws = kp()->ws;
            const int dil = (g == 0) ? 1 : (g == 1 ? 4 : 16);
            pg8::EpiAttn E{(bf16*)(ws + A_Q) + (size_t)g * 8192 * 1024, (bf16*)(ws + A_K) + (size_t)g * 8192 * 1024, (bf16*)(ws + A_VT) + (size_t)g * 8192 * 1024};
            run_gemm(LDSP, (const bf16*)(ws + WS_XN) + (size_t)b * SEQ * DM, (const bf16*)(ws + W_IN) + (size_t)g * 3072 * 1024, SEQ, 3072, DM, dil, SEQ / dil, g * 128, E);
        }
        GSYNC();
        { PHASE_IDX; attn_phase(LDSP, (bf16*)(ws + A_Q), (const bf16*)(ws + A_K), (const bf16*)(ws + A_VT), (float*)(ws + A_LSE), tid, bid); }
        GSYNC();
        { PHASE_IDX; combine_phase((const bf16*)(ws + A_Q), (const float*)(ws + A_LSE), (bf16*)(ws + WS_XN) + (size_t)b * SEQ * DM, gtid, nthr); }
        GSYNC();
    }
    { unsigned char* ws = kp()->ws; pg8::EpiRes E{kp()->x, kp()->out, (const float*)(ws + WS_MOD) + 2 * 1024}; run_gemm(LDSP, (const bf16*)(ws + WS_XN), (const bf16*)(ws + W_OUT), MROWS, DM, DM, 1, MROWS, 0, E); }
    GSYNC();
#endif
#if STAGE >= 2
    FFN_BLOCK(0);
#endif
#if STAGE >= 3
    {
        {
            PHASE_IDX;
            const float* ml = (const float*)(ws + WS_MOD) + (size_t)2 * 6144;
            modulate_phase(kp()->out, (bf16*)(ws + WS_XN), kp()->norm_mix + DM, ml + 0 * 1024, ml + 1 * 1024, gw, ngw, lane);
            LAS float* scr = (LAS float*)(LDSP + wave * 16384);
            constexpr int I_IN = 16 * 97, I_O = 16 * 32, I_UP = 16 * 176, I_DN = 44 * 32;
            for (int it = gw; it < I_IN + I_O + I_UP + I_DN; it += ngw) {
                int r = it;
                if (r < I_IN) { transpose_item(kp()->gla_w_in, 1024, 3088, (bf16*)(ws + W_IN), 2, scr, r, lane); continue; } r -= I_IN;
                if (r < I_O) { transpose_item(kp()->gla_w_out, 1024, 1024, (bf16*)(ws + W_OUT), 0, scr, r, lane); continue; } r -= I_O;
                if (r < I_UP) { transpose_item(kp()->ffn_w_up + (size_t)1024 * 2 * FF, 1024, 2 * FF, (bf16*)(ws + W_UP), 3, scr, r, lane); continue; } r -= I_UP;
                transpose_item(kp()->ffn_w_down + (size_t)FF * 1024, FF, 1024, (bf16*)(ws + W_DOWN), 0, scr, r, lane);
            }
            for (int i = gtid; i < 240 * 1024 / 8; i += nthr) ((u32x4*)(ws + W_IN + (size_t)3088 * 1024 * 2))[i] = (u32x4){0u, 0u, 0u, 0u};
        }
        GSYNC();
        { unsigned char* ws = kp()->ws; pg8::EpiGla E{(bf16*)(ws + G_Q), (bf16*)(ws + G_K), (bf16*)(ws + G_VT), (bf16*)(ws + G_R), (float*)(ws + G_GL)};
          run_gemm(LDSP, (const bf16*)(ws + WS_XN), (const bf16*)(ws + W_IN), MROWS, 3328, DM, 1, MROWS, 0, E); }
        GSYNC();
        { PHASE_IDX; gla_g3_phase(LDSP, (bf16*)(ws + G_Q), (bf16*)(ws + G_K), (const bf16*)(ws + G_VT), (const float*)(ws + G_GL), kp()->gla_w_gate, kp()->gla_b_gate, (float*)(ws + G_DEC), (bf16*)(ws + G_ST), G); }
        GSYNC();
        { PHASE_IDX; gla_scan_phase((bf16*)(ws + G_ST), (const float*)(ws + G_DEC), gtid, nthr); }
        GSYNC();
        { PHASE_IDX; gla_g5_phase(LDSP, (const bf16*)(ws + G_Q), (const bf16*)(ws + G_K), (const bf16*)(ws + G_VT), (const bf16*)(ws + G_R), (const bf16*)(ws + G_ST), kp()->gla_norm, (bf16*)(ws + WS_XN), G); }
        GSYNC();
        { unsigned char* ws = kp()->ws; float* o = kp()->out; pg8::EpiRes E{o, o, (const float*)(ws + WS_MOD) + (size_t)2 * 6144 + 2 * 1024}; run_gemm(LDSP, (const bf16*)(ws + WS_XN), (const bf16*)(ws + W_OUT), MROWS, DM, DM, 1, MROWS, 0, E); }
        GSYNC();
    }
#endif
#if STAGE >= 4
    FFN_BLOCK(1);
#endif
    { PHASE_IDX;
#if STAGE >= 1
      final_norm_phase(kp()->out, kp()->out, kp()->norm_final, gw, ngw, lane);
#else
      final_norm_phase(kp()->x, kp()->out, kp()->norm_final, gw, ngw, lane);
#endif
    }
#ifdef PROBE_GROUP
    if (threadIdx.x == 0 && blockIdx.x == 0) {
        unsigned long long* tb_ = TSBUF; const unsigned long long tend = __builtin_amdgcn_s_memrealtime();
        unsigned long long d[24]; d[0] = tb_[0] - tb_[62]; for (int k = 1; k < 23; ++k) d[k] = tb_[k] - tb_[k - 1]; d[23] = tend - tb_[22];
        unsigned long long sel = 0;
        if (PROBE_GROUP == 1) sel = d[2] + d[5] + d[8] + d[10] + d[12] + d[14] + d[18] + d[20] + d[22];
        if (PROBE_GROUP == 2) sel = d[3] + d[6];
        if (PROBE_GROUP == 3) sel = d[15] + d[16] + d[17];
        if (PROBE_GROUP == 4) sel = d[1] + d[9] + d[13] + d[19] + d[23];
        if (PROBE_GROUP == 5) sel = d[11] + d[21];
        if (PROBE_GROUP == 6) sel = d[0];
        if (PROBE_GROUP == 7) sel = d[4] + d[7];
        if (PROBE_GROUP == 8) sel = d[10] + d[20];
        if (PROBE_GROUP == 9) sel = d[2] + d[5];
        if (PROBE_GROUP == 10) sel = d[16];
        if (PROBE_GROUP == 11) sel = d[15];
        const unsigned long long t0 = __builtin_amdgcn_s_memrealtime();
        while (__builtin_amdgcn_s_memrealtime() - t0 < 2 * sel) __builtin_amdgcn_s_sleep(8);
    }
#endif
}

extern "C" void kernel_launch(void* const* d_in, const int* in_sizes, int n_in, void* d_out, int out_size, void* d_ws, size_t ws_size, hipStream_t stream) {
    static int grid = 0;
    if (grid == 0) {
        if (n_in != 18 || ws_size < WS_END) { fprintf(stderr, "kernel_launch: unexpected n_in %d / ws_size %zu\n", n_in, ws_size); grid = -1; return; }
        int dev = 0, cus = 0, per_cu = 0;
        hipGetDevice(&dev);
        hipDeviceGetAttribute(&cus, hipDeviceAttributeMultiprocessorCount, dev);
        hipFuncSetAttribute((const void*)fwd_kernel, hipFuncAttributeMaxDynamicSharedMemorySize, LDS_BYTES);
        hipOccupancyMaxActiveBlocksPerMultiprocessor(&per_cu, (const void*)fwd_kernel, NTHR, LDS_BYTES);
        if (per_cu < 1) { fprintf(stderr, "kernel_launch: occupancy query says %d blocks per CU\n", per_cu); grid = -1; return; }
        grid = cus;
    }
    if (grid < 0) return;
    if (hipMemsetAsync((char*)d_ws + WS_BAR, 0, 16384, stream) != hipSuccess) { fprintf(stderr, "kernel_launch: memset of barrier words failed\n"); return; }
    Params p{};
    const float** pp = (const float**)&p;
    for (int i = 0; i < 18; ++i) pp[i] = (const float*)d_in[i];
    p.out = (float*)d_out; p.ws = (unsigned char*)d_ws;
    void* args[] = {&p};
    hipError_t e = hipLaunchCooperativeKernel((const void*)fwd_kernel, dim3(grid), dim3(NTHR), args, LDS_BYTES, stream);
    if (e != hipSuccess) fprintf(stderr, "cooperative launch failed: %s (grid %d)\n", hipGetErrorString(e), grid);
}
```
